# Optimizing an MI355X kernel written in HIP

```python
import math
import jax
import jax.numpy as jnp
from jax import lax
import numpy as np

D_MODEL = 1024
BATCH = 4
SEQ = 8192
DEPTH = 1

GRID_W = 64
CTX_LEN = 256
QBLOCK = 128
ROPE_THETA = 10000.0
EPS = 1e-6

MLA_HEADS = 8
MLA_Q_RANK = 256
MLA_KV_RANK = 128
MLA_NOPE = 64
MLA_ROPE = 32
MLA_V = 64
DIFF_HEADS = 4
DIFF_HD = 64
N_EXPERTS = 16
EXPERT_FF = 1024
EC_CAPACITY = 2

MLA_Q_OFF = 0
MLA_KV_OFF = MLA_Q_OFF + MLA_Q_RANK
MLA_KR_OFF = MLA_KV_OFF + MLA_KV_RANK
DIFF_Q_OFF = MLA_KR_OFF + MLA_ROPE
DIFF_K_OFF = DIFF_Q_OFF + DIFF_HEADS * 2 * DIFF_HD
DIFF_V_OFF = DIFF_K_OFF + DIFF_HEADS * 2 * DIFF_HD
GATE_OFF = DIFF_V_OFF + DIFF_HEADS * 2 * DIFF_HD
N_IN = GATE_OFF + 2 * D_MODEL
MLA_WIDTH = MLA_HEADS * MLA_V
DIFF_WIDTH = DIFF_HEADS * 2 * DIFF_HD
MLA_SCALE = (MLA_NOPE + MLA_ROPE) ** -0.5
DIFF_SCALE = DIFF_HD ** -0.5
DEEPNORM_ALPHA = (2 * DEPTH) ** 0.25
DEEPNORM_BETA = (8 * DEPTH) ** -0.25

kernel_name = 'hybrid_mla_diffattn_ecmoe_dit_block'


def layer_norm(x, g, b):
    xf = x.astype(jnp.float32)
    mu = jnp.mean(xf, axis=-1, keepdims=True)
    var = jnp.mean(jnp.square(xf - mu), axis=-1, keepdims=True)
    y = (xf - mu) * lax.rsqrt(var + EPS) * g.astype(jnp.float32) + b.astype(jnp.float32)
    return y.astype(x.dtype)


def rms_norm(x, g):
    xf = x.astype(jnp.float32)
    y = xf * lax.rsqrt(jnp.mean(xf * xf, axis=-1, keepdims=True) + EPS) * g.astype(jnp.float32)
    return y.astype(x.dtype)


def rope_1d(x, pos):
    d = x.shape[-1]
    half = d // 2
    inv = ROPE_THETA ** (-(jnp.arange(half, dtype=jnp.float32) * 2.0 / d))
    ang = pos.astype(jnp.float32)[:, None] * inv
    cos, sin = jnp.cos(ang), jnp.sin(ang)
    xf = x.astype(jnp.float32)
    x1, x2 = xf[..., :half], xf[..., half:]
    return jnp.concatenate([x1 * cos - x2 * sin, x2 * cos + x1 * sin], axis=-1).astype(x.dtype)


def axial_rope(x, row, col):
    h = x.shape[-1] // 2
    return jnp.concatenate([rope_1d(x[..., :h], row), rope_1d(x[..., h:], col)], axis=-1)


def split_heads(t, n_heads):
    b, s, _ = t.shape
    return t.reshape(b, s, n_heads, -1).transpose(0, 2, 1, 3)


def merge_heads(t):
    b, h, s, d = t.shape
    return t.transpose(0, 2, 1, 3).reshape(b, s, h * d)


def over_query_blocks(fn, q):
    b, h, sq = q.shape[:3]
    rest = q.shape[3:]
    nb = sq // QBLOCK
    qb = jnp.moveaxis(q.reshape(b, h, nb, QBLOCK, *rest), 2, 0)
    out = lax.map(fn, qb)
    out = jnp.moveaxis(out, 0, 2)
    return out.reshape(b, h, sq, out.shape[-1])


def softmax_attention(q, k, v, scale):
    def one(qb):
        s = jnp.einsum('bhqd,bhkd->bhqk', qb, k).astype(jnp.float32) * scale
        p = jax.nn.softmax(s, axis=-1)
        return jnp.einsum('bhqk,bhkd->bhqd', p.astype(v.dtype), v)
    return over_query_blocks(one, q)


def diff_attention(q, k, v, lam, scale):
    def one(qb):
        s = jnp.einsum('bhqmd,bhkmd->bhmqk', qb, k).astype(jnp.float32) * scale
        p = jax.nn.softmax(s, axis=-1)
        w = p[:, :, 0] - lam * p[:, :, 1]
        return jnp.einsum('bhqk,bhkd->bhqd', w.astype(v.dtype), v)
    return over_query_blocks(one, q)


def mixer_projections(h, w_in, g_q, w_uq, g_kv, w_ukv, pos):
    b, s, _ = h.shape
    p = h @ w_in
    c_q = rms_norm(p[..., MLA_Q_OFF:MLA_KV_OFF], g_q)
    q = split_heads(c_q @ w_uq, MLA_HEADS)
    c_kv = rms_norm(p[..., MLA_KV_OFF:MLA_KR_OFF], g_kv)
    kv = split_heads(c_kv @ w_ukv, MLA_HEADS)
    q_nope, q_rope = q[..., :MLA_NOPE], q[..., MLA_NOPE:]
    k_nope, v_mla = kv[..., :MLA_NOPE], kv[..., MLA_NOPE:]
    k_rope = p[..., MLA_KR_OFF:DIFF_Q_OFF][:, None]
    dq = p[..., DIFF_Q_OFF:DIFF_K_OFF].reshape(b, s, DIFF_HEADS, 2, DIFF_HD).transpose(0, 2, 3, 1, 4)
    dk = p[..., DIFF_K_OFF:DIFF_V_OFF].reshape(b, s, DIFF_HEADS, 2, DIFF_HD).transpose(0, 2, 3, 1, 4)
    dv = split_heads(p[..., DIFF_V_OFF:GATE_OFF], DIFF_HEADS)
    if pos is not None:
        row, col = pos
        q_rope = axial_rope(q_rope, row, col)
        k_rope = axial_rope(k_rope, row, col)
        dq = axial_rope(dq, row, col)
        dk = axial_rope(dk, row, col)
    q_mla = jnp.concatenate([q_nope, q_rope], axis=-1)
    k_mla = jnp.concatenate([k_nope, jnp.broadcast_to(k_rope, (b, MLA_HEADS, s, MLA_ROPE))], axis=-1)
    dq = dq.transpose(0, 1, 3, 2, 4)
    dk = dk.transpose(0, 1, 3, 2, 4)
    gates = jax.nn.sigmoid(p[..., GATE_OFF:].astype(jnp.float32)).astype(h.dtype)
    return (q_mla, k_mla, v_mla, dq, dk, dv, gates)


def mixer_output(q_mla, dq, gates, k_mla, v_mla, dk, dv, lam, lambda_init, g_subln, w_o_mla, w_o_diff, w_out):
    o_mla = merge_heads(softmax_attention(q_mla, k_mla, v_mla, MLA_SCALE))
    o_diff = rms_norm(diff_attention(dq, dk, dv, lam, DIFF_SCALE), g_subln) * (1.0 - lambda_init)
    o_diff = merge_heads(o_diff)
    y = gates[..., :D_MODEL] * (o_mla @ w_o_mla) + gates[..., D_MODEL:] * (o_diff @ w_o_diff)
    return y @ w_out


def ec_moe(h, w_router, b_router, w1, w3, w2):
    b, n, _ = h.shape
    cap = EC_CAPACITY * n // N_EXPERTS
    aff = jax.nn.softmax((h @ w_router + b_router).astype(jnp.float32), axis=-1)
    g, idx = lax.top_k(jnp.swapaxes(aff, 1, 2), cap)
    bidx = jnp.arange(b)[:, None, None]
    xe = h[bidx, idx]
    hid = jax.nn.silu(jnp.einsum('becd,edf->becf', xe, w1)) * jnp.einsum('becd,edf->becf', xe, w3)
    ye = jnp.einsum('becf,efd->becd', hid, w2) * g[..., None].astype(h.dtype)
    return jnp.zeros_like(h).at[bidx, idx].add(ye)


def setup_inputs(seed: int = 0) -> dict:
    key = jax.random.key(seed)
    ks = jax.random.split(key, 32)
    L, D = DEPTH, D_MODEL

    def nrm(k, shape, scale):
        return jax.random.normal(k, shape, jnp.float32) * scale

    return {
        'x': nrm(ks[0], (BATCH, SEQ, D), 1.0),
        'c': nrm(ks[1], (BATCH, D), 1.0),
        'ctx': nrm(ks[2], (BATCH, CTX_LEN, D), 1.0),
        'c_ctx': nrm(ks[3], (D,), 1.0),
        'w_ada': nrm(ks[4], (L, D, 6 * D), 0.5 * D ** -0.5),
        'b_ada': nrm(ks[5], (L, 6 * D), 0.02),
        'w_in': nrm(ks[6], (L, D, N_IN), D ** -0.5),
        'mla_g_q': 1.0 + nrm(ks[7], (L, MLA_Q_RANK), 0.02),
        'mla_w_uq': nrm(ks[8], (L, MLA_Q_RANK, MLA_HEADS * (MLA_NOPE + MLA_ROPE)), MLA_Q_RANK ** -0.5),
        'mla_g_kv': 1.0 + nrm(ks[9], (L, MLA_KV_RANK), 0.02),
        'mla_w_ukv': nrm(ks[10], (L, MLA_KV_RANK, MLA_HEADS * (MLA_NOPE + MLA_V)), MLA_KV_RANK ** -0.5),
        'mla_w_o': nrm(ks[11], (L, MLA_WIDTH, D), MLA_WIDTH ** -0.5),
        'diff_lambda': nrm(ks[12], (L, 4, DIFF_HD), 0.1),
        'diff_g_subln': 1.0 + nrm(ks[13], (L, 2 * DIFF_HD), 0.02),
        'diff_w_o': nrm(ks[14], (L, DIFF_WIDTH, D), DIFF_WIDTH ** -0.5),
        'w_out': nrm(ks[15], (L, D, D), DEEPNORM_BETA * D ** -0.5),
        'ln1_g': 1.0 + nrm(ks[16], (L, D), 0.02),
        'ln1_b': nrm(ks[17], (L, D), 0.02),
        'moe_w_router': nrm(ks[18], (L, D, N_EXPERTS), D ** -0.5),
        'moe_b_router': nrm(ks[19], (L, N_EXPERTS), 0.01),
        'moe_w1': nrm(ks[20], (L, N_EXPERTS, D, EXPERT_FF), D ** -0.5),
        'moe_w3': nrm(ks[21], (L, N_EXPERTS, D, EXPERT_FF), D ** -0.5),
        'moe_w2': nrm(ks[22], (L, N_EXPERTS, EXPERT_FF, D), DEEPNORM_BETA * EXPERT_FF ** -0.5),
        'ln2_g': 1.0 + nrm(ks[23], (L, D), 0.02),
        'ln2_b': nrm(ks[24], (L, D), 0.02),
    }


def reference(x, c, ctx, c_ctx, w_ada, b_ada, w_in, mla_g_q, mla_w_uq, mla_g_kv, mla_w_ukv, mla_w_o,
              diff_lambda, diff_g_subln, diff_w_o, w_out, ln1_g, ln1_b, moe_w_router, moe_b_router,
              moe_w1, moe_w3, moe_w2, ln2_g, ln2_b):
    rows = x.shape[1] // GRID_W
    row = jnp.repeat(jnp.arange(rows, dtype=jnp.int32), GRID_W)
    col = jnp.tile(jnp.arange(GRID_W, dtype=jnp.int32), rows)
    for l in range(DEPTH):
        lambda_init = 0.8 - 0.6 * math.exp(-0.3 * l)
        lq1, lk1, lq2, lk2 = diff_lambda[l].astype(jnp.float32)
        lam = jnp.exp(jnp.sum(lq1 * lk1)) - jnp.exp(jnp.sum(lq2 * lk2)) + lambda_init
        mod = jax.nn.silu(c) @ w_ada[l] + b_ada[l]
        sh1, sc1, g1, sh2, sc2, g2 = jnp.split(mod[:, None, :], 6, axis=-1)
        mod_c = jax.nn.silu(c_ctx) @ w_ada[l] + b_ada[l]
        sh1c, sc1c, g1c, sh2c, sc2c, g2c = jnp.split(mod_c, 6)
        proj = (w_in[l], mla_g_q[l], mla_w_uq[l], mla_g_kv[l], mla_w_ukv[l])
        outp = (lam, lambda_init, diff_g_subln[l], mla_w_o[l], diff_w_o[l], w_out[l])
        moe = (moe_w_router[l], moe_b_router[l], moe_w1[l], moe_w3[l], moe_w2[l])
        qm_c, km_c, vm_c, dq_c, dk_c, dv_c, gt_c = mixer_projections(ctx * (1.0 + sc1c) + sh1c, *proj, None)
        qm, km, vm, dq, dk, dv, gt = mixer_projections(x * (1.0 + sc1) + sh1, *proj, (row, col))
        o_lat = mixer_output(qm, dq, gt,
                             jnp.concatenate([km_c, km], axis=2), jnp.concatenate([vm_c, vm], axis=2),
                             jnp.concatenate([dk_c, dk], axis=2), jnp.concatenate([dv_c, dv], axis=2),
                             *outp)
        x = layer_norm(DEEPNORM_ALPHA * x + g1 * o_lat, ln1_g[l], ln1_b[l])
        x = layer_norm(DEEPNORM_ALPHA * x + g2 * ec_moe(x * (1.0 + sc2) + sh2, *moe), ln2_g[l], ln2_b[l])
        if l + 1 < DEPTH:
            o_ctx = mixer_output(qm_c, dq_c, gt_c, km_c, vm_c, dk_c, dv_c, *outp)
            ctx = layer_norm(DEEPNORM_ALPHA * ctx + g1c * o_ctx, ln1_g[l], ln1_b[l])
            ctx = layer_norm(DEEPNORM_ALPHA * ctx + g2c * ec_moe(ctx * (1.0 + sc2c) + sh2c, *moe),
                             ln2_g[l], ln2_b[l])
    return x
```

```cpp
#define MK_ONE_LAUNCH 0
#define MK_SLOWK 0
#define MK_NAIVE_ATTN 0
#include <hip/hip_runtime.h>
#include <hip/hip_cooperative_groups.h>
#include <cstdio>
#include <cstdint>
namespace cg = cooperative_groups;

#ifndef MK_ONE_LAUNCH
#define MK_ONE_LAUNCH 0
#endif
#ifndef MK_SLOWK
#define MK_SLOWK 1
#endif
#ifndef MK_NAIVE_ATTN
#define MK_NAIVE_ATTN 1
#endif

#define LAS __attribute__((address_space(3)))
#define GAS __attribute__((address_space(1)))
typedef unsigned short bf16_t;
typedef short bf16x8 __attribute__((ext_vector_type(8)));
typedef short s16x4 __attribute__((ext_vector_type(4)));
typedef float f32x2 __attribute__((ext_vector_type(2)));
typedef float f32x4 __attribute__((ext_vector_type(4)));
typedef float f32x16 __attribute__((ext_vector_type(16)));
typedef unsigned u32x2 __attribute__((ext_vector_type(2)));
typedef unsigned u32x4 __attribute__((ext_vector_type(4)));

constexpr int DM = 1024, NB = 4, SEQ = 8192, CTXL = 256, SK = SEQ + CTXL;
constexpr int NLAT = NB * SEQ, NCTX = NB * CTXL, MTOT = NCTX + NLAT;
constexpr int NE = 16, CAP = 1024, FFD = 1024, NIN = 4000;
constexpr float EPS = 1e-6f, LOG2E = 1.4426950408889634f;
constexpr float MLA_QS = 0.10206207261596577f * LOG2E;
constexpr float DIFF_QS = 0.125f * LOG2E;
constexpr float ALPHA = 1.189207115002721f;
constexpr float LAMBDA_INIT = 0.2f;
constexpr int NWAVES = 8, NTHR = 512;

constexpr size_t MiB = 1u << 20;
constexpr size_t WS_CTL = 0;
constexpr size_t WS_MOD = 1 * MiB;
constexpr size_t WS_ROPE = 1 * MiB + 256 * 1024;
constexpr size_t WS_LAM = 1 * MiB + 512 * 1024;
constexpr size_t WS_SSQ = 2 * MiB;
constexpr size_t WS_KR = 4 * MiB;
constexpr size_t WS_AFF = 7 * MiB;
constexpr size_t WS_IDX = 9 * MiB;
constexpr size_t WS_GSEL = 9 * MiB + 512 * 1024;
constexpr size_t WS_SLOT = 10 * MiB;
constexpr size_t WS_WIN = 16 * MiB;
constexpr size_t WS_WUQ = 24 * MiB;
constexpr size_t WS_WUKV = 25 * MiB;
constexpr size_t WS_WOC = 26 * MiB;
constexpr size_t WS_WOUT = 28 * MiB;
constexpr size_t WS_W13 = 32 * MiB;
constexpr size_t WS_W2T = 96 * MiB;
constexpr size_t WS_A1 = 128 * MiB;
constexpr size_t WS_P0B = 194 * MiB;
constexpr size_t WS_QD = 228 * MiB;
constexpr size_t WS_KD = 260 * MiB;
constexpr size_t WS_VD = 293 * MiB;
constexpr size_t WS_QM = 326 * MiB;
constexpr size_t WS_KM = 374 * MiB;
constexpr size_t WS_VM = 424 * MiB;
constexpr size_t WS_OA = 128 * MiB;
constexpr size_t WS_Y = 192 * MiB;
constexpr size_t WS_H2 = 128 * MiB;
constexpr size_t WS_XE = 256 * MiB;
constexpr size_t WS_HID = 384 * MiB;
constexpr size_t WS_YE = 256 * MiB;
constexpr size_t WS_NEED = 512 * MiB;

constexpr int LDS_BYTES = 147456;

typedef __bf16 bf16x2_t __attribute__((ext_vector_type(2)));
__device__ __forceinline__ unsigned cvt_pk_bf16(float lo, float hi) { const f32x2 v = {lo, hi}; const bf16x2_t b = __builtin_convertvector(v, bf16x2_t); return __builtin_bit_cast(unsigned, b); }
__device__ __forceinline__ float bf_lo(unsigned w) { return __uint_as_float(w << 16); }
__device__ __forceinline__ float bf_hi(unsigned w) { return __uint_as_float(w & 0xffff0000u); }
__device__ __forceinline__ float bf2f(bf16_t h) { return __uint_as_float(((unsigned)h) << 16); }
__device__ __forceinline__ float fast_exp2(float x) { return __builtin_amdgcn_exp2f(x); }
__device__ __forceinline__ float fast_rcp(float x) { return __builtin_amdgcn_rcpf(x); }
__device__ __forceinline__ float fast_rsq(float x) { return __builtin_amdgcn_rsqf(x); }
__device__ __forceinline__ float sigmoidf_(float x) { return fast_rcp(1.0f + fast_exp2(-x * LOG2E)); }
__device__ __forceinline__ float wave_sum(float v) {
#pragma unroll
    for (int o = 1; o < 64; o <<= 1) v += __shfl_xor(v, o);
    return v;
}
__device__ __forceinline__ float wave_max(float v) {
#pragma unroll
    for (int o = 1; o < 64; o <<= 1) v = fmaxf(v, __shfl_xor(v, o));
    return v;
}

struct Args { const float* in[25]; float* out; unsigned char* ws; int ph_lo, ph_hi; };

struct Ctx {
    LAS unsigned char* lds; unsigned char* lds_g;
    int tid, lane, wave, G, vcu, xcd, slot;
};

namespace pg8 {
constexpr int BM = 256, BK = 64, HALF = 128, HTB = HALF * BK * 2, STAGE_BYTES = 8 * HTB;
__host__ __device__ __forceinline__ int lds_byte(int r, int c) { const int st = (r >> 4) * 2 + (c >> 5), rr = r & 15, cc = c & 31, ob = rr * 64 + cc * 2; return st * 1024 + (ob ^ (((ob >> 9) & 1) << 5)); }
__host__ __device__ __forceinline__ void stage_rc(int b, int& R, int& C) { const int st = b / 1024, sb = b % 1024, swz = sb ^ (((sb >> 9) & 1) << 5); R = (st >> 1) * 16 + swz / 64; C = (st & 1) * 32 + (swz % 64) / 2; }
__host__ __device__ __forceinline__ int perm32(int rho) { const int n = rho >> 4, i = rho & 15; return 8 * (i >> 2) + 4 * n + (i & 3); }
struct Unit { int pm, pn, aux; };
struct Gemm { int K, lda, ldb; };

#define ACC_ZERO() do { _Pragma("unroll") for (int a_ = 0; a_ < 2; ++a_) _Pragma("unroll") for (int b_ = 0; b_ < 2; ++b_) _Pragma("unroll") for (int m_ = 0; m_ < 4; ++m_) _Pragma("unroll") for (int n_ = 0; n_ < 2; ++n_) acc[a_][b_][m_][n_] = (f32x4){0.f, 0.f, 0.f, 0.f}; } while (0)

#if MK_SLOWK
template <class Epi, class Sched>
__device__ __forceinline__ void gemm_phase(LAS unsigned char* lds, const Gemm g, const Sched& S, const Epi& E) {
    const int tid = threadIdx.x, wid = __builtin_amdgcn_readfirstlane(tid >> 6), lane = tid & 63, wr = wid >> 2, wc = wid & 3, fr = lane & 15, fq = lane >> 4;
    f32x4 acc[2][2][4][2];
    ACC_ZERO();
    Unit cur;
    for (int ui = 0; S.next(ui, cur); ++ui) {
        const char* cA = S.a_ptr(cur); const char* cB = S.b_ptr(cur);
        for (int k0 = 0; k0 < g.K; k0 += 32) {
            bf16x8 At[2][4], Bt[2][2];
#pragma unroll
            for (int ai = 0; ai < 2; ++ai)
#pragma unroll
                for (int m = 0; m < 4; ++m) At[ai][m] = *(const bf16x8*)(cA + ((size_t)(128 * ai + 64 * wr + 16 * m + fr) * g.lda + k0 + 8 * fq) * 2);
#pragma unroll
            for (int bj = 0; bj < 2; ++bj)
#pragma unroll
                for (int n = 0; n < 2; ++n) { const int sl = 16 * n + fr; const int row = 128 * bj + 32 * wc + (Epi::PERM ? perm32(sl) : sl);
                    Bt[bj][n] = *(const bf16x8*)(cB + ((size_t)row * g.ldb + k0 + 8 * fq) * 2); }
#pragma unroll
            for (int ai = 0; ai < 2; ++ai)
#pragma unroll
                for (int bj = 0; bj < 2; ++bj)
#pragma unroll
                    for (int m = 0; m < 4; ++m)
#pragma unroll
                        for (int n = 0; n < 2; ++n) acc[ai][bj][m][n] = __builtin_amdgcn_mfma_f32_16x16x32_bf16(Bt[bj][n], At[ai][m], acc[ai][bj][m][n], 0, 0, 0);
        }
        E(acc, cur, wr, wc, fr, fq);
        if (!E.keep(cur)) ACC_ZERO();
    }
}
#else
template <class Epi, class Sched>
__device__ __forceinline__ void gemm_phase(LAS unsigned char* lds, const Gemm g, const Sched& S, const Epi& E) {
    constexpr bool ALIGN_EPI = true;
    int tid_ = threadIdx.x; asm volatile("" : "+v"(tid_));
    const int tid = tid_, wid = __builtin_amdgcn_readfirstlane(tid >> 6), lane = tid & 63, wr = wid >> 2, wc = wid & 3, fr = lane & 15, fq = lane >> 4;
    const int K = g.K, nt = K / BK;
    unsigned voffA[2], voffB[2];
#pragma unroll
    for (int i = 0; i < 2; ++i) { int R, C; stage_rc(tid * 16 + i * 8192, R, C); const int Rb = Epi::PERM ? ((R & ~31) + perm32(R & 31)) : R;
        voffA[i] = (unsigned)(R * g.lda + C) * 2u; voffB[i] = (unsigned)(Rb * g.ldb + C) * 2u; }
    const size_t kstep = (size_t)(BK * 2);
    const size_t hstepA = (size_t)HALF * g.lda * 2, hstepB = (size_t)HALF * g.ldb * 2;
    const unsigned ldsw = (unsigned)wid * 1024u;
    const int aoff = lds_byte(wr * 64 + fr, fq * 8), boff = lds_byte(wc * 32 + fr, fq * 8);
#define PG8_SA(b, h) (((b) * 2 + (h)) * HTB)
#define PG8_SB(b, h) ((4 + (b) * 2 + (h)) * HTB)
#define PG8_STAGE(bufoff, gbase, voff) do { _Pragma("unroll") for (int _i = 0; _i < 2; ++_i) \
        __builtin_amdgcn_global_load_lds((const unsigned*)((const char*)(gbase) + (voff)[_i]), (LAS unsigned*)(lds + (bufoff) + ldsw + _i * 8192), 16, 0, 0); } while (0)
#define PG8_LDA(dst, b, h) do { _Pragma("unroll") for (int m = 0; m < 4; ++m) _Pragma("unroll") for (int k = 0; k < 2; ++k) dst[m][k] = *(const LAS bf16x8*)(lds + PG8_SA(b, h) + aoff + m * 2048 + k * 1024); } while (0)
#define PG8_LDB(dst, b, h) do { _Pragma("unroll") for (int n = 0; n < 2; ++n) _Pragma("unroll") for (int k = 0; k < 2; ++k) dst[n][k] = *(const LAS bf16x8*)(lds + PG8_SB(b, h) + boff + n * 2048 + k * 1024); } while (0)
#define PG8_MMA(ai, bj, At, Bt) do { __builtin_amdgcn_s_setprio(1); _Pragma("unroll") for (int m = 0; m < 4; ++m) _Pragma("unroll") for (int n = 0; n < 2; ++n) _Pragma("unroll") for (int k = 0; k < 2; ++k) \
        acc[ai][bj][m][n] = __builtin_amdgcn_mfma_f32_16x16x32_bf16(Bt[n][k], At[m][k], acc[ai][bj][m][n], 0, 0, 0); __builtin_amdgcn_s_setprio(0); } while (0)
#define PG8_WAIT_V(n) asm volatile("s_waitcnt vmcnt(" #n ")" ::: "memory")
#define PG8_WAIT_L(n) asm volatile("s_waitcnt lgkmcnt(" #n ")" ::: "memory")
#define PG8_BAR __builtin_amdgcn_s_barrier()
#define PG8_SCHED __builtin_amdgcn_sched_barrier(0)
    Unit cur, nxt; int ui = 0;
    if (!S.next(0, cur)) return;
    f32x4 acc[2][2][4][2];
    ACC_ZERO();
    bf16x8 At[4][2], B0[2][2], B1[2][2];
    const char* cA = S.a_ptr(cur); const char* cB = S.b_ptr(cur);
    PG8_STAGE(PG8_SB(0, 0), cB, voffB); PG8_STAGE(PG8_SB(0, 1), cB + hstepB, voffB); PG8_STAGE(PG8_SA(0, 0), cA, voffA); PG8_STAGE(PG8_SA(0, 1), cA + hstepA, voffA);
    if (wr == 1) PG8_BAR;
    PG8_WAIT_V(2); PG8_BAR;
    PG8_STAGE(PG8_SB(1, 0), cB + kstep, voffB); PG8_STAGE(PG8_SA(1, 0), cA + kstep, voffA); PG8_STAGE(PG8_SB(1, 1), cB + hstepB + kstep, voffB);
    PG8_WAIT_V(6); PG8_BAR;
    for (;;) {
        const bool has_next = S.next(ui + 1, nxt);
        const char* nA = has_next ? S.a_ptr(nxt) : cA; const char* nB = has_next ? S.b_ptr(nxt) : cB;
        for (int t = 0; t < nt; t += 2) {
            const bool last = (t == nt - 2);
            const char* a1 = cA + (size_t)(t + 1) * kstep;
            const char* a2 = last ? nA : cA + (size_t)(t + 2) * kstep; const char* b2 = last ? nB : cB + (size_t)(t + 2) * kstep;
            const char* a3 = a2 + kstep; const char* b3 = b2 + kstep;
            PG8_LDB(B0, 0, 0); PG8_LDB(B1, 0, 1); PG8_SCHED; PG8_LDA(At, 0, 0); PG8_STAGE(PG8_SA(1, 1), a1 + hstepA, voffA);
            PG8_WAIT_V(8); PG8_WAIT_L(0); PG8_BAR; PG8_MMA(0, 0, At, B0); PG8_MMA(0, 1, At, B1); PG8_BAR; PG8_SCHED;
            PG8_LDA(At, 0, 1); PG8_STAGE(PG8_SB(0, 0), b2, voffB); PG8_STAGE(PG8_SB(0, 1), b2 + hstepB, voffB); PG8_STAGE(PG8_SA(0, 0), a2, voffA);
            PG8_WAIT_V(8); PG8_WAIT_L(0); PG8_BAR; PG8_MMA(1, 0, At, B0); PG8_MMA(1, 1, At, B1); PG8_BAR; PG8_SCHED;
            PG8_LDB(B0, 1, 0); PG8_LDB(B1, 1, 1); PG8_SCHED; PG8_LDA(At, 1, 0); PG8_STAGE(PG8_SA(0, 1), a2 + hstepA, voffA);
            PG8_WAIT_V(8); PG8_WAIT_L(0); PG8_BAR; PG8_MMA(0, 0, At, B0); PG8_MMA(0, 1, At, B1); PG8_BAR; PG8_SCHED;
            PG8_LDA(At, 1, 1); PG8_STAGE(PG8_SB(1, 0), b3, voffB); PG8_STAGE(PG8_SB(1, 1), b3 + hstepB, voffB); PG8_STAGE(PG8_SA(1, 0), a3, voffA);
            PG8_WAIT_V(8); PG8_WAIT_L(0); PG8_BAR; PG8_MMA(1, 0, At, B0); PG8_MMA(1, 1, At, B1); PG8_BAR; PG8_SCHED;
        }
        if constexpr (ALIGN_EPI) { if (wr == 0) PG8_BAR; }
        E(acc, cur, wr, wc, fr, fq);
#ifdef MK_EPI_DRAIN
        PG8_WAIT_V(0);
#endif
        if (!has_next) break;
        if (!E.keep(cur)) ACC_ZERO();
        cur = nxt; cA = nA; cB = nB; ++ui;
        if constexpr (ALIGN_EPI) { if (wr == 1) PG8_BAR; }
    }
    PG8_WAIT_V(0);
    if constexpr (!ALIGN_EPI) { if (wr == 0) PG8_BAR; }
    PG8_BAR;
#undef PG8_SA
#undef PG8_SB
#undef PG8_STAGE
#undef PG8_LDA
#undef PG8_LDB
#undef PG8_MMA
#undef PG8_WAIT_V
#undef PG8_WAIT_L
#undef PG8_BAR
#undef PG8_SCHED
}
#endif
}
using pg8::Unit;

__device__ __forceinline__ void static_order(int L, int nM, int nN, int& pm, int& pn) {
    const int nwg = nM * nN; int wgid = L;
    { const int q = nwg / 8, r = nwg % 8, xcd = wgid % 8, off = wgid / 8; wgid = (xcd < r ? xcd * (q + 1) : r * (q + 1) + (xcd - r) * q) + off; }
    const int nig = 8 * nN, gid = wgid / nig, fm = gid * 8, gsz = (nM - fm) < 8 ? (nM - fm) : 8;
    pm = fm + ((wgid % nig) % gsz); pn = (wgid % nig) / gsz;
}
__device__ __forceinline__ u32x4 pack8(f32x4 a, f32x4 b) { u32x4 w; w.x = cvt_pk_bf16(a[0], a[1]); w.y = cvt_pk_bf16(a[2], a[3]); w.z = cvt_pk_bf16(b[0], b[1]); w.w = cvt_pk_bf16(b[2], b[3]); return w; }
__device__ __forceinline__ void rope4(f32x4& x1, f32x4& x2, f32x4 c, f32x4 s) { const f32x4 o1 = x1 * c - x2 * s, o2 = x2 * c + x1 * s; x1 = o1; x2 = o2; }
__device__ __forceinline__ float sq4(f32x4 v) { return (v[0] * v[0] + v[1] * v[1]) + (v[2] * v[2] + v[3] * v[3]); }

struct Sched1 {
    int G, c; const char* A1; const char* WIN;
    __device__ __forceinline__ bool next(int i, Unit& u) const {
        int L = i * G + c; u.aux = 0;
        if (L < 2048) { int pm, pn; static_order(L, 128, 16, pm, pn); u.pm = pm + 4; u.pn = pn; return true; }
        L -= 2048; if (L >= 20) return false;
        u.pm = L / 5; const int j = L % 5; u.pn = (j == 0) ? 1 : (3 + j); return true;
    }
    __device__ __forceinline__ const char* a_ptr(const Unit& u) const { return A1 + (size_t)u.pm * 256 * 1024 * 2; }
    __device__ __forceinline__ const char* b_ptr(const Unit& u) const { return WIN + (size_t)u.pn * 256 * 1024 * 2; }
};
struct Epi1 {
    static constexpr bool PERM = true;
    bf16_t* P0B; float* SSQ; bf16_t* KR; bf16_t* QD; bf16_t* KD; bf16_t* VD; bf16_t* GT; const float* rope;
    __device__ __forceinline__ bool keep(const Unit&) const { return false; }
    __device__ __forceinline__ void operator()(f32x4 (&acc)[2][2][4][2], const Unit& u, int wr, int wc, int fr, int fq) const {
        asm volatile("" : "+v"(fr), "+v"(fq));
        const bool isctx = u.pm < 4; int b, tbase;
        if (isctx) { b = u.pm; tbase = 0; } else { const int lt = u.pm - 4; b = lt >> 5; tbase = (lt & 31) * 256; }
        const int pn = u.pn;
        const float* cosD = rope; const float* sinD = rope + 2048; const float* cosM = rope + 4096; const float* sinM = rope + 5120;
        const int lr0 = 64 * wr + fr, cw = 32 * wc + 8 * fq;
#define E1_ROWS(...) _Pragma("unroll") for (int ai = 0; ai < 2; ++ai) _Pragma("unroll") for (int m = 0; m < 4; ++m) { const int lr = 128 * ai + 16 * m + lr0; const int t = tbase + lr; __VA_ARGS__ asm volatile("" ::: "memory"); }
        if (pn == 0) {
            bf16_t* P = P0B + (size_t)u.pm * 256 * 512 + cw; float* SQ = SSQ + (size_t)u.pm * 256 * 8 + wc;
            E1_ROWS({ (void)t; float ss = 0.f;
                _Pragma("unroll") for (int bj = 0; bj < 2; ++bj) { const f32x4 v0 = acc[ai][bj][m][0], v1 = acc[ai][bj][m][1]; ss += sq4(v0) + sq4(v1); *(u32x4*)(P + lr * 512 + 128 * bj) = pack8(v0, v1); }
                ss += __shfl_xor(ss, 16); ss += __shfl_xor(ss, 32); if (fq == 0) SQ[lr * 8] = ss; })
        } else if (pn == 1) {
            bf16_t* P = P0B + (size_t)u.pm * 256 * 512 + 256 + cw; float* SQ = SSQ + (size_t)u.pm * 256 * 8 + 4 + wc; bf16_t* KRb = KR + (size_t)b * SK * 32 + 8 * fq;
            const int axis = fq >> 1, sub = fq & 1;
            E1_ROWS({ const f32x4 v0 = acc[ai][0][m][0], v1 = acc[ai][0][m][1]; float ss = sq4(v0) + sq4(v1);
                *(u32x4*)(P + lr * 512) = pack8(v0, v1);
                ss += __shfl_xor(ss, 16); ss += __shfl_xor(ss, 32); if (fq == 0) SQ[lr * 8] = ss;
                f32x4 w0 = acc[ai][1][m][0], w1 = acc[ai][1][m][1];
                *(u32x4*)(P + lr * 512 + 128) = pack8(w0, w1);
                if (wc == 0) { const int kidx = isctx ? lr : 256 + t;
                    if (!isctx) { const int pos = axis ? (t & 63) : (t >> 6); const f32x4 c = *(const f32x4*)(cosM + pos * 8 + 4 * sub), s = *(const f32x4*)(sinM + pos * 8 + 4 * sub); rope4(w0, w1, c, s); }
                    *(u32x4*)(KRb + kidx * 32) = pack8(w0, w1); } })
        } else if (pn < 6) {
            const bool isq = pn < 4; const int h0 = 2 * (isq ? pn - 2 : pn - 4); const int axis = wc & 1;
            bf16_t* Qb = QD + (size_t)(b * 4 + h0) * SEQ * 128 + cw; bf16_t* Kb = KD + (size_t)(b * 4 + h0) * SK * 128 + cw;
            E1_ROWS({ const int kidx = isctx ? lr : 256 + t; const int pos = axis ? (t & 63) : (t >> 6);
                f32x4 c = {1.f, 1.f, 1.f, 1.f}, s = {0.f, 0.f, 0.f, 0.f};
                if (!isctx) { c = *(const f32x4*)(cosD + pos * 16 + 4 * fq); s = *(const f32x4*)(sinD + pos * 16 + 4 * fq); }
                _Pragma("unroll") for (int bj = 0; bj < 2; ++bj) { f32x4 v0 = acc[ai][bj][m][0], v1 = acc[ai][bj][m][1]; rope4(v0, v1, c, s);
                    if (isq) { v0 = v0 * DIFF_QS; v1 = v1 * DIFF_QS; *(u32x4*)(Qb + (bj * SEQ + t) * 128) = pack8(v0, v1); }
                    else *(u32x4*)(Kb + (bj * SK + kidx) * 128) = pack8(v0, v1); } })
        } else if (pn < 8) {
            bf16_t* Vb = VD + (size_t)(b * 4 + 2 * (pn - 6)) * SK * 128 + cw;
            E1_ROWS({ const int kidx = isctx ? lr : 256 + t;
                _Pragma("unroll") for (int bj = 0; bj < 2; ++bj) *(u32x4*)(Vb + (bj * SK + kidx) * 128) = pack8(acc[ai][bj][m][0], acc[ai][bj][m][1]); })
        } else {
            bf16_t* Gb = GT + (size_t)(u.pm - 4) * 256 * 2048 + (pn - 8) * 256 + cw;
            E1_ROWS({ (void)t;
                _Pragma("unroll") for (int bj = 0; bj < 2; ++bj) { f32x4 v0 = acc[ai][bj][m][0], v1 = acc[ai][bj][m][1];
                    #ifndef DBG_RAW_GATES
                    _Pragma("unroll") for (int j = 0; j < 4; ++j) { v0[j] = sigmoidf_(v0[j]); v1[j] = sigmoidf_(v1[j]); }
#endif

                    *(u32x4*)(Gb + lr * 2048 + 128 * bj) = pack8(v0, v1); } })
        }
#undef E1_ROWS
    }
};

struct SchedUQ {
    int G, c; const char* P0B; const char* WUQ;
    __device__ __forceinline__ bool next(int i, Unit& u) const { const int L = i * G + c; if (L >= 384) return false; u.pn = L % 3; u.pm = L / 3; u.aux = 0; return true; }
    __device__ __forceinline__ const char* a_ptr(const Unit& u) const { return P0B + ((size_t)(NCTX + 256 * u.pm) * 512) * 2; }
    __device__ __forceinline__ const char* b_ptr(const Unit& u) const { return WUQ + (size_t)u.pn * 256 * 256 * 2; }
};
struct EpiUQ {
    static constexpr bool PERM = true;
    const float* SSQ; bf16_t* QM; const float* rope;
    __device__ __forceinline__ bool keep(const Unit&) const { return false; }
    __device__ __forceinline__ void operator()(f32x4 (&acc)[2][2][4][2], const Unit& u, int wr, int wc, int fr, int fq) const {
        asm volatile("" : "+v"(fr), "+v"(fq));
        const int b = u.pm >> 5, tbase = (u.pm & 31) * 256; const float* cosM = rope + 4096; const float* sinM = rope + 5120;
        const float* SQ = SSQ + (size_t)(NCTX + u.pm * 256) * 8; bf16_t* Qb = QM + (size_t)b * 8 * SEQ * 96;
        int hh[2], dd[2];
#pragma unroll
        for (int bj = 0; bj < 2; ++bj) { const int c = 256 * u.pn + 128 * bj + 32 * wc + 8 * fq; hh[bj] = c / 96; dd[bj] = c - 96 * hh[bj]; }
#pragma unroll
        for (int ai = 0; ai < 2; ++ai)
#pragma unroll
            for (int m = 0; m < 4; ++m) {
                const int lr = 128 * ai + 64 * wr + 16 * m + fr; const int t = tbase + lr;
                const f32x4 sq = *(const f32x4*)(SQ + lr * 8);
                const float rs = fast_rsq(((sq[0] + sq[1]) + (sq[2] + sq[3])) * (1.0f / 256.0f) + EPS);
#pragma unroll
                for (int bj = 0; bj < 2; ++bj) { const int h = hh[bj], d = dd[bj];
                    f32x4 v0 = acc[ai][bj][m][0] * rs, v1 = acc[ai][bj][m][1] * rs;
                    if (d >= 64) { const int g = (d - 64) >> 3, axis = g >> 1, sub = g & 1; const int pos = axis ? (t & 63) : (t >> 6);
                        const f32x4 cc = *(const f32x4*)(cosM + pos * 8 + 4 * sub), ss = *(const f32x4*)(sinM + pos * 8 + 4 * sub); rope4(v0, v1, cc, ss); }
                    v0 = v0 * MLA_QS; v1 = v1 * MLA_QS;
                    *(u32x4*)(Qb + (h * SEQ + t) * 96 + d) = pack8(v0, v1); }
                asm volatile("" ::: "memory");
            }
    }
};
struct SchedUKV {
    int G, c; const char* P0B; const char* WUKV;
    __device__ __forceinline__ bool next(int i, Unit& u) const { const int L = i * G + c; if (L >= 528) return false; u.pn = L & 3; u.pm = L >> 2; u.aux = 0; return true; }
    __device__ __forceinline__ const char* a_ptr(const Unit& u) const { return P0B + ((size_t)(256 * u.pm) * 512 + 256) * 2; }
    __device__ __forceinline__ const char* b_ptr(const Unit& u) const { return WUKV + (size_t)u.pn * 256 * 256 * 2; }
};
struct EpiUKV {
    static constexpr bool PERM = true;
    const float* SSQ; const bf16_t* KR; bf16_t* KM; bf16_t* VM;
    __device__ __forceinline__ bool keep(const Unit&) const { return false; }
    __device__ __forceinline__ void operator()(f32x4 (&acc)[2][2][4][2], const Unit& u, int wr, int wc, int fr, int fq) const {
        asm volatile("" : "+v"(fr), "+v"(fq));
        const bool isctx = u.pm < 4; int b, tbase;
        if (isctx) { b = u.pm; tbase = 0; } else { const int lt = u.pm - 4; b = lt >> 5; tbase = 256 + (lt & 31) * 256; }
        const float* SQ = SSQ + (size_t)(u.pm * 256) * 8 + 4; const bf16_t* KRb = KR + (size_t)b * SK * 32 + 8 * fq;
        bf16_t* Kb = KM + (size_t)(b * 8 + 2 * u.pn) * SK * 96; bf16_t* Vb = VM + (size_t)(b * 8 + 2 * u.pn) * SK * 64;
#pragma unroll
        for (int ai = 0; ai < 2; ++ai)
#pragma unroll
            for (int m = 0; m < 4; ++m) {
                const int lr = 128 * ai + 64 * wr + 16 * m + fr; const int kidx = tbase + lr;
                const f32x4 sq = *(const f32x4*)(SQ + lr * 8);
                const float rs = fast_rsq(((sq[0] + sq[1]) + (sq[2] + sq[3])) * (1.0f / 128.0f) + EPS);
#pragma unroll
                for (int bj = 0; bj < 2; ++bj) { const int row = bj * SK + kidx;
                    const u32x4 w = pack8(acc[ai][bj][m][0] * rs, acc[ai][bj][m][1] * rs);
                    if (wc < 2) *(u32x4*)(Kb + row * 96 + 32 * wc + 8 * fq) = w; else *(u32x4*)(Vb + row * 64 + 32 * (wc - 2) + 8 * fq) = w;
                    if (wc == 0) *(u32x4*)(Kb + row * 96 + 64 + 8 * fq) = *(const u32x4*)(KRb + kidx * 32); }
                asm volatile("" ::: "memory");
            }
    }
};

struct SchedY {
    int G, c; const char* OA; const char* WOC;
    __device__ __forceinline__ bool next(int i, Unit& u) const { if (i >= 4) return false; const int T = (i >> 1) * G + c; if (T >= 512) return false;
        int pm, pn; static_order(T, 128, 4, pm, pn); u.pm = pm; u.pn = pn; u.aux = i & 1; return true; }
    __device__ __forceinline__ const char* a_ptr(const Unit& u) const { return OA + ((size_t)u.pm * 256 * 1024 + u.aux * 512) * 2; }
    __device__ __forceinline__ const char* b_ptr(const Unit& u) const { return WOC + ((size_t)u.pn * 256 * 1024 + u.aux * 512) * 2; }
};
struct EpiY {
    static constexpr bool PERM = true;
    const bf16_t* GT; bf16_t* Y;
    __device__ __forceinline__ bool keep(const Unit& u) const { return u.aux == 0; }
    __device__ __forceinline__ void operator()(f32x4 (&acc)[2][2][4][2], const Unit& u, int wr, int wc, int fr, int fq) const {
        asm volatile("" : "+v"(fr), "+v"(fq));
#pragma unroll
        for (int ai = 0; ai < 2; ++ai)
#pragma unroll
            for (int m = 0; m < 4; ++m) {
                const size_t rr = (size_t)u.pm * 256 + 128 * ai + 64 * wr + 16 * m + fr;
#pragma unroll
                for (int bj = 0; bj < 2; ++bj) { const int c = 256 * u.pn + 128 * bj + 32 * wc + 8 * fq;
                    const u32x4 gb = *(const u32x4*)(GT + rr * 2048 + 1024 + c);
                    f32x4 b0 = {bf_lo(gb.x), bf_hi(gb.x), bf_lo(gb.y), bf_hi(gb.y)}, b1 = {bf_lo(gb.z), bf_hi(gb.z), bf_lo(gb.w), bf_hi(gb.w)};
                    if (u.aux == 0) {
                        const u32x4 ga = *(const u32x4*)(GT + rr * 2048 + c);
                        const f32x4 a0 = {bf_lo(ga.x), bf_hi(ga.x), bf_lo(ga.y), bf_hi(ga.y)}, a1 = {bf_lo(ga.z), bf_hi(ga.z), bf_lo(ga.w), bf_hi(ga.w)};
#pragma unroll
                        for (int j = 0; j < 4; ++j) { acc[ai][bj][m][0][j] *= (b0[j] > 0.f ? a0[j] / b0[j] : 0.f); acc[ai][bj][m][1][j] *= (b1[j] > 0.f ? a1[j] / b1[j] : 0.f); }
                    } else {
                        *(u32x4*)(Y + rr * 1024 + c) = pack8(acc[ai][bj][m][0] * b0, acc[ai][bj][m][1] * b1);
                    } }
            }
    }
};

struct SchedZ {
    int G, c; const char* Y; const char* WOUT;
    __device__ __forceinline__ bool next(int i, Unit& u) const { const int L = i * G + c; if (L >= 512) return false; int pm, pn; static_order(L, 128, 4, pm, pn); u.pm = pm; u.pn = pn; u.aux = 0; return true; }
    __device__ __forceinline__ const char* a_ptr(const Unit& u) const { return Y + (size_t)u.pm * 256 * 1024 * 2; }
    __device__ __forceinline__ const char* b_ptr(const Unit& u) const { return WOUT + (size_t)u.pn * 256 * 1024 * 2; }
};
struct EpiZ {
    static constexpr bool PERM = false;
    const float* x; const float* mod; float* Z;
    __device__ __forceinline__ bool keep(const Unit&) const { return false; }
    __device__ __forceinline__ void operator()(f32x4 (&acc)[2][2][4][2], const Unit& u, int wr, int wc, int fr, int fq) const {
        asm volatile("" : "+v"(fr), "+v"(fq));
        const int b = u.pm >> 5; const float* g1 = mod + b * 6144 + 2048;
#pragma unroll
        for (int bj = 0; bj < 2; ++bj)
#pragma unroll
            for (int n = 0; n < 2; ++n) { const int c = 256 * u.pn + 128 * bj + 32 * wc + 16 * n + 4 * fq; const f32x4 gv = *(const f32x4*)(g1 + c);
#pragma unroll
                for (int ai = 0; ai < 2; ++ai)
#pragma unroll
                    for (int m = 0; m < 4; ++m) { const size_t rr = (size_t)u.pm * 256 + 128 * ai + 64 * wr + 16 * m + fr;
                        const f32x4 xv = *(const f32x4*)(x + rr * 1024 + c);
                        *(f32x4*)(Z + rr * 1024 + c) = xv * ALPHA + gv * acc[ai][bj][m][n]; } }
    }
};

struct SchedM1 {
    int xcd, slot; const char* XE; const char* W13;
    __device__ __forceinline__ bool next(int i, Unit& u) const { if (i >= 8) return false; const int e = 2 * xcd + (i >> 2), ap = (i & 3) * 4 + (slot >> 3);
        u.pn = slot & 7; u.pm = ((ap >> 2) * 16 + e) * 4 + (ap & 3); u.aux = e; return true; }
    __device__ __forceinline__ const char* a_ptr(const Unit& u) const { return XE + (size_t)u.pm * 256 * 1024 * 2; }
    __device__ __forceinline__ const char* b_ptr(const Unit& u) const { return W13 + ((size_t)u.aux * 2048 + u.pn * 256) * 1024 * 2; }
};
struct EpiM1 {
    static constexpr bool PERM = true;
    bf16_t* HID;
    __device__ __forceinline__ bool keep(const Unit&) const { return false; }
    __device__ __forceinline__ void operator()(f32x4 (&acc)[2][2][4][2], const Unit& u, int wr, int wc, int fr, int fq) const {
        asm volatile("" : "+v"(fr), "+v"(fq));
#pragma unroll
        for (int ai = 0; ai < 2; ++ai)
#pragma unroll
            for (int m = 0; m < 4; ++m) { const size_t row = (size_t)u.pm * 256 + 128 * ai + 64 * wr + 16 * m + fr;
                f32x4 h0, h1;
#pragma unroll
                for (int j = 0; j < 4; ++j) { const float a0 = acc[ai][0][m][0][j], a1 = acc[ai][0][m][1][j];
                    h0[j] = a0 * sigmoidf_(a0) * acc[ai][1][m][0][j]; h1[j] = a1 * sigmoidf_(a1) * acc[ai][1][m][1][j]; }
                *(u32x4*)(HID + row * 1024 + 128 * u.pn + 32 * wc + 8 * fq) = pack8(h0, h1); }
    }
};
struct SchedM2 {
    int xcd, slot; const char* HID; const char* W2T;
    __device__ __forceinline__ bool next(int i, Unit& u) const { if (i >= 4) return false; const int e = 2 * xcd + (i >> 1), ap = (i & 1) * 8 + (slot >> 2);
        u.pn = slot & 3; u.pm = ((ap >> 2) * 16 + e) * 4 + (ap & 3); u.aux = e; return true; }
    __device__ __forceinline__ const char* a_ptr(const Unit& u) const { return HID + (size_t)u.pm * 256 * 1024 * 2; }
    __device__ __forceinline__ const char* b_ptr(const Unit& u) const { return W2T + ((size_t)u.aux * 1024 + u.pn * 256) * 1024 * 2; }
};
struct EpiM2 {
    static constexpr bool PERM = true;
    const float* GSEL; bf16_t* YE;
    __device__ __forceinline__ bool keep(const Unit&) const { return false; }
    __device__ __forceinline__ void operator()(f32x4 (&acc)[2][2][4][2], const Unit& u, int wr, int wc, int fr, int fq) const {
        asm volatile("" : "+v"(fr), "+v"(fq));
#pragma unroll
        for (int ai = 0; ai < 2; ++ai)
#pragma unroll
            for (int m = 0; m < 4; ++m) { const size_t row = (size_t)u.pm * 256 + 128 * ai + 64 * wr + 16 * m + fr; const float g = GSEL[row];
#pragma unroll
                for (int bj = 0; bj < 2; ++bj)
                    *(u32x4*)(YE + row * 1024 + 256 * u.pn + 128 * bj + 32 * wc + 8 * fq) = pack8(acc[ai][bj][m][0] * g, acc[ai][bj][m][1] * g); }
    }
};

struct SchedU {
    SchedUQ q; SchedUKV kv; int G, c;
    __device__ __forceinline__ bool next(int i, Unit& u) const { const int L = i * G + c; if (L >= 912) return false;
        if (L < 384) { u.pn = L % 3; u.pm = L / 3; u.aux = 0; } else { const int L2 = L - 384; u.pn = L2 & 3; u.pm = L2 >> 2; u.aux = 1; } return true; }
    __device__ __forceinline__ const char* a_ptr(const Unit& u) const { return u.aux == 0 ? q.a_ptr(u) : kv.a_ptr(u); }
    __device__ __forceinline__ const char* b_ptr(const Unit& u) const { return u.aux == 0 ? q.b_ptr(u) : kv.b_ptr(u); }
};
struct EpiU {
    static constexpr bool PERM = true;
    EpiUQ q; EpiUKV kv;
    __device__ __forceinline__ bool keep(const Unit&) const { return false; }
    __device__ __forceinline__ void operator()(f32x4 (&acc)[2][2][4][2], const Unit& u, int wr, int wc, int fr, int fq) const {
        if (u.aux == 0) q(acc, u, wr, wc, fr, fq); else kv(acc, u, wr, wc, fr, fq);
    }
};
namespace fa {
#define KSWZ(row, colB) ((row) * 256 + ((colB) ^ (((row) & 7) << 4)))
#define SBAR() __builtin_amdgcn_sched_barrier(0)
__device__ __forceinline__ int crow(int r, int hi) { return (r & 3) + 8 * (r >> 2) + 4 * hi; }
constexpr float THRL = 11.0f;
constexpr int VOFF = 0, KOFF = 32768, BUFB = 16384, WSOFF = 131072;

__device__ __forceinline__ void partialSM(f32x16& p0, f32x16& p1, float& m_reg, float& alpha) {
    float pmax = p0[0];
#pragma unroll
    for (int r = 1; r < 16; ++r) pmax = fmaxf(pmax, p0[r]);
#pragma unroll
    for (int r = 0; r < 16; ++r) pmax = fmaxf(pmax, p1[r]);
    { auto rr = __builtin_amdgcn_permlane32_swap(__float_as_uint(pmax), __float_as_uint(pmax), false, false);
      pmax = fmaxf(__uint_as_float(rr[0]), __uint_as_float(rr[1])); }
    float mn;
    if (__builtin_expect(__all(pmax - m_reg <= THRL), 1)) { mn = m_reg; alpha = 1.f; }
    else { mn = fmaxf(m_reg, pmax); alpha = fast_exp2(m_reg - mn); m_reg = mn; }
#pragma unroll
    for (int r = 0; r < 16; ++r) { p0[r] -= mn; p1[r] -= mn; }
#pragma unroll
    for (int r = 0; r < 16; ++r) p0[r] = fast_exp2(p0[r]);
}
__device__ __forceinline__ void finishSM(f32x16& p0, f32x16& p1, float alpha, float& l_reg, bf16x8& pa0, bf16x8& pa1, bf16x8& pa2, bf16x8& pa3) {
#pragma unroll
    for (int r = 0; r < 16; ++r) p1[r] = fast_exp2(p1[r]);
    float ps = 0.f;
#pragma unroll
    for (int r = 0; r < 16; ++r) ps += p0[r];
#pragma unroll
    for (int r = 0; r < 16; ++r) ps += p1[r];
    { auto rr = __builtin_amdgcn_permlane32_swap(__float_as_uint(ps), __float_as_uint(ps), false, false);
      ps = __uint_as_float(rr[0]) + __uint_as_float(rr[1]); }
    l_reg = l_reg * alpha + ps;
#define PK4(P, BASE, OUT) do { unsigned a0 = cvt_pk_bf16(P[BASE + 0], P[BASE + 1]), a1 = cvt_pk_bf16(P[BASE + 2], P[BASE + 3]);   \
    unsigned b0 = cvt_pk_bf16(P[BASE + 4], P[BASE + 5]), b1 = cvt_pk_bf16(P[BASE + 6], P[BASE + 7]);                              \
    auto r0 = __builtin_amdgcn_permlane32_swap(a0, b0, false, false); auto r1 = __builtin_amdgcn_permlane32_swap(a1, b1, false, false); \
    u32x4 w = {r0[0], r1[0], r0[1], r1[1]}; OUT = __builtin_bit_cast(bf16x8, w); } while (0)
    PK4(p0, 0, pa0); PK4(p0, 8, pa1); PK4(p1, 0, pa2); PK4(p1, 8, pa3);
#undef PK4
}
template <int NQ>
__device__ __forceinline__ void qkt(f32x16& p0, f32x16& p1, const LAS unsigned char* Ks, const bf16x8* qr, int r32, int hi, int kcolB) {
    p0 = f32x16{}; p1 = f32x16{};
#pragma unroll
    for (int d0 = 0; d0 < NQ; ++d0) { const int cb = kcolB + (d0 * 16 + hi * 8) * 2;
        const bf16x8 b0 = *(const LAS bf16x8*)(Ks + KSWZ(r32, cb));
        const bf16x8 b1 = *(const LAS bf16x8*)(Ks + KSWZ(32 + r32, cb));
        p0 = __builtin_amdgcn_mfma_f32_32x32x16_bf16(b0, qr[d0], p0, 0, 0, 0);
        p1 = __builtin_amdgcn_mfma_f32_32x32x16_bf16(b1, qr[d0], p1, 0, 0, 0); }
}
template <int NCB> __device__ __forceinline__ int v_st(int k, int c) { const int kk = (k & ~0xC) | ((k & 4) << 1) | ((k & 8) >> 1); return ((kk >> 3) * NCB + (c >> 5)) * 512 + ((kk & 7) * 32 + (c & 31)) * 2; }
__device__ __forceinline__ int v_rd_base(int lane) { return ((lane & 3) << 3) | (((lane >> 2) & 3) << 6) | (((lane >> 4) & 1) << 5) | (((lane >> 5) & 1) << 8); }
template <int OFF> __device__ __forceinline__ s16x4 tr_read(int vb) {
    s16x4 r; asm volatile("ds_read_b64_tr_b16 %0, %1 offset:%2" : "=&v"(r) : "v"(vb), "i"(OFF) : "memory"); return r;
}
template <int NCB, int D0> __device__ __forceinline__ void pv_one(f32x16& od, int vb, bf16x8 pa0, bf16x8 pa1, bf16x8 pa2, bf16x8 pa3) {
#define VO(ks, half) (D0 * 512 + (ks) * (1024 * NCB) + (half) * (512 * NCB))
    const s16x4 l0 = tr_read<VO(0, 0)>(vb), h0 = tr_read<VO(0, 1)>(vb), l1 = tr_read<VO(1, 0)>(vb), h1 = tr_read<VO(1, 1)>(vb);
    const s16x4 l2 = tr_read<VO(2, 0)>(vb), h2 = tr_read<VO(2, 1)>(vb), l3 = tr_read<VO(3, 0)>(vb), h3 = tr_read<VO(3, 1)>(vb);
#undef VO
    asm volatile("s_waitcnt lgkmcnt(0)" ::: "memory"); SBAR();
#define PK(L, H) (bf16x8){L[0], L[1], L[2], L[3], H[0], H[1], H[2], H[3]}
    od = __builtin_amdgcn_mfma_f32_32x32x16_bf16(pa0, PK(l0, h0), od, 0, 0, 0);
    od = __builtin_amdgcn_mfma_f32_32x32x16_bf16(pa1, PK(l1, h1), od, 0, 0, 0);
    od = __builtin_amdgcn_mfma_f32_32x32x16_bf16(pa2, PK(l2, h2), od, 0, 0, 0);
    od = __builtin_amdgcn_mfma_f32_32x32x16_bf16(pa3, PK(l3, h3), od, 0, 0, 0);
#undef PK
}
template <int NCB> __device__ __forceinline__ void pv_all(f32x16* o, int vb, bf16x8 pa0, bf16x8 pa1, bf16x8 pa2, bf16x8 pa3) {
    pv_one<NCB, 0>(o[0], vb, pa0, pa1, pa2, pa3); pv_one<NCB, 1>(o[1], vb, pa0, pa1, pa2, pa3);
    if constexpr (NCB == 4) { pv_one<NCB, 2>(o[2], vb, pa0, pa1, pa2, pa3); pv_one<NCB, 3>(o[3], vb, pa0, pa1, pa2, pa3); }
}

template <int MODE>
__device__ __forceinline__ void attn_unit(LAS unsigned char* lds, const bf16_t* __restrict__ Qu, const bf16_t* __restrict__ Kh, const bf16_t* __restrict__ Vh, bf16_t* Ou,
                                          float lam, const float* __restrict__ gsub) {
    constexpr int DQK = MODE ? 64 : 96, DV = MODE ? 128 : 64, LDQ = MODE ? 128 : 96, LDK = MODE ? 128 : 96, LDV = DV;
    constexpr int KCPR = LDK / 8, VCPR = LDV / 8, NKCH = 64 * KCPR, NCH = NKCH + 64 * VCPR, NLD = (NCH + 511) / 512, NCB = DV / 32, NQ = DQK / 16, NT = SK / 64;
    int tid_ = threadIdx.x; asm volatile("" : "+v"(tid_));
    const int tid = tid_, wid = __builtin_amdgcn_readfirstlane(tid >> 6), lane = tid & 63, r32 = lane & 31, hi = lane >> 5;
    const int mp = MODE ? (wid >> 2) : 0, qw = MODE ? (wid & 3) : wid;
    LAS float* ws = (LAS float*)(lds + WSOFF) + wid * 64; LAS float* li_l = ws; LAS float* al_l = ws + 32;
    float m_reg = -1e30f, l_reg = 0.f; f32x16 o[NCB]; bf16x8 qr[NQ];
#pragma unroll
    for (int d = 0; d < NCB; ++d) o[d] = f32x16{};
    { const bf16_t* Qw = Qu + (size_t)(qw * 32 + r32) * LDQ + mp * 64 + hi * 8;
#pragma unroll
      for (int d0 = 0; d0 < NQ; ++d0) qr[d0] = *(const bf16x8*)(Qw + d0 * 16); }
    const bf16_t* sp[NLD]; int tstep[NLD], dst[NLD];
#pragma unroll
    for (int i = 0; i < NLD; ++i) { int c = tid + 512 * i; if (c >= NCH) c -= NCH;
        if (c < NKCH) { const int row = c / KCPR, ch = c % KCPR; sp[i] = Kh + row * LDK + ch * 8; tstep[i] = 64 * LDK; dst[i] = KOFF + KSWZ(row, ch * 16); }
        else { const int c2 = c - NKCH; const int row = c2 / VCPR, ch = c2 % VCPR; sp[i] = Vh + row * LDV + ch * 8; tstep[i] = 64 * LDV; dst[i] = VOFF + v_st<NCB>(row, ch * 8); } }
    const int vb0 = (int)(uintptr_t)(lds + VOFF) + v_rd_base(lane);
    const int kcolB = mp * 128;
    bf16x8 sr_[2][NLD];
#define SLOAD(s, t) do { _Pragma("unroll") for (int i_ = 0; i_ < NLD; ++i_) sr_[s][i_] = *(const bf16x8*)(sp[i_] + (size_t)(t) * tstep[i_]); } while (0)
#define SWRITE(b, s) do { _Pragma("unroll") for (int i_ = 0; i_ < NLD; ++i_) *(LAS bf16x8*)(lds + (b) * BUFB + dst[i_]) = sr_[s][i_]; } while (0)
#define SWAIT() asm volatile("s_waitcnt vmcnt(%0)" :: "n"(NLD) : "memory")
#define RESC(a) do { if (__any((a) < 1.f)) { if (hi == 0) al_l[r32] = (a); asm volatile("s_waitcnt lgkmcnt(0)" ::: "memory"); \
    _Pragma("unroll") for (int d = 0; d < NCB; ++d) _Pragma("unroll") for (int r = 0; r < 16; ++r) o[d][r] *= al_l[crow(r, hi)]; } } while (0)
    f32x16 pA0, pA1, pB0, pB1; float alA, alB; bf16x8 pa0, pa1, pa2, pa3;
    __syncthreads();
    SLOAD(0, 0); asm volatile("s_waitcnt vmcnt(0)" ::: "memory"); SWRITE(0, 0); __syncthreads();
    qkt<NQ>(pA0, pA1, lds + KOFF, qr, r32, hi, kcolB); partialSM(pA0, pA1, m_reg, alA);
    SLOAD(1, 1); SLOAD(0, 2);
    SWAIT(); SWRITE(1, 1); __syncthreads();
    for (int j = 1; j + 1 < NT; j += 2) {
        SBAR(); qkt<NQ>(pB0, pB1, lds + KOFF + BUFB, qr, r32, hi, kcolB);
        finishSM(pA0, pA1, alA, l_reg, pa0, pa1, pa2, pa3); SBAR();
        SLOAD(1, j + 2); SBAR();
        pv_all<NCB>(o, vb0, pa0, pa1, pa2, pa3); partialSM(pB0, pB1, m_reg, alB);
        __syncthreads(); SWAIT(); SWRITE(0, 0);
        RESC(alB); __syncthreads();
        SBAR(); qkt<NQ>(pA0, pA1, lds + KOFF, qr, r32, hi, kcolB);
        finishSM(pB0, pB1, alB, l_reg, pa0, pa1, pa2, pa3); SBAR();
        if (j + 3 < NT) SLOAD(0, j + 3); SBAR();
        pv_all<NCB>(o, vb0 + BUFB, pa0, pa1, pa2, pa3); partialSM(pA0, pA1, m_reg, alA);
        __syncthreads(); SWAIT(); SWRITE(1, 1);
        RESC(alA); __syncthreads();
    }
    SBAR(); qkt<NQ>(pB0, pB1, lds + KOFF + BUFB, qr, r32, hi, kcolB);
    finishSM(pA0, pA1, alA, l_reg, pa0, pa1, pa2, pa3); SBAR();
    pv_all<NCB>(o, vb0, pa0, pa1, pa2, pa3); partialSM(pB0, pB1, m_reg, alB);
    __syncthreads(); RESC(alB);
    finishSM(pB0, pB1, alB, l_reg, pa0, pa1, pa2, pa3); SBAR();
    pv_all<NCB>(o, vb0 + BUFB, pa0, pa1, pa2, pa3);
    if (hi == 0) li_l[r32] = l_reg; asm volatile("s_waitcnt lgkmcnt(0)" ::: "memory");
    float rli[16];
#pragma unroll
    for (int r = 0; r < 16; ++r) rli[r] = fast_rcp(li_l[crow(r, hi)]);
    if constexpr (MODE == 0) {
        bf16_t* Ow = Ou + (size_t)(wid * 32) * 1024;
#pragma unroll
        for (int r = 0; r < 16; ++r) { const int orow = crow(r, hi);
#pragma unroll
            for (int d0 = 0; d0 < NCB; ++d0) Ow[(size_t)orow * 1024 + d0 * 32 + r32] = (bf16_t)(cvt_pk_bf16(o[d0][r] * rli[r], 0.f) & 0xffffu); }
    } else {
        __syncthreads();
        LAS float* Ost = (LAS float*)lds;
#pragma unroll
        for (int r = 0; r < 16; ++r) { const int row = mp * 128 + qw * 32 + crow(r, hi);
#pragma unroll
            for (int d0 = 0; d0 < NCB; ++d0) Ost[row * 128 + d0 * 32 + r32] = o[d0][r] * rli[r]; }
        __syncthreads();
        const float g0 = gsub[2 * lane], g1 = gsub[2 * lane + 1];
#pragma unroll 4
        for (int k = 0; k < 16; ++k) { const int row = wid * 16 + k;
            const f32x2 a = *(const LAS f32x2*)(Ost + row * 128 + 2 * lane), b2 = *(const LAS f32x2*)(Ost + (128 + row) * 128 + 2 * lane);
            const float d0 = a.x - lam * b2.x, d1 = a.y - lam * b2.y;
            const float ss = wave_sum(d0 * d0 + d1 * d1);
            const float rs = (fast_rsq(ss * (1.0f / 128.0f) + EPS)) * (1.0f - LAMBDA_INIT);
            *(unsigned*)(Ou + (size_t)row * 1024 + 2 * lane) = cvt_pk_bf16(d0 * rs * g0, d1 * rs * g1); }
    }
#undef SLOAD
#undef SWRITE
#undef SWAIT
#undef RESC
}
#undef KSWZ
#undef SBAR
}

__device__ __forceinline__ void attn_phase(const Ctx& C, unsigned char* ws, const float* gsub) {
    const bf16_t* QM = (const bf16_t*)(ws + WS_QM); const bf16_t* KM = (const bf16_t*)(ws + WS_KM); const bf16_t* VM = (const bf16_t*)(ws + WS_VM);
    const bf16_t* QD = (const bf16_t*)(ws + WS_QD); const bf16_t* KD = (const bf16_t*)(ws + WS_KD); const bf16_t* VD = (const bf16_t*)(ws + WS_VD);
    bf16_t* OA = (bf16_t*)(ws + WS_OA);
    const float lam = *(const float*)(ws + WS_LAM);
    for (int r = 0; r < 4; ++r) {
        const int bh = C.xcd * 4 + r, b = bh >> 3, h = bh & 7, qb = C.slot;
        fa::attn_unit<0>(C.lds, QM + ((size_t)bh * SEQ + qb * 256) * 96, KM + (size_t)bh * SK * 96, VM + (size_t)bh * SK * 64,
                         OA + ((size_t)b * SEQ + qb * 256) * 1024 + h * 64, lam, gsub);
    }
    for (int r = 0; r < 4; ++r) {
        const int bh = C.xcd * 2 + (r >> 1), b = bh >> 2, h = bh & 3, qb = (r & 1) * 32 + C.slot;
        fa::attn_unit<1>(C.lds, QD + ((size_t)bh * SEQ + qb * 128) * 128, KD + (size_t)bh * SK * 128, VD + (size_t)bh * SK * 128,
                         OA + ((size_t)b * SEQ + qb * 128) * 1024 + 512 + h * 128, lam, gsub);
    }
    __syncthreads();
}

#if MK_NAIVE_ATTN
template <int MODE>
__global__ __launch_bounds__(256) void naive_attn(const bf16_t* __restrict__ Q, const bf16_t* __restrict__ K, const bf16_t* __restrict__ V, bf16_t* __restrict__ OA,
                                                  const float* __restrict__ lamp, const float* __restrict__ gsub) {
    constexpr int NH = MODE ? 4 : 8, DQK = MODE ? 64 : 96, LDQ = MODE ? 128 : 96, LDK = LDQ, DV = MODE ? 128 : 64, NMAP = MODE ? 2 : 1;
    const int lane = threadIdx.x & 63; const long gw = (long)blockIdx.x * 4 + (threadIdx.x >> 6);
    const int q = (int)(gw % SEQ); const int bh = (int)(gw / SEQ); const int b = bh / NH, h = bh % NH;
    const bf16_t* Qrow = Q + ((size_t)bh * SEQ + q) * LDQ; const bf16_t* Kh = K + (size_t)bh * SK * LDK; const bf16_t* Vh = V + (size_t)bh * SK * DV;
    float res0 = 0.f, res1 = 0.f; const float lam = *lamp;
    for (int mp = 0; mp < NMAP; ++mp) {
        u32x4 qp[DQK / 8];
#pragma unroll
        for (int i = 0; i < DQK / 8; ++i) qp[i] = *(const u32x4*)(Qrow + mp * 64 + 8 * i);
        float m = -1e30f, l = 0.f, acc0 = 0.f, acc1 = 0.f;
        for (int t = 0; t < SK / 64; ++t) {
            const bf16_t* kr = Kh + (size_t)(t * 64 + lane) * LDK + mp * 64; float s = 0.f;
#pragma unroll
            for (int i = 0; i < DQK / 8; ++i) { const u32x4 kv = *(const u32x4*)(kr + 8 * i);
                s += bf_lo(qp[i].x) * bf_lo(kv.x) + bf_hi(qp[i].x) * bf_hi(kv.x) + bf_lo(qp[i].y) * bf_lo(kv.y) + bf_hi(qp[i].y) * bf_hi(kv.y)
                   + bf_lo(qp[i].z) * bf_lo(kv.z) + bf_hi(qp[i].z) * bf_hi(kv.z) + bf_lo(qp[i].w) * bf_lo(kv.w) + bf_hi(qp[i].w) * bf_hi(kv.w); }
            const float mn = fmaxf(m, wave_max(s)); const float alpha = exp2f(m - mn); const float p = exp2f(s - mn);
            l = l * alpha + wave_sum(p); acc0 *= alpha; acc1 *= alpha; m = mn;
            for (int kk = 0; kk < 64; ++kk) { const float pk = __shfl(p, kk); const bf16_t* vr = Vh + (size_t)(t * 64 + kk) * DV;
                acc0 += pk * bf2f(vr[lane]); if (DV == 128) acc1 += pk * bf2f(vr[64 + lane]); }
        }
        const float il = 1.0f / l;
        if (mp == 0) { res0 = acc0 * il; res1 = acc1 * il; } else { res0 -= lam * acc0 * il; res1 -= lam * acc1 * il; }
    }
    if (MODE == 0) { OA[((size_t)b * SEQ + q) * 1024 + h * 64 + lane] = (bf16_t)(cvt_pk_bf16(res0, 0.f) & 0xffffu); }
    else { const float ss = wave_sum(res0 * res0 + res1 * res1); const float rs = (fast_rsq(ss * (1.0f / 128.0f) + EPS)) * (1.0f - LAMBDA_INIT);
        bf16_t* o = OA + ((size_t)b * SEQ + q) * 1024 + 512 + h * 128;
        o[lane] = (bf16_t)(cvt_pk_bf16(res0 * rs * gsub[lane], 0.f) & 0xffffu); o[64 + lane] = (bf16_t)(cvt_pk_bf16(res1 * rs * gsub[64 + lane], 0.f) & 0xffffu); }
}
#endif
__device__ __forceinline__ int invperm64(int d) { const int a = d >> 5, half = (d >> 4) & 1, i = d & 15; return (a * 4 + (i >> 2)) * 8 + half * 4 + (i & 3); }
__device__ __forceinline__ int invperm32(int d) { const int a = d >> 4, half = (d >> 3) & 1, i = d & 7; return (a * 2 + (i >> 2)) * 8 + half * 4 + (i & 3); }
struct MapWin { __device__ __forceinline__ int operator()(int n) const {
    if (n < 384) return n;
    if (n < 416) return 384 + invperm32(n - 384);
    if (n < 1440) { const int isk = n >= 928; const int rel = n - (isk ? 928 : 416); return (isk ? 1024 : 512) + (rel & ~63) + invperm64(rel & 63); }
    if (n < 1952) return 1536 + (n - 1440);
    return 2048 + (n - 1952); } };
struct MapUq { __device__ __forceinline__ int operator()(int n) const { const int h = n / 96, d = n - 96 * h; return d < 64 ? n : h * 96 + 64 + invperm32(d - 64); } };
struct MapId { int off; __device__ __forceinline__ int operator()(int n) const { return off + n; } };
struct MapW13 { int off; __device__ __forceinline__ int operator()(int f) const { return off + (f >> 7) * 256 + (f & 127); } };

template <class RM>
__device__ __forceinline__ void tr_item(const float* __restrict__ W, int ldw, int k0, int n0, bf16_t* WT, int ldt, int kdst0, const float* kscale, RM rm, LAS float* scr, int lane) {
#pragma unroll 8
    for (int i = 0; i < 32; ++i) { const int kk = 2 * i + (lane >> 5); float v = W[(size_t)(k0 + kk) * ldw + n0 + (lane & 31)]; if (kscale) v *= kscale[k0 + kk]; scr[kk * 33 + (lane & 31)] = v; }
    asm volatile("s_waitcnt lgkmcnt(0)" ::: "memory");
    const int c = lane & 7;
#pragma unroll
    for (int j = 0; j < 4; ++j) { const int n = (lane >> 3) + 8 * j; const LAS float* s = scr + (8 * c) * 33 + n;
        u32x4 o; o.x = cvt_pk_bf16(s[0 * 33], s[1 * 33]); o.y = cvt_pk_bf16(s[2 * 33], s[3 * 33]); o.z = cvt_pk_bf16(s[4 * 33], s[5 * 33]); o.w = cvt_pk_bf16(s[6 * 33], s[7 * 33]);
        *(u32x4*)(WT + (size_t)rm(n0 + n) * ldt + kdst0 + k0 + 8 * c) = o; }
    asm volatile("s_waitcnt lgkmcnt(0)" ::: "memory");
}

__device__ __forceinline__ void p0_prologue(const Ctx& C0, const Args& A) {
    Ctx C = C0; asm volatile("" : "+v"(C.lane), "+v"(C.tid));
    unsigned char* ws = A.ws;
    const float* cvec = A.in[1]; const float* cctx = A.in[3]; const float* w_ada = A.in[4]; const float* b_ada = A.in[5];
    if (C.vcu < 96) {
        const int col = C.vcu * 64 + C.lane; float acc[5] = {0.f, 0.f, 0.f, 0.f, 0.f};
        for (int k = C.wave * 128; k < C.wave * 128 + 128; ++k) { const float wv = w_ada[(size_t)k * 6144 + col];
#pragma unroll
            for (int r = 0; r < 5; ++r) { const float cv = (r < 4) ? cvec[r * 1024 + k] : cctx[k]; acc[r] += cv * sigmoidf_(cv) * wv; } }
        LAS float* red = (LAS float*)(C.lds + 73728);
#pragma unroll
        for (int r = 0; r < 5; ++r) red[(C.wave * 5 + r) * 64 + C.lane] = acc[r];
        __syncthreads();
        if (C.tid < 320) { const int r = C.tid >> 6, l = C.tid & 63; float s = 0.f;
#pragma unroll
            for (int w = 0; w < 8; ++w) s += red[(w * 5 + r) * 64 + l];
            ((float*)(ws + WS_MOD))[r * 6144 + C.vcu * 64 + l] = s + b_ada[C.vcu * 64 + l]; }
        __syncthreads();
    }
    if (C.vcu == C.G - 1) {
        float* rope = (float*)(ws + WS_ROPE);
        for (int i = C.tid; i < 2048; i += NTHR) { const int pos = i >> 4, f = i & 15; const float inv = exp2f(-(float)f * (13.287712379549449f / 16.0f)); const float ang = (float)pos * inv;
            rope[i] = cosf(ang); rope[2048 + i] = sinf(ang); }
        for (int i = C.tid; i < 1024; i += NTHR) { const int pos = i >> 3, f = i & 7; const float inv = exp2f(-(float)f * (13.287712379549449f / 8.0f)); const float ang = (float)pos * inv;
            rope[4096 + i] = cosf(ang); rope[5120 + i] = sinf(ang); }
        if (C.wave == 0) { const float* dl = A.in[12]; const float s1 = wave_sum(dl[C.lane] * dl[64 + C.lane]), s2 = wave_sum(dl[128 + C.lane] * dl[192 + C.lane]);
            if (C.lane == 0) *(float*)(ws + WS_LAM) = expf(s1) - expf(s2) + LAMBDA_INIT; }
    }
    LAS float* scr = (LAS float*)(C.lds + C.wave * 8448);
    const int gw = C.vcu * NWAVES + C.wave, NGW = C.G * NWAVES;
    constexpr int I_IN = 16 * 125, I_UQ = 4 * 24, I_UKV = 2 * 32, I_OM = 8 * 32, I_OD = 8 * 32, I_OUT = 16 * 32, I_E = 16 * 16 * 32;
    constexpr int NITEMS = I_IN + I_UQ + I_UKV + I_OM + I_OD + I_OUT + 3 * I_E;
    for (int it = gw; it < NITEMS; it += NGW) {
        int r = it;
        if (r < I_IN) { tr_item(A.in[6], NIN, 64 * (r / 125), 32 * (r % 125), (bf16_t*)(ws + WS_WIN), 1024, 0, nullptr, MapWin{}, scr, C.lane); continue; } r -= I_IN;
        if (r < I_UQ) { tr_item(A.in[8], 768, 64 * (r / 24), 32 * (r % 24), (bf16_t*)(ws + WS_WUQ), 256, 0, A.in[7], MapUq{}, scr, C.lane); continue; } r -= I_UQ;
        if (r < I_UKV) { tr_item(A.in[10], 1024, 64 * (r / 32), 32 * (r % 32), (bf16_t*)(ws + WS_WUKV), 256, 0, A.in[9], MapId{0}, scr, C.lane); continue; } r -= I_UKV;
        if (r < I_OM) { tr_item(A.in[11], 1024, 64 * (r / 32), 32 * (r % 32), (bf16_t*)(ws + WS_WOC), 1024, 0, nullptr, MapId{0}, scr, C.lane); continue; } r -= I_OM;
        if (r < I_OD) { tr_item(A.in[14], 1024, 64 * (r / 32), 32 * (r % 32), (bf16_t*)(ws + WS_WOC), 1024, 512, nullptr, MapId{0}, scr, C.lane); continue; } r -= I_OD;
        if (r < I_OUT) { tr_item(A.in[15], 1024, 64 * (r / 32), 32 * (r % 32), (bf16_t*)(ws + WS_WOUT), 1024, 0, nullptr, MapId{0}, scr, C.lane); continue; } r -= I_OUT;
        const int which = r / I_E; r -= which * I_E; const int e = r / 512, q = r % 512;
        if (which == 0) tr_item(A.in[20] + (size_t)e * 1024 * 1024, 1024, 64 * (q / 32), 32 * (q % 32), (bf16_t*)(ws + WS_W13), 1024, 0, nullptr, MapW13{e * 2048}, scr, C.lane);
        else if (which == 1) tr_item(A.in[21] + (size_t)e * 1024 * 1024, 1024, 64 * (q / 32), 32 * (q % 32), (bf16_t*)(ws + WS_W13), 1024, 0, nullptr, MapW13{e * 2048 + 128}, scr, C.lane);
        else tr_item(A.in[22] + (size_t)e * 1024 * 1024, 1024, 64 * (q / 32), 32 * (q % 32), (bf16_t*)(ws + WS_W2T), 1024, 0, nullptr, MapId{e * 1024}, scr, C.lane);
    }
    const int gt = C.vcu * NTHR + C.tid, NGT = C.G * NTHR; const u32x4 z4 = {0u, 0u, 0u, 0u};
    for (int i = gt; i < 96 * 128; i += NGT) *(u32x4*)(ws + WS_WIN + (size_t)416 * 2048 + (size_t)i * 16) = z4;
    for (int i = gt; i < 1024 * 16; i += NGT) *(u32x4*)(ws + WS_WUKV + (size_t)(i >> 4) * 512 + 256 + (size_t)(i & 15) * 16) = z4;
}

__device__ __forceinline__ void p0b_modulate(const Ctx& C0, const Args& A) {
    Ctx C = C0; asm volatile("" : "+v"(C.lane), "+v"(C.tid));
    const float* mod = (const float*)(A.ws + WS_MOD); bf16_t* A1 = (bf16_t*)(A.ws + WS_A1);
    const int gw = C.vcu * NWAVES + C.wave, NGW = C.G * NWAVES;
    for (int r = gw; r < MTOT; r += NGW) {
        const float* src = r < NCTX ? A.in[2] + (size_t)r * 1024 : A.in[0] + (size_t)(r - NCTX) * 1024;
        const float* sh = mod + (r < NCTX ? 4 : ((r - NCTX) >> 13)) * 6144; const float* sc = sh + 1024;
#pragma unroll
        for (int j = 0; j < 4; ++j) { const int d = 4 * C.lane + 256 * j; const f32x4 v = *(const f32x4*)(src + d), s = *(const f32x4*)(sc + d), h = *(const f32x4*)(sh + d);
            const f32x4 o = v * (s + 1.0f) + h; u32x2 w; w.x = cvt_pk_bf16(o[0], o[1]); w.y = cvt_pk_bf16(o[2], o[3]);
            *(u32x2*)(A1 + (size_t)r * 1024 + d) = w; }
    }
}

__device__ __forceinline__ void p4_ln_router(const Ctx& C0, const Args& A) {
    Ctx C = C0; asm volatile("" : "+v"(C.lane), "+v"(C.tid));
    float* Z = A.out; bf16_t* H2 = (bf16_t*)(A.ws + WS_H2); float* aff = (float*)(A.ws + WS_AFF); const float* mod = (const float*)(A.ws + WS_MOD);
    LAS float* wrt = (LAS float*)C.lds;
    for (int i = C.tid; i < 16384; i += NTHR) wrt[(i & 15) * 1024 + (i >> 4)] = A.in[18][i];
    __syncthreads();
    f32x4 lg[4], lb[4];
#pragma unroll
    for (int j = 0; j < 4; ++j) { lg[j] = *(const f32x4*)(A.in[16] + 4 * C.lane + 256 * j); lb[j] = *(const f32x4*)(A.in[17] + 4 * C.lane + 256 * j); }
    const int gw = C.vcu * NWAVES + C.wave, NGW = C.G * NWAVES;
    for (int row = gw; row < NLAT; row += NGW) {
        const int b = row >> 13, n = row & 8191; float* zr = Z + (size_t)row * 1024; const float* sh2 = mod + b * 6144 + 3 * 1024; const float* sc2 = mod + b * 6144 + 4 * 1024;
        f32x4 v[4]; float s = 0.f;
#pragma unroll
        for (int j = 0; j < 4; ++j) { v[j] = *(const f32x4*)(zr + 4 * C.lane + 256 * j); s += (v[j][0] + v[j][1]) + (v[j][2] + v[j][3]); }
        const float mean = wave_sum(s) * (1.0f / 1024.0f); float s2 = 0.f;
#pragma unroll
        for (int j = 0; j < 4; ++j) { v[j] = v[j] - mean; s2 += sq4(v[j]); }
        const float rstd = fast_rsq(wave_sum(s2) * (1.0f / 1024.0f) + EPS);
        float p[16];
#pragma unroll
        for (int e = 0; e < 16; ++e) p[e] = 0.f;
#pragma unroll
        for (int j = 0; j < 4; ++j) { const int d = 4 * C.lane + 256 * j; const f32x4 x1 = v[j] * rstd * lg[j] + lb[j];
            *(f32x4*)(zr + d) = x1;
            const f32x4 h = x1 * (*(const f32x4*)(sc2 + d) + 1.0f) + *(const f32x4*)(sh2 + d);
            u32x2 w; w.x = cvt_pk_bf16(h[0], h[1]); w.y = cvt_pk_bf16(h[2], h[3]); *(u32x2*)(H2 + (size_t)row * 1024 + d) = w;
#pragma unroll
            for (int e = 0; e < 16; ++e) { const f32x4 wv = *(const LAS f32x4*)(wrt + e * 1024 + d); p[e] += (h[0] * wv[0] + h[1] * wv[1]) + (h[2] * wv[2] + h[3] * wv[3]); if ((e & 3) == 3) asm volatile("" ::: "memory"); } }
        float mx = -1e30f;
#pragma unroll
        for (int e = 0; e < 16; ++e) { p[e] = wave_sum(p[e]) + A.in[19][e]; mx = fmaxf(mx, p[e]); }
        float den = 0.f;
#pragma unroll
        for (int e = 0; e < 16; ++e) { p[e] = expf(p[e] - mx); den += p[e]; }
        const float inv = 1.0f / den; float mine = 0.f;
#pragma unroll
        for (int e = 0; e < 16; ++e) mine = (C.lane == e) ? p[e] * inv : mine;
        if (C.lane < 16) aff[((size_t)b * 16 + C.lane) * SEQ + n] = mine;
    }
    __syncthreads();
}

__device__ __forceinline__ unsigned block_incl_scan(unsigned v, LAS unsigned* wtot, int lane, int wave, unsigned& total) {
    unsigned x = v;
#pragma unroll
    for (int o = 1; o < 64; o <<= 1) { const unsigned y = __shfl_up(x, o); if (lane >= o) x += y; }
    if (lane == 63) wtot[wave] = x;
    __syncthreads();
    unsigned off = 0, tot = 0;
#pragma unroll
    for (int w = 0; w < 8; ++w) { const unsigned t = wtot[w]; off += (w < wave) ? t : 0u; tot += t; }
    __syncthreads();
    total = tot; return x + off;
}
__device__ __forceinline__ void p5_topk(const Ctx& C0, const Args& A) {
    Ctx C = C0; asm volatile("" : "+v"(C.lane), "+v"(C.tid));
    const float* aff = (const float*)(A.ws + WS_AFF); int* idx = (int*)(A.ws + WS_IDX); float* gsel = (float*)(A.ws + WS_GSEL); short* slotmap = (short*)(A.ws + WS_SLOT);
    LAS unsigned* hist = (LAS unsigned*)C.lds; LAS unsigned* wtot = hist + 4096; LAS unsigned* res = wtot + 16;
    for (int be = C.vcu; be < NB * NE; be += C.G) {
        const int b = be >> 4, e = be & 15; unsigned key[16];
#pragma unroll
        for (int j = 0; j < 4; ++j) { const u32x4 k4 = *(const u32x4*)(aff + (size_t)be * SEQ + C.tid * 16 + 4 * j); key[4 * j] = k4.x; key[4 * j + 1] = k4.y; key[4 * j + 2] = k4.z; key[4 * j + 3] = k4.w; }
        unsigned prefix = 0u, mask = 0u, need = CAP;
#pragma unroll
        for (int pass = 0; pass < 3; ++pass) {
            const int shift = pass == 0 ? 20 : (pass == 1 ? 8 : 0), nb = pass == 2 ? 256 : 4096;
            for (int i = C.tid; i < nb; i += NTHR) hist[i] = 0u;
            __syncthreads();
#pragma unroll
            for (int k = 0; k < 16; ++k) if ((key[k] & mask) == prefix) atomicAdd((unsigned*)(hist + ((key[k] >> shift) & (unsigned)(nb - 1))), 1u);
            __syncthreads();
            const int per = nb / NTHR > 0 ? nb / NTHR : 1; const int lo = C.tid * per; unsigned s = 0u;
            if (lo < nb) for (int d = 0; d < per; ++d) s += hist[lo + d];
            unsigned total; const unsigned incl = block_incl_scan(s, wtot, C.lane, C.wave, total);
            unsigned running = total - incl;
            if (lo < nb) for (int d = per - 1; d >= 0; --d) { const unsigned hv = hist[lo + d]; if (running < need && need <= running + hv) { res[0] = (unsigned)(lo + d); res[1] = running; } running += hv; }
            __syncthreads();
            prefix |= res[0] << shift; mask |= (unsigned)(nb - 1) << shift; need -= res[1];
            __syncthreads();
        }
        const unsigned T = prefix; unsigned cg = 0u, ce = 0u;
#pragma unroll
        for (int k = 0; k < 16; ++k) { cg += key[k] > T ? 1u : 0u; ce += key[k] == T ? 1u : 0u; }
        unsigned total; const unsigned packed = cg | (ce << 16); const unsigned excl = block_incl_scan(packed, wtot, C.lane, C.wave, total) - packed;
        unsigned eqr = excl >> 16; unsigned slot = (excl & 0xffffu) + (eqr < need ? eqr : need);
#pragma unroll
        for (int k = 0; k < 16; ++k) { const int n = C.tid * 16 + k; const bool iseq = key[k] == T; const bool sel = key[k] > T || (iseq && eqr < need); eqr += iseq ? 1u : 0u;
            slotmap[((size_t)b * SEQ + n) * 16 + e] = sel ? (short)slot : (short)-1;
            if (sel) { idx[be * CAP + slot] = n; gsel[be * CAP + slot] = __uint_as_float(key[k]); ++slot; } }
        __syncthreads();
    }
}
__device__ __forceinline__ void p5b_gather(const Ctx& C0, const Args& A) {
    Ctx C = C0; asm volatile("" : "+v"(C.lane), "+v"(C.tid));
    const int* idx = (const int*)(A.ws + WS_IDX); const bf16_t* H2 = (const bf16_t*)(A.ws + WS_H2); bf16_t* XE = (bf16_t*)(A.ws + WS_XE);
    const int gw = C.vcu * NWAVES + C.wave, NGW = C.G * NWAVES;
    for (int r = gw; r < NB * NE * CAP; r += NGW) { const int b = r >> 14; const int n = idx[r];
        const bf16_t* s = H2 + ((size_t)b * SEQ + n) * 1024; bf16_t* d = XE + (size_t)r * 1024;
        const u32x4 v0 = *(const u32x4*)(s + 8 * C.lane), v1 = *(const u32x4*)(s + 512 + 8 * C.lane);
        *(u32x4*)(d + 8 * C.lane) = v0; *(u32x4*)(d + 512 + 8 * C.lane) = v1; }
}
__device__ __forceinline__ void p8_final(const Ctx& C0, const Args& A) {
    Ctx C = C0; asm volatile("" : "+v"(C.lane), "+v"(C.tid));
    float* X1 = A.out; const bf16_t* YE = (const bf16_t*)(A.ws + WS_YE); const short* slotmap = (const short*)(A.ws + WS_SLOT); const float* mod = (const float*)(A.ws + WS_MOD);
    f32x4 lg[4], lb[4];
#pragma unroll
    for (int j = 0; j < 4; ++j) { lg[j] = *(const f32x4*)(A.in[23] + 4 * C.lane + 256 * j); lb[j] = *(const f32x4*)(A.in[24] + 4 * C.lane + 256 * j); }
    const int gw = C.vcu * NWAVES + C.wave, NGW = C.G * NWAVES;
    for (int row = gw; row < NLAT; row += NGW) {
        const int b = row >> 13; float* xr = X1 + (size_t)row * 1024; const float* g2 = mod + b * 6144 + 5 * 1024;
        const int myslot = (int)slotmap[(size_t)row * 16 + (C.lane & 15)];
        f32x4 mo[4];
#pragma unroll
        for (int j = 0; j < 4; ++j) mo[j] = (f32x4){0.f, 0.f, 0.f, 0.f};
        for (int e = 0; e < 16; ++e) { const int sl = __shfl(myslot, e);
            if (sl >= 0) { const bf16_t* yr = YE + ((size_t)(b * 16 + e) * CAP + sl) * 1024;
#pragma unroll
                for (int j = 0; j < 4; ++j) { const u32x2 w = *(const u32x2*)(yr + 4 * C.lane + 256 * j); mo[j] += (f32x4){bf_lo(w.x), bf_hi(w.x), bf_lo(w.y), bf_hi(w.y)}; } } }
        f32x4 v[4]; float s = 0.f;
#pragma unroll
        for (int j = 0; j < 4; ++j) { const int d = 4 * C.lane + 256 * j; v[j] = *(const f32x4*)(xr + d) * ALPHA + *(const f32x4*)(g2 + d) * mo[j]; s += (v[j][0] + v[j][1]) + (v[j][2] + v[j][3]); }
        const float mean = wave_sum(s) * (1.0f / 1024.0f); float s2 = 0.f;
#pragma unroll
        for (int j = 0; j < 4; ++j) { v[j] = v[j] - mean; s2 += sq4(v[j]); }
        const float rstd = fast_rsq(wave_sum(s2) * (1.0f / 1024.0f) + EPS);
#pragma unroll
        for (int j = 0; j < 4; ++j) *(f32x4*)(xr + 4 * C.lane + 256 * j) = v[j] * rstd * lg[j] + lb[j];
    }
}
constexpr int NPHASE = 13;
__global__ void __launch_bounds__(NTHR, 2) mk(Args A) {
    extern __shared__ __attribute__((aligned(16))) unsigned char lds_raw[];
    Ctx C; C.lds = (LAS unsigned char*)lds_raw; C.lds_g = lds_raw;
    C.tid = threadIdx.x; C.lane = C.tid & 63; C.wave = __builtin_amdgcn_readfirstlane(C.tid >> 6);
    C.G = gridDim.x; { const int bx = blockIdx.x; C.xcd = bx & 7; C.slot = bx >> 3; C.vcu = (bx & 7) * (C.G >> 3) + (bx >> 3); }
    unsigned char* ws = A.ws; const int lo = A.ph_lo, hi = A.ph_hi;
#if MK_ONE_LAUNCH
    cg::grid_group grid = cg::this_grid();
#define SEAM(k) do { if (lo <= (k) && (k) + 1 < hi) grid.sync(); } while (0)
#else
#define SEAM(k) do { } while (0)
#endif
#ifndef DBG_ONLY
#define DBG_ONLY -1
#endif
#ifndef DBG_SKIP_MASK
#define DBG_SKIP_MASK 0
#endif
#define IN(k) ((DBG_ONLY < 0 || DBG_ONLY == (k)) && !((DBG_SKIP_MASK >> (k)) & 1) && lo <= (k) && (k) < hi)
    const float* rope = (const float*)(ws + WS_ROPE);
    const int bx = blockIdx.x;
    if (IN(0)) { p0_prologue(C, A); } SEAM(0);
    if (IN(1)) { p0b_modulate(C, A); } SEAM(1);
    if (IN(2)) {
        Sched1 S{C.G, bx, (const char*)(ws + WS_A1), (const char*)(ws + WS_WIN)};
        Epi1 E{(bf16_t*)(ws + WS_P0B), (float*)(ws + WS_SSQ), (bf16_t*)(ws + WS_KR), (bf16_t*)(ws + WS_QD), (bf16_t*)(ws + WS_KD), (bf16_t*)(ws + WS_VD),
#ifdef DBG_GT_WS
            (bf16_t*)(ws + (326ull << 20)),
#else
            (bf16_t*)A.out,
#endif
            rope};
        pg8::gemm_phase(C.lds, pg8::Gemm{1024, 1024, 1024}, S, E);
    } SEAM(2);
    if (IN(3)) {
        SchedUQ Sq{C.G, bx, (const char*)(ws + WS_P0B), (const char*)(ws + WS_WUQ)}; SchedUKV Sk{C.G, bx, (const char*)(ws + WS_P0B), (const char*)(ws + WS_WUKV)};
        SchedU S{Sq, Sk, C.G, bx};
        EpiU E{EpiUQ{(const float*)(ws + WS_SSQ), (bf16_t*)(ws + WS_QM), rope}, EpiUKV{(const float*)(ws + WS_SSQ), (const bf16_t*)(ws + WS_KR), (bf16_t*)(ws + WS_KM), (bf16_t*)(ws + WS_VM)}};
        pg8::gemm_phase(C.lds, pg8::Gemm{256, 512, 256}, S, E);
    } SEAM(3);
#if !MK_NAIVE_ATTN
    if (IN(4)) { attn_phase(C, ws, A.in[13]); }
#endif
    SEAM(4);
    if (IN(5)) {
        SchedY S{C.G, bx, (const char*)(ws + WS_OA), (const char*)(ws + WS_WOC)}; EpiY E{(const bf16_t*)A.out, (bf16_t*)(ws + WS_Y)};
        pg8::gemm_phase(C.lds, pg8::Gemm{512, 1024, 1024}, S, E);
    } SEAM(5);
    if (IN(6)) {
        SchedZ S{C.G, bx, (const char*)(ws + WS_Y), (const char*)(ws + WS_WOUT)}; EpiZ E{A.in[0], (const float*)(ws + WS_MOD), A.out};
        pg8::gemm_phase(C.lds, pg8::Gemm{1024, 1024, 1024}, S, E);
    } SEAM(6);
    if (IN(7)) { p4_ln_router(C, A); } SEAM(7);
    if (IN(8)) { p5_topk(C, A); } SEAM(8);
    if (IN(9)) { p5b_gather(C, A); } SEAM(9);
    if (IN(10)) {
        SchedM1 S{C.xcd, C.slot, (const char*)(ws + WS_XE), (const char*)(ws + WS_W13)}; EpiM1 E{(bf16_t*)(ws + WS_HID)};
        pg8::gemm_phase(C.lds, pg8::Gemm{1024, 1024, 1024}, S, E);
    } SEAM(10);
    if (IN(11)) {
        SchedM2 S{C.xcd, C.slot, (const char*)(ws + WS_HID), (const char*)(ws + WS_W2T)}; EpiM2 E{(const float*)(ws + WS_GSEL), (bf16_t*)(ws + WS_YE)};
        pg8::gemm_phase(C.lds, pg8::Gemm{1024, 1024, 1024}, S, E);
    } SEAM(11);
    if (IN(12)) { p8_final(C, A); }
#undef IN
#undef SEAM
}

#ifdef DBG_COPY_OFF
__global__ void dbg_copy(u32x4* dst, const u32x4* src, size_t n16) { for (size_t i = blockIdx.x * 256ull + threadIdx.x; i < n16; i += gridDim.x * 256ull) dst[i] = src[i]; }
#endif
extern "C" void kernel_launch(void* const* d_in, const int* in_sizes, int n_in, void* d_out, int out_size, void* d_ws, size_t ws_size, hipStream_t stream) {
    static int ready = 0;
    if (ready == 0) {
        if (n_in != 25 || in_sizes[0] != NLAT * DM || out_size != NLAT * DM || ws_size < WS_NEED) {
            fprintf(stderr, "kernel_launch: unexpected shapes (n_in %d, x %d, out %d, ws %zu; need ws >= %zu)\n", n_in, n_in > 0 ? in_sizes[0] : -1, out_size, ws_size, (size_t)WS_NEED); ready = -1; return; }
        if (hipFuncSetAttribute((const void*)mk, hipFuncAttributeMaxDynamicSharedMemorySize, LDS_BYTES) != hipSuccess) { fprintf(stderr, "kernel_launch: hipFuncSetAttribute failed\n"); ready = -1; return; }
        int dev = 0, cus = 0, per_cu = 0;
        (void)hipGetDevice(&dev); (void)hipDeviceGetAttribute(&cus, hipDeviceAttributeMultiprocessorCount, dev);
        (void)hipOccupancyMaxActiveBlocksPerMultiprocessor(&per_cu, (const void*)mk, NTHR, LDS_BYTES);
        if (cus != 256 || per_cu < 1) { fprintf(stderr, "kernel_launch: needs 256 CUs with one resident workgroup each (cus %d, per_cu %d)\n", cus, per_cu); ready = -1; return; }
        ready = 1;
    }
    if (ready < 0) return;
    Args a{};
    for (int i = 0; i < 25; ++i) a.in[i] = (const float*)d_in[i];
    a.out = (float*)d_out; a.ws = (unsigned char*)d_ws;
#if MK_ONE_LAUNCH
    a.ph_lo = 0; a.ph_hi = NPHASE;
    void* kargs[] = {&a};
    hipError_t e = hipLaunchCooperativeKernel((const void*)mk, dim3(256), dim3(NTHR), kargs, LDS_BYTES, stream);
    if (e != hipSuccess) fprintf(stderr, "kernel_launch: cooperative launch failed: %s\n", hipGetErrorString(e));
#else
#ifndef DBG_LAST_PHASE
#define DBG_LAST_PHASE 99
#endif
    for (int ph = 0; ph < NPHASE && ph <= DBG_LAST_PHASE; ++ph) {
#if MK_NAIVE_ATTN
        if (ph == 4) {
            unsigned char* ws = (unsigned char*)d_ws;
            naive_attn<0><<<NB * 8 * SEQ / 4, 256, 0, stream>>>((const bf16_t*)(ws + WS_QM), (const bf16_t*)(ws + WS_KM), (const bf16_t*)(ws + WS_VM), (bf16_t*)(ws + WS_OA), (const float*)(ws + WS_LAM), (const float*)d_in[13]);
            naive_attn<1><<<NB * 4 * SEQ / 4, 256, 0, stream>>>((const bf16_t*)(ws + WS_QD), (const bf16_t*)(ws + WS_KD), (const bf16_t*)(ws + WS_VD), (bf16_t*)(ws + WS_OA), (const float*)(ws + WS_LAM), (const float*)d_in[13]);
            continue;
        }
#endif
        a.ph_lo = ph; a.ph_hi = ph + 1;
        hipLaunchKernelGGL(mk, dim3(256), dim3(NTHR), LDS_BYTES, stream, a);
    }
#ifdef DBG_COPY_OFF
    dbg_copy<<<2048, 256, 0, stream>>>((u32x4*)d_out, (const u32x4*)((unsigned char*)d_ws + (size_t)DBG_COPY_OFF), (size_t)DBG_COPY_BYTES / 16);
#endif
    hipError_t e = hipPeekAtLastError();
    if (e != hipSuccess) fprintf(stderr, "kernel_launch: launch failed: %s\n", hipGetErrorString(e));
#endif
}
```

```cpp
#define MK_ONE_LAUNCH 1
#define MK_SLOWK 0
#define MK_NAIVE_ATTN 0
#include <hip/hip_runtime.h>
#include <hip/hip_cooperative_groups.h>
#include <cstdio>
#include <cstdint>
namespace cg = cooperative_groups;

#ifndef MK_ONE_LAUNCH
#define MK_ONE_LAUNCH 0
#endif
#ifndef MK_SLOWK
#define MK_SLOWK 1
#endif
#ifndef MK_NAIVE_ATTN
#define MK_NAIVE_ATTN 1
#endif

#define LAS __attribute__((address_space(3)))
#define GAS __attribute__((address_space(1)))
typedef unsigned short bf16_t;
typedef short bf16x8 __attribute__((ext_vector_type(8)));
typedef short s16x4 __attribute__((ext_vector_type(4)));
typedef float f32x2 __attribute__((ext_vector_type(2)));
typedef float f32x4 __attribute__((ext_vector_type(4)));
typedef float f32x16 __attribute__((ext_vector_type(16)));
typedef unsigned u32x2 __attribute__((ext_vector_type(2)));
typedef unsigned u32x4 __attribute__((ext_vector_type(4)));

constexpr int DM = 1024, NB = 4, SEQ = 8192, CTXL = 256, SK = SEQ + CTXL;
constexpr int NLAT = NB * SEQ, NCTX = NB * CTXL, MTOT = NCTX + NLAT;
constexpr int NE = 16, CAP = 1024, FFD = 1024, NIN = 4000;
constexpr float EPS = 1e-6f, LOG2E = 1.4426950408889634f;
constexpr float MLA_QS = 0.10206207261596577f * LOG2E;
constexpr float DIFF_QS = 0.125f * LOG2E;
constexpr float ALPHA = 1.189207115002721f;
constexpr float LAMBDA_INIT = 0.2f;
constexpr int NWAVES = 8, NTHR = 512;

constexpr size_t MiB = 1u << 20;
constexpr size_t WS_CTL = 0;
constexpr size_t WS_MOD = 1 * MiB;
constexpr size_t WS_ROPE = 1 * MiB + 256 * 1024;
constexpr size_t WS_LAM = 1 * MiB + 512 * 1024;
constexpr size_t WS_SSQ = 2 * MiB;
constexpr size_t WS_KR = 4 * MiB;
constexpr size_t WS_AFF = 7 * MiB;
constexpr size_t WS_IDX = 9 * MiB;
constexpr size_t WS_GSEL = 9 * MiB + 512 * 1024;
constexpr size_t WS_SLOT = 10 * MiB;
constexpr size_t WS_WIN = 16 * MiB;
constexpr size_t WS_WUQ = 24 * MiB;
constexpr size_t WS_WUKV = 25 * MiB;
constexpr size_t WS_WOC = 26 * MiB;
constexpr size_t WS_WOUT = 28 * MiB;
constexpr size_t WS_W13 = 32 * MiB;
constexpr size_t WS_W2T = 96 * MiB;
constexpr size_t WS_A1 = 128 * MiB;
constexpr size_t WS_P0B = 194 * MiB;
constexpr size_t WS_QD = 228 * MiB;
constexpr size_t WS_KD = 260 * MiB;
constexpr size_t WS_VD = 293 * MiB;
constexpr size_t WS_QM = 326 * MiB;
constexpr size_t WS_KM = 374 * MiB;
constexpr size_t WS_VM = 424 * MiB;
constexpr size_t WS_OA = 128 * MiB;
constexpr size_t WS_Y = 192 * MiB;
constexpr size_t WS_H2 = 128 * MiB;
constexpr size_t WS_XE = 256 * MiB;
constexpr size_t WS_HID = 384 * MiB;
constexpr size_t WS_YE = 256 * MiB;
constexpr size_t WS_NEED = 512 * MiB;

constexpr int LDS_BYTES = 147456;

typedef __bf16 bf16x2_t __attribute__((ext_vector_type(2)));
__device__ __forceinline__ unsigned cvt_pk_bf16(float lo, float hi) { const f32x2 v = {lo, hi}; const bf16x2_t b = __builtin_convertvector(v, bf16x2_t); return __builtin_bit_cast(unsigned, b); }
__device__ __forceinline__ float bf_lo(unsigned w) { return __uint_as_float(w << 16); }
__device__ __forceinline__ float bf_hi(unsigned w) { return __uint_as_float(w & 0xffff0000u); }
__device__ __forceinline__ float bf2f(bf16_t h) { return __uint_as_float(((unsigned)h) << 16); }
__device__ __forceinline__ float fast_exp2(float x) { return __builtin_amdgcn_exp2f(x); }
__device__ __forceinline__ float fast_rcp(float x) { return __builtin_amdgcn_rcpf(x); }
__device__ __forceinline__ float fast_rsq(float x) { return __builtin_amdgcn_rsqf(x); }
__device__ __forceinline__ float sigmoidf_(float x) { return fast_rcp(1.0f + fast_exp2(-x * LOG2E)); }
__device__ __forceinline__ float wave_sum(float v) {
#pragma unroll
    for (int o = 1; o < 64; o <<= 1) v += __shfl_xor(v, o);
    return v;
}
__device__ __forceinline__ float wave_max(float v) {
#pragma unroll
    for (int o = 1; o < 64; o <<= 1) v = fmaxf(v, __shfl_xor(v, o));
    return v;
}

struct Args { const float* in[25]; float* out; unsigned char* ws; int ph_lo, ph_hi; };

struct Ctx {
    LAS unsigned char* lds; unsigned char* lds_g;
    int tid, lane, wave, G, vcu, xcd, slot;
};

namespace pg8 {
constexpr int BM = 256, BK = 64, HALF = 128, HTB = HALF * BK * 2, STAGE_BYTES = 8 * HTB;
__host__ __device__ __forceinline__ int lds_byte(int r, int c) { const int st = (r >> 4) * 2 + (c >> 5), rr = r & 15, cc = c & 31, ob = rr * 64 + cc * 2; return st * 1024 + (ob ^ (((ob >> 9) & 1) << 5)); }
__host__ __device__ __forceinline__ void stage_rc(int b, int& R, int& C) { const int st = b / 1024, sb = b % 1024, swz = sb ^ (((sb >> 9) & 1) << 5); R = (st >> 1) * 16 + swz / 64; C = (st & 1) * 32 + (swz % 64) / 2; }
__host__ __device__ __forceinline__ int perm32(int rho) { const int n = rho >> 4, i = rho & 15; return 8 * (i >> 2) + 4 * n + (i & 3); }
struct Unit { int pm, pn, aux; };
struct Gemm { int K, lda, ldb; };

#define ACC_ZERO() do { _Pragma("unroll") for (int a_ = 0; a_ < 2; ++a_) _Pragma("unroll") for (int b_ = 0; b_ < 2; ++b_) _Pragma("unroll") for (int m_ = 0; m_ < 4; ++m_) _Pragma("unroll") for (int n_ = 0; n_ < 2; ++n_) acc[a_][b_][m_][n_] = (f32x4){0.f, 0.f, 0.f, 0.f}; } while (0)

#if MK_SLOWK
template <class Epi, class Sched>
__device__ __forceinline__ void gemm_phase(LAS unsigned char* lds, const Gemm g, const Sched& S, const Epi& E) {
    const int tid = threadIdx.x, wid = __builtin_amdgcn_readfirstlane(tid >> 6), lane = tid & 63, wr = wid >> 2, wc = wid & 3, fr = lane & 15, fq = lane >> 4;
    f32x4 acc[2][2][4][2];
    ACC_ZERO();
    Unit cur;
    for (int ui = 0; S.next(ui, cur); ++ui) {
        const char* cA = S.a_ptr(cur); const char* cB = S.b_ptr(cur);
        for (int k0 = 0; k0 < g.K; k0 += 32) {
            bf16x8 At[2][4], Bt[2][2];
#pragma unroll
            for (int ai = 0; ai < 2; ++ai)
#pragma unroll
                for (int m = 0; m < 4; ++m) At[ai][m] = *(const bf16x8*)(cA + ((size_t)(128 * ai + 64 * wr + 16 * m + fr) * g.lda + k0 + 8 * fq) * 2);
#pragma unroll
            for (int bj = 0; bj < 2; ++bj)
#pragma unroll
                for (int n = 0; n < 2; ++n) { const int sl = 16 * n + fr; const int row = 128 * bj + 32 * wc + (Epi::PERM ? perm32(sl) : sl);
                    Bt[bj][n] = *(const bf16x8*)(cB + ((size_t)row * g.ldb + k0 + 8 * fq) * 2); }
#pragma unroll
            for (int ai = 0; ai < 2; ++ai)
#pragma unroll
                for (int bj = 0; bj < 2; ++bj)
#pragma unroll
                    for (int m = 0; m < 4; ++m)
#pragma unroll
                        for (int n = 0; n < 2; ++n) acc[ai][bj][m][n] = __builtin_amdgcn_mfma_f32_16x16x32_bf16(Bt[bj][n], At[ai][m], acc[ai][bj][m][n], 0, 0, 0);
        }
        E(acc, cur, wr, wc, fr, fq);
        if (!E.keep(cur)) ACC_ZERO();
    }
}
#else
template <class Epi, class Sched>
__device__ __forceinline__ void gemm_phase(LAS unsigned char* lds, const Gemm g, const Sched& S, const Epi& E) {
    constexpr bool ALIGN_EPI = true;
    int tid_ = threadIdx.x; asm volatile("" : "+v"(tid_));
    const int tid = tid_, wid = __builtin_amdgcn_readfirstlane(tid >> 6), lane = tid & 63, wr = wid >> 2, wc = wid & 3, fr = lane & 15, fq = lane >> 4;
    const int K = g.K, nt = K / BK;
    unsigned voffA[2], voffB[2];
#pragma unroll
    for (int i = 0; i < 2; ++i) { int R, C; stage_rc(tid * 16 + i * 8192, R, C); const int Rb = Epi::PERM ? ((R & ~31) + perm32(R & 31)) : R;
        voffA[i] = (unsigned)(R * g.lda + C) * 2u; voffB[i] = (unsigned)(Rb * g.ldb + C) * 2u; }
    const size_t kstep = (size_t)(BK * 2);
    const size_t hstepA = (size_t)HALF * g.lda * 2, hstepB = (size_t)HALF * g.ldb * 2;
    const unsigned ldsw = (unsigned)wid * 1024u;
    const int aoff = lds_byte(wr * 64 + fr, fq * 8), boff = lds_byte(wc * 32 + fr, fq * 8);
#define PG8_SA(b, h) (((b) * 2 + (h)) * HTB)
#define PG8_SB(b, h) ((4 + (b) * 2 + (h)) * HTB)
#define PG8_STAGE(bufoff, gbase, voff) do { _Pragma("unroll") for (int _i = 0; _i < 2; ++_i) \
        __builtin_amdgcn_global_load_lds((const unsigned*)((const char*)(gbase) + (voff)[_i]), (LAS unsigned*)(lds + (bufoff) + ldsw + _i * 8192), 16, 0, 0); } while (0)
#define PG8_LDA(dst, b, h) do { _Pragma("unroll") for (int m = 0; m < 4; ++m) _Pragma("unroll") for (int k = 0; k < 2; ++k) dst[m][k] = *(const LAS bf16x8*)(lds + PG8_SA(b, h) + aoff + m * 2048 + k * 1024); } while (0)
#define PG8_LDB(dst, b, h) do { _Pragma("unroll") for (int n = 0; n < 2; ++n) _Pragma("unroll") for (int k = 0; k < 2; ++k) dst[n][k] = *(const LAS bf16x8*)(lds + PG8_SB(b, h) + boff + n * 2048 + k * 1024); } while (0)
#define PG8_MMA(ai, bj, At, Bt) do { __builtin_amdgcn_s_setprio(1); _Pragma("unroll") for (int m = 0; m < 4; ++m) _Pragma("unroll") for (int n = 0; n < 2; ++n) _Pragma("unroll") for (int k = 0; k < 2; ++k) \
        acc[ai][bj][m][n] = __builtin_amdgcn_mfma_f32_16x16x32_bf16(Bt[n][k], At[m][k], acc[ai][bj][m][n], 0, 0, 0); __builtin_amdgcn_s_setprio(0); } while (0)
#define PG8_WAIT_V(n) asm volatile("s_waitcnt vmcnt(" #n ")" ::: "memory")
#define PG8_WAIT_L(n) asm volatile("s_waitcnt lgkmcnt(" #n ")" ::: "memory")
#define PG8_BAR __builtin_amdgcn_s_barrier()
#define PG8_SCHED __builtin_amdgcn_sched_barrier(0)
    Unit cur, nxt; int ui = 0;
    if (!S.next(0, cur)) return;
    f32x4 acc[2][2][4][2];
    ACC_ZERO();
    bf16x8 At[4][2], B0[2][2], B1[2][2];
    const char* cA = S.a_ptr(cur); const char* cB = S.b_ptr(cur);
    PG8_STAGE(PG8_SB(0, 0), cB, voffB); PG8_STAGE(PG8_SB(0, 1), cB + hstepB, voffB); PG8_STAGE(PG8_SA(0, 0), cA, voffA); PG8_STAGE(PG8_SA(0, 1), cA + hstepA, voffA);
    if (wr == 1) PG8_BAR;
    PG8_WAIT_V(2); PG8_BAR;
    PG8_STAGE(PG8_SB(1, 0), cB + kstep, voffB); PG8_STAGE(PG8_SA(1, 0), cA + kstep, voffA); PG8_STAGE(PG8_SB(1, 1), cB + hstepB + kstep, voffB);
    PG8_WAIT_V(6); PG8_BAR;
    for (;;) {
        const bool has_next = S.next(ui + 1, nxt);
        const char* nA = has_next ? S.a_ptr(nxt) : cA; const char* nB = has_next ? S.b_ptr(nxt) : cB;
        for (int t = 0; t < nt; t += 2) {
            const bool last = (t == nt - 2);
            const char* a1 = cA + (size_t)(t + 1) * kstep;
            const char* a2 = last ? nA : cA + (size_t)(t + 2) * kstep; const char* b2 = last ? nB : cB + (size_t)(t + 2) * kstep;
            const char* a3 = a2 + kstep; const char* b3 = b2 + kstep;
            PG8_LDB(B0, 0, 0); PG8_LDB(B1, 0, 1); PG8_SCHED; PG8_LDA(At, 0, 0); PG8_STAGE(PG8_SA(1, 1), a1 + hstepA, voffA);
            PG8_WAIT_V(8); PG8_WAIT_L(0); PG8_BAR; PG8_MMA(0, 0, At, B0); PG8_MMA(0, 1, At, B1); PG8_BAR; PG8_SCHED;
            PG8_LDA(At, 0, 1); PG8_STAGE(PG8_SB(0, 0), b2, voffB); PG8_STAGE(PG8_SB(0, 1), b2 + hstepB, voffB); PG8_STAGE(PG8_SA(0, 0), a2, voffA);
            PG8_WAIT_V(8); PG8_WAIT_L(0); PG8_BAR; PG8_MMA(1, 0, At, B0); PG8_MMA(1, 1, At, B1); PG8_BAR; PG8_SCHED;
            PG8_LDB(B0, 1, 0); PG8_LDB(B1, 1, 1); PG8_SCHED; PG8_LDA(At, 1, 0); PG8_STAGE(PG8_SA(0, 1), a2 + hstepA, voffA);
            PG8_WAIT_V(8); PG8_WAIT_L(0); PG8_BAR; PG8_MMA(0, 0, At, B0); PG8_MMA(0, 1, At, B1); PG8_BAR; PG8_SCHED;
            PG8_LDA(At, 1, 1); PG8_STAGE(PG8_SB(1, 0), b3, voffB); PG8_STAGE(PG8_SB(1, 1), b3 + hstepB, voffB); PG8_STAGE(PG8_SA(1, 0), a3, voffA);
            PG8_WAIT_V(8); PG8_WAIT_L(0); PG8_BAR; PG8_MMA(1, 0, At, B0); PG8_MMA(1, 1, At, B1); PG8_BAR; PG8_SCHED;
        }
        if constexpr (ALIGN_EPI) { if (wr == 0) PG8_BAR; }
        E(acc, cur, wr, wc, fr, fq);
#ifdef MK_EPI_DRAIN
        PG8_WAIT_V(0);
#endif
        if (!has_next) break;
        if (!E.keep(cur)) ACC_ZERO();
        cur = nxt; cA = nA; cB = nB; ++ui;
        if constexpr (ALIGN_EPI) { if (wr == 1) PG8_BAR; }
    }
    PG8_WAIT_V(0);
    if constexpr (!ALIGN_EPI) { if (wr == 0) PG8_BAR; }
    PG8_BAR;
#undef PG8_SA
#undef PG8_SB
#undef PG8_STAGE
#undef PG8_LDA
#undef PG8_LDB
#undef PG8_MMA
#undef PG8_WAIT_V
#undef PG8_WAIT_L
#undef PG8_BAR
#undef PG8_SCHED
}
#endif
}
using pg8::Unit;

__device__ __forceinline__ void static_order(int L, int nM, int nN, int& pm, int& pn) {
    const int nwg = nM * nN; int wgid = L;
    { const int q = nwg / 8, r = nwg % 8, xcd = wgid % 8, off = wgid / 8; wgid = (xcd < r ? xcd * (q + 1) : r * (q + 1) + (xcd - r) * q) + off; }
    const int nig = 8 * nN, gid = wgid / nig, fm = gid * 8, gsz = (nM - fm) < 8 ? (nM - fm) : 8;
    pm = fm + ((wgid % nig) % gsz); pn = (wgid % nig) / gsz;
}
__device__ __forceinline__ u32x4 pack8(f32x4 a, f32x4 b) { u32x4 w; w.x = cvt_pk_bf16(a[0], a[1]); w.y = cvt_pk_bf16(a[2], a[3]); w.z = cvt_pk_bf16(b[0], b[1]); w.w = cvt_pk_bf16(b[2], b[3]); return w; }
__device__ __forceinline__ void rope4(f32x4& x1, f32x4& x2, f32x4 c, f32x4 s) { const f32x4 o1 = x1 * c - x2 * s, o2 = x2 * c + x1 * s; x1 = o1; x2 = o2; }
__device__ __forceinline__ float sq4(f32x4 v) { return (v[0] * v[0] + v[1] * v[1]) + (v[2] * v[2] + v[3] * v[3]); }

struct Sched1 {
    int G, c; const char* A1; const char* WIN;
    __device__ __forceinline__ bool next(int i, Unit& u) const {
        int L = i * G + c; u.aux = 0;
        if (L < 2048) { int pm, pn; static_order(L, 128, 16, pm, pn); u.pm = pm + 4; u.pn = pn; return true; }
        L -= 2048; if (L >= 20) return false;
        u.pm = L / 5; const int j = L % 5; u.pn = (j == 0) ? 1 : (3 + j); return true;
    }
    __device__ __forceinline__ const char* a_ptr(const Unit& u) const { return A1 + (size_t)u.pm * 256 * 1024 * 2; }
    __device__ __forceinline__ const char* b_ptr(const Unit& u) const { return WIN + (size_t)u.pn * 256 * 1024 * 2; }
};
struct Epi1 {
    static constexpr bool PERM = true;
    bf16_t* P0B; float* SSQ; bf16_t* KR; bf16_t* QD; bf16_t* KD; bf16_t* VD; bf16_t* GT; const float* rope;
    __device__ __forceinline__ bool keep(const Unit&) const { return false; }
    __device__ __forceinline__ void operator()(f32x4 (&acc)[2][2][4][2], const Unit& u, int wr, int wc, int fr, int fq) const {
        asm volatile("" : "+v"(fr), "+v"(fq));
        const bool isctx = u.pm < 4; int b, tbase;
        if (isctx) { b = u.pm; tbase = 0; } else { const int lt = u.pm - 4; b = lt >> 5; tbase = (lt & 31) * 256; }
        const int pn = u.pn;
        const float* cosD = rope; const float* sinD = rope + 2048; const float* cosM = rope + 4096; const float* sinM = rope + 5120;
        const int lr0 = 64 * wr + fr, cw = 32 * wc + 8 * fq;
#define E1_ROWS(...) _Pragma("unroll") for (int ai = 0; ai < 2; ++ai) _Pragma("unroll") for (int m = 0; m < 4; ++m) { const int lr = 128 * ai + 16 * m + lr0; const int t = tbase + lr; __VA_ARGS__ asm volatile("" ::: "memory"); }
        if (pn == 0) {
            bf16_t* P = P0B + (size_t)u.pm * 256 * 512 + cw; float* SQ = SSQ + (size_t)u.pm * 256 * 8 + wc;
            E1_ROWS({ (void)t; float ss = 0.f;
                _Pragma("unroll") for (int bj = 0; bj < 2; ++bj) { const f32x4 v0 = acc[ai][bj][m][0], v1 = acc[ai][bj][m][1]; ss += sq4(v0) + sq4(v1); *(u32x4*)(P + lr * 512 + 128 * bj) = pack8(v0, v1); }
                ss += __shfl_xor(ss, 16); ss += __shfl_xor(ss, 32); if (fq == 0) SQ[lr * 8] = ss; })
        } else if (pn == 1) {
            bf16_t* P = P0B + (size_t)u.pm * 256 * 512 + 256 + cw; float* SQ = SSQ + (size_t)u.pm * 256 * 8 + 4 + wc; bf16_t* KRb = KR + (size_t)b * SK * 32 + 8 * fq;
            const int axis = fq >> 1, sub = fq & 1;
            E1_ROWS({ const f32x4 v0 = acc[ai][0][m][0], v1 = acc[ai][0][m][1]; float ss = sq4(v0) + sq4(v1);
                *(u32x4*)(P + lr * 512) = pack8(v0, v1);
                ss += __shfl_xor(ss, 16); ss += __shfl_xor(ss, 32); if (fq == 0) SQ[lr * 8] = ss;
                f32x4 w0 = acc[ai][1][m][0], w1 = acc[ai][1][m][1];
                *(u32x4*)(P + lr * 512 + 128) = pack8(w0, w1);
                if (wc == 0) { const int kidx = isctx ? lr : 256 + t;
                    if (!isctx) { const int pos = axis ? (t & 63) : (t >> 6); const f32x4 c = *(const f32x4*)(cosM + pos * 8 + 4 * sub), s = *(const f32x4*)(sinM + pos * 8 + 4 * sub); rope4(w0, w1, c, s); }
                    *(u32x4*)(KRb + kidx * 32) = pack8(w0, w1); } })
        } else if (pn < 6) {
            const bool isq = pn < 4; const int h0 = 2 * (isq ? pn - 2 : pn - 4); const int axis = wc & 1;
            bf16_t* Qb = QD + (size_t)(b * 4 + h0) * SEQ * 128 + cw; bf16_t* Kb = KD + (size_t)(b * 4 + h0) * SK * 128 + cw;
            E1_ROWS({ const int kidx = isctx ? lr : 256 + t; const int pos = axis ? (t & 63) : (t >> 6);
                f32x4 c = {1.f, 1.f, 1.f, 1.f}, s = {0.f, 0.f, 0.f, 0.f};
                if (!isctx) { c = *(const f32x4*)(cosD + pos * 16 + 4 * fq); s = *(const f32x4*)(sinD + pos * 16 + 4 * fq); }
                _Pragma("unroll") for (int bj = 0; bj < 2; ++bj) { f32x4 v0 = acc[ai][bj][m][0], v1 = acc[ai][bj][m][1]; rope4(v0, v1, c, s);
                    if (isq) { v0 = v0 * DIFF_QS; v1 = v1 * DIFF_QS; *(u32x4*)(Qb + (bj * SEQ + t) * 128) = pack8(v0, v1); }
                    else *(u32x4*)(Kb + (bj * SK + kidx) * 128) = pack8(v0, v1); } })
        } else if (pn < 8) {
            bf16_t* Vb = VD + (size_t)(b * 4 + 2 * (pn - 6)) * SK * 128 + cw;
            E1_ROWS({ const int kidx = isctx ? lr : 256 + t;
                _Pragma("unroll") for (int bj = 0; bj < 2; ++bj) *(u32x4*)(Vb + (bj * SK + kidx) * 128) = pack8(acc[ai][bj][m][0], acc[ai][bj][m][1]); })
        } else {
            bf16_t* Gb = GT + (size_t)(u.pm - 4) * 256 * 2048 + (pn - 8) * 256 + cw;
            E1_ROWS({ (void)t;
                _Pragma("unroll") for (int bj = 0; bj < 2; ++bj) { f32x4 v0 = acc[ai][bj][m][0], v1 = acc[ai][bj][m][1];
                    #ifndef DBG_RAW_GATES
                    _Pragma("unroll") for (int j = 0; j < 4; ++j) { v0[j] = sigmoidf_(v0[j]); v1[j] = sigmoidf_(v1[j]); }
#endif

                    *(u32x4*)(Gb + lr * 2048 + 128 * bj) = pack8(v0, v1); } })
        }
#undef E1_ROWS
    }
};

struct SchedUQ {
    int G, c; const char* P0B; const char* WUQ;
    __device__ __forceinline__ bool next(int i, Unit& u) const { const int L = i * G + c; if (L >= 384) return false; u.pn = L % 3; u.pm = L / 3; u.aux = 0; return true; }
    __device__ __forceinline__ const char* a_ptr(const Unit& u) const { return P0B + ((size_t)(NCTX + 256 * u.pm) * 512) * 2; }
    __device__ __forceinline__ const char* b_ptr(const Unit& u) const { return WUQ + (size_t)u.pn * 256 * 256 * 2; }
};
struct EpiUQ {
    static constexpr bool PERM = true;
    const float* SSQ; bf16_t* QM; const float* rope;
    __device__ __forceinline__ bool keep(const Unit&) const { return false; }
    __device__ __forceinline__ void operator()(f32x4 (&acc)[2][2][4][2], const Unit& u, int wr, int wc, int fr, int fq) const {
        asm volatile("" : "+v"(fr), "+v"(fq));
        const int b = u.pm >> 5, tbase = (u.pm & 31) * 256; const float* cosM = rope + 4096; const float* sinM = rope + 5120;
        const float* SQ = SSQ + (size_t)(NCTX + u.pm * 256) * 8; bf16_t* Qb = QM + (size_t)b * 8 * SEQ * 96;
        int hh[2], dd[2];
#pragma unroll
        for (int bj = 0; bj < 2; ++bj) { const int c = 256 * u.pn + 128 * bj + 32 * wc + 8 * fq; hh[bj] = c / 96; dd[bj] = c - 96 * hh[bj]; }
#pragma unroll
        for (int ai = 0; ai < 2; ++ai)
#pragma unroll
            for (int m = 0; m < 4; ++m) {
                const int lr = 128 * ai + 64 * wr + 16 * m + fr; const int t = tbase + lr;
                const f32x4 sq = *(const f32x4*)(SQ + lr * 8);
                const float rs = fast_rsq(((sq[0] + sq[1]) + (sq[2] + sq[3])) * (1.0f / 256.0f) + EPS);
#pragma unroll
                for (int bj = 0; bj < 2; ++bj) { const int h = hh[bj], d = dd[bj];
                    f32x4 v0 = acc[ai][bj][m][0] * rs, v1 = acc[ai][bj][m][1] * rs;
                    if (d >= 64) { const int g = (d - 64) >> 3, axis = g >> 1, sub = g & 1; const int pos = axis ? (t & 63) : (t >> 6);
                        const f32x4 cc = *(const f32x4*)(cosM + pos * 8 + 4 * sub), ss = *(const f32x4*)(sinM + pos * 8 + 4 * sub); rope4(v0, v1, cc, ss); }
                    v0 = v0 * MLA_QS; v1 = v1 * MLA_QS;
                    *(u32x4*)(Qb + (h * SEQ + t) * 96 + d) = pack8(v0, v1); }
                asm volatile("" ::: "memory");
            }
    }
};
struct SchedUKV {
    int G, c; const char* P0B; const char* WUKV;
    __device__ __forceinline__ bool next(int i, Unit& u) const { const int L = i * G + c; if (L >= 528) return false; u.pn = L & 3; u.pm = L >> 2; u.aux = 0; return true; }
    __device__ __forceinline__ const char* a_ptr(const Unit& u) const { return P0B + ((size_t)(256 * u.pm) * 512 + 256) * 2; }
    __device__ __forceinline__ const char* b_ptr(const Unit& u) const { return WUKV + (size_t)u.pn * 256 * 256 * 2; }
};
struct EpiUKV {
    static constexpr bool PERM = true;
    const float* SSQ; const bf16_t* KR; bf16_t* KM; bf16_t* VM;
    __device__ __forceinline__ bool keep(const Unit&) const { return false; }
    __device__ __forceinline__ void operator()(f32x4 (&acc)[2][2][4][2], const Unit& u, int wr, int wc, int fr, int fq) const {
        asm volatile("" : "+v"(fr), "+v"(fq));
        const bool isctx = u.pm < 4; int b, tbase;
        if (isctx) { b = u.pm; tbase = 0; } else { const int lt = u.pm - 4; b = lt >> 5; tbase = 256 + (lt & 31) * 256; }
        const float* SQ = SSQ + (size_t)(u.pm * 256) * 8 + 4; const bf16_t* KRb = KR + (size_t)b * SK * 32 + 8 * fq;
        bf16_t* Kb = KM + (size_t)(b * 8 + 2 * u.pn) * SK * 96; bf16_t* Vb = VM + (size_t)(b * 8 + 2 * u.pn) * SK * 64;
#pragma unroll
        for (int ai = 0; ai < 2; ++ai)
#pragma unroll
            for (int m = 0; m < 4; ++m) {
                const int lr = 128 * ai + 64 * wr + 16 * m + fr; const int kidx = tbase + lr;
                const f32x4 sq = *(const f32x4*)(SQ + lr * 8);
                const float rs = fast_rsq(((sq[0] + sq[1]) + (sq[2] + sq[3])) * (1.0f / 128.0f) + EPS);
#pragma unroll
                for (int bj = 0; bj < 2; ++bj) { const int row = bj * SK + kidx;
                    const u32x4 w = pack8(acc[ai][bj][m][0] * rs, acc[ai][bj][m][1] * rs);
                    if (wc < 2) *(u32x4*)(Kb + row * 96 + 32 * wc + 8 * fq) = w; else *(u32x4*)(Vb + row * 64 + 32 * (wc - 2) + 8 * fq) = w;
                    if (wc == 0) *(u32x4*)(Kb + row * 96 + 64 + 8 * fq) = *(const u32x4*)(KRb + kidx * 32); }
                asm volatile("" ::: "memory");
            }
    }
};

struct SchedY {
    int G, c; const char* OA; const char* WOC;
    __device__ __forceinline__ bool next(int i, Unit& u) const { if (i >= 4) return false; const int T = (i >> 1) * G + c; if (T >= 512) return false;
        int pm, pn; static_order(T, 128, 4, pm, pn); u.pm = pm; u.pn = pn; u.aux = i & 1; return true; }
    __device__ __forceinline__ const char* a_ptr(const Unit& u) const { return OA + ((size_t)u.pm * 256 * 1024 + u.aux * 512) * 2; }
    __device__ __forceinline__ const char* b_ptr(const Unit& u) const { return WOC + ((size_t)u.pn * 256 * 1024 + u.aux * 512) * 2; }
};
struct EpiY {
    static constexpr bool PERM = true;
    const bf16_t* GT; bf16_t* Y;
    __device__ __forceinline__ bool keep(const Unit& u) const { return u.aux == 0; }
    __device__ __forceinline__ void operator()(f32x4 (&acc)[2][2][4][2], const Unit& u, int wr, int wc, int fr, int fq) const {
        asm volatile("" : "+v"(fr), "+v"(fq));
#pragma unroll
        for (int ai = 0; ai < 2; ++ai)
#pragma unroll
            for (int m = 0; m < 4; ++m) {
                const size_t rr = (size_t)u.pm * 256 + 128 * ai + 64 * wr + 16 * m + fr;
#pragma unroll
                for (int bj = 0; bj < 2; ++bj) { const int c = 256 * u.pn + 128 * bj + 32 * wc + 8 * fq;
                    const u32x4 gb = *(const u32x4*)(GT + rr * 2048 + 1024 + c);
                    f32x4 b0 = {bf_lo(gb.x), bf_hi(gb.x), bf_lo(gb.y), bf_hi(gb.y)}, b1 = {bf_lo(gb.z), bf_hi(gb.z), bf_lo(gb.w), bf_hi(gb.w)};
                    if (u.aux == 0) {
                        const u32x4 ga = *(const u32x4*)(GT + rr * 2048 + c);
                        const f32x4 a0 = {bf_lo(ga.x), bf_hi(ga.x), bf_lo(ga.y), bf_hi(ga.y)}, a1 = {bf_lo(ga.z), bf_hi(ga.z), bf_lo(ga.w), bf_hi(ga.w)};
#pragma unroll
                        for (int j = 0; j < 4; ++j) { acc[ai][bj][m][0][j] *= (b0[j] > 0.f ? a0[j] / b0[j] : 0.f); acc[ai][bj][m][1][j] *= (b1[j] > 0.f ? a1[j] / b1[j] : 0.f); }
                    } else {
                        *(u32x4*)(Y + rr * 1024 + c) = pack8(acc[ai][bj][m][0] * b0, acc[ai][bj][m][1] * b1);
                    } }
            }
    }
};

struct SchedZ {
    int G, c; const char* Y; const char* WOUT;
    __device__ __forceinline__ bool next(int i, Unit& u) const { const int L = i * G + c; if (L >= 512) return false; int pm, pn; static_order(L, 128, 4, pm, pn); u.pm = pm; u.pn = pn; u.aux = 0; return true; }
    __device__ __forceinline__ const char* a_ptr(const Unit& u) const { return Y + (size_t)u.pm * 256 * 1024 * 2; }
    __device__ __forceinline__ const char* b_ptr(const Unit& u) const { return WOUT + (size_t)u.pn * 256 * 1024 * 2; }
};
struct EpiZ {
    static constexpr bool PERM = false;
    const float* x; const float* mod; float* Z;
    __device__ __forceinline__ bool keep(const Unit&) const { return false; }
    __device__ __forceinline__ void operator()(f32x4 (&acc)[2][2][4][2], const Unit& u, int wr, int wc, int fr, int fq) const {
        asm volatile("" : "+v"(fr), "+v"(fq));
        const int b = u.pm >> 5; const float* g1 = mod + b * 6144 + 2048;
#pragma unroll
        for (int bj = 0; bj < 2; ++bj)
#pragma unroll
            for (int n = 0; n < 2; ++n) { const int c = 256 * u.pn + 128 * bj + 32 * wc + 16 * n + 4 * fq; const f32x4 gv = *(const f32x4*)(g1 + c);
#pragma unroll
                for (int ai = 0; ai < 2; ++ai)
#pragma unroll
                    for (int m = 0; m < 4; ++m) { const size_t rr = (size_t)u.pm * 256 + 128 * ai + 64 * wr + 16 * m + fr;
                        const f32x4 xv = *(const f32x4*)(x + rr * 1024 + c);
                        *(f32x4*)(Z + rr * 1024 + c) = xv * ALPHA + gv * acc[ai][bj][m][n]; } }
    }
};

struct SchedM1 {
    int xcd, slot; const char* XE; const char* W13;
    __device__ __forceinline__ bool next(int i, Unit& u) const { if (i >= 8) return false; const int e = 2 * xcd + (i >> 2), ap = (i & 3) * 4 + (slot >> 3);
        u.pn = slot & 7; u.pm = ((ap >> 2) * 16 + e) * 4 + (ap & 3); u.aux = e; return true; }
    __device__ __forceinline__ const char* a_ptr(const Unit& u) const { return XE + (size_t)u.pm * 256 * 1024 * 2; }
    __device__ __forceinline__ const char* b_ptr(const Unit& u) const { return W13 + ((size_t)u.aux * 2048 + u.pn * 256) * 1024 * 2; }
};
struct EpiM1 {
    static constexpr bool PERM = true;
    bf16_t* HID;
    __device__ __forceinline__ bool keep(const Unit&) const { return false; }
    __device__ __forceinline__ void operator()(f32x4 (&acc)[2][2][4][2], const Unit& u, int wr, int wc, int fr, int fq) const {
        asm volatile("" : "+v"(fr), "+v"(fq));
#pragma unroll
        for (int ai = 0; ai < 2; ++ai)
#pragma unroll
            for (int m = 0; m < 4; ++m) { const size_t row = (size_t)u.pm * 256 + 128 * ai + 64 * wr + 16 * m + fr;
                f32x4 h0, h1;
#pragma unroll
                for (int j = 0; j < 4; ++j) { const float a0 = acc[ai][0][m][0][j], a1 = acc[ai][0][m][1][j];
                    h0[j] = a0 * sigmoidf_(a0) * acc[ai][1][m][0][j]; h1[j] = a1 * sigmoidf_(a1) * acc[ai][1][m][1][j]; }
                *(u32x4*)(HID + row * 1024 + 128 * u.pn + 32 * wc + 8 * fq) = pack8(h0, h1); }
    }
};
struct SchedM2 {
    int xcd, slot; const char* HID; const char* W2T;
    __device__ __forceinline__ bool next(int i, Unit& u) const { if (i >= 4) return false; const int e = 2 * xcd + (i >> 1), ap = (i & 1) * 8 + (slot >> 2);
        u.pn = slot & 3; u.pm = ((ap >> 2) * 16 + e) * 4 + (ap & 3); u.aux = e; return true; }
    __device__ __forceinline__ const char* a_ptr(const Unit& u) const { return HID + (size_t)u.pm * 256 * 1024 * 2; }
    __device__ __forceinline__ const char* b_ptr(const Unit& u) const { return W2T + ((size_t)u.aux * 1024 + u.pn * 256) * 1024 * 2; }
};
struct EpiM2 {
    static constexpr bool PERM = true;
    const float* GSEL; bf16_t* YE;
    __device__ __forceinline__ bool keep(const Unit&) const { return false; }
    __device__ __forceinline__ void operator()(f32x4 (&acc)[2][2][4][2], const Unit& u, int wr, int wc, int fr, int fq) const {
        asm volatile("" : "+v"(fr), "+v"(fq));
#pragma unroll
        for (int ai = 0; ai < 2; ++ai)
#pragma unroll
            for (int m = 0; m < 4; ++m) { const size_t row = (size_t)u.pm * 256 + 128 * ai + 64 * wr + 16 * m + fr; const float g = GSEL[row];
#pragma unroll
                for (int bj = 0; bj < 2; ++bj)
                    *(u32x4*)(YE + row * 1024 + 256 * u.pn + 128 * bj + 32 * wc + 8 * fq) = pack8(acc[ai][bj][m][0] * g, acc[ai][bj][m][1] * g); }
    }
};

struct SchedU {
    SchedUQ q; SchedUKV kv; int G, c;
    __device__ __forceinline__ bool next(int i, Unit& u) const { const int L = i * G + c; if (L >= 912) return false;
        if (L < 384) { u.pn = L % 3; u.pm = L / 3; u.aux = 0; } else { const int L2 = L - 384; u.pn = L2 & 3; u.pm = L2 >> 2; u.aux = 1; } return true; }
    __device__ __forceinline__ const char* a_ptr(const Unit& u) const { return u.aux == 0 ? q.a_ptr(u) : kv.a_ptr(u); }
    __device__ __forceinline__ const char* b_ptr(const Unit& u) const { return u.aux == 0 ? q.b_ptr(u) : kv.b_ptr(u); }
};
struct EpiU {
    static constexpr bool PERM = true;
    EpiUQ q; EpiUKV kv;
    __device__ __forceinline__ bool keep(const Unit&) const { return false; }
    __device__ __forceinline__ void operator()(f32x4 (&acc)[2][2][4][2], const Unit& u, int wr, int wc, int fr, int fq) const {
        if (u.aux == 0) q(acc, u, wr, wc, fr, fq); else kv(acc, u, wr, wc, fr, fq);
    }
};
namespace fa {
#define KSWZ(row, colB) ((row) * 256 + ((colB) ^ (((row) & 7) << 4)))
#define SBAR() __builtin_amdgcn_sched_barrier(0)
__device__ __forceinline__ int crow(int r, int hi) { return (r & 3) + 8 * (r >> 2) + 4 * hi; }
constexpr float THRL = 11.0f;
constexpr int VOFF = 0, KOFF = 32768, BUFB = 16384, WSOFF = 131072;

__device__ __forceinline__ void partialSM(f32x16& p0, f32x16& p1, float& m_reg, float& alpha) {
    float pmax = p0[0];
#pragma unroll
    for (int r = 1; r < 16; ++r) pmax = fmaxf(pmax, p0[r]);
#pragma unroll
    for (int r = 0; r < 16; ++r) pmax = fmaxf(pmax, p1[r]);
    { auto rr = __builtin_amdgcn_permlane32_swap(__float_as_uint(pmax), __float_as_uint(pmax), false, false);
      pmax = fmaxf(__uint_as_float(rr[0]), __uint_as_float(rr[1])); }
    float mn;
    if (__builtin_expect(__all(pmax - m_reg <= THRL), 1)) { mn = m_reg; alpha = 1.f; }
    else { mn = fmaxf(m_reg, pmax); alpha = fast_exp2(m_reg - mn); m_reg = mn; }
#pragma unroll
    for (int r = 0; r < 16; ++r) { p0[r] -= mn; p1[r] -= mn; }
#pragma unroll
    for (int r = 0; r < 16; ++r) p0[r] = fast_exp2(p0[r]);
}
__device__ __forceinline__ void finishSM(f32x16& p0, f32x16& p1, float alpha, float& l_reg, bf16x8& pa0, bf16x8& pa1, bf16x8& pa2, bf16x8& pa3) {
#pragma unroll
    for (int r = 0; r < 16; ++r) p1[r] = fast_exp2(p1[r]);
    float ps = 0.f;
#pragma unroll
    for (int r = 0; r < 16; ++r) ps += p0[r];
#pragma unroll
    for (int r = 0; r < 16; ++r) ps += p1[r];
    { auto rr = __builtin_amdgcn_permlane32_swap(__float_as_uint(ps), __float_as_uint(ps), false, false);
      ps = __uint_as_float(rr[0]) + __uint_as_float(rr[1]); }
    l_reg = l_reg * alpha + ps;
#define PK4(P, BASE, OUT) do { unsigned a0 = cvt_pk_bf16(P[BASE + 0], P[BASE + 1]), a1 = cvt_pk_bf16(P[BASE + 2], P[BASE + 3]);   \
    unsigned b0 = cvt_pk_bf16(P[BASE + 4], P[BASE + 5]), b1 = cvt_pk_bf16(P[BASE + 6], P[BASE + 7]);                              \
    auto r0 = __builtin_amdgcn_permlane32_swap(a0, b0, false, false); auto r1 = __builtin_amdgcn_permlane32_swap(a1, b1, false, false); \
    u32x4 w = {r0[0], r1[0], r0[1], r1[1]}; OUT = __builtin_bit_cast(bf16x8, w); } while (0)
    PK4(p0, 0, pa0); PK4(p0, 8, pa1); PK4(p1, 0, pa2); PK4(p1, 8, pa3);
#undef PK4
}
template <int NQ>
__device__ __forceinline__ void qkt(f32x16& p0, f32x16& p1, const LAS unsigned char* Ks, const bf16x8* qr, int r32, int hi, int kcolB) {
    p0 = f32x16{}; p1 = f32x16{};
#pragma unroll
    for (int d0 = 0; d0 < NQ; ++d0) { const int cb = kcolB + (d0 * 16 + hi * 8) * 2;
        const bf16x8 b0 = *(const LAS bf16x8*)(Ks + KSWZ(r32, cb));
        const bf16x8 b1 = *(const LAS bf16x8*)(Ks + KSWZ(32 + r32, cb));
        p0 = __builtin_amdgcn_mfma_f32_32x32x16_bf16(b0, qr[d0], p0, 0, 0, 0);
        p1 = __builtin_amdgcn_mfma_f32_32x32x16_bf16(b1, qr[d0], p1, 0, 0, 0); }
}
template <int NCB> __device__ __forceinline__ int v_st(int k, int c) { const int kk = (k & ~0xC) | ((k & 4) << 1) | ((k & 8) >> 1); return ((kk >> 3) * NCB + (c >> 5)) * 512 + ((kk & 7) * 32 + (c & 31)) * 2; }
__device__ __forceinline__ int v_rd_base(int lane) { return ((lane & 3) << 3) | (((lane >> 2) & 3) << 6) | (((lane >> 4) & 1) << 5) | (((lane >> 5) & 1) << 8); }
template <int OFF> __device__ __forceinline__ s16x4 tr_read(int vb) {
    s16x4 r; asm volatile("ds_read_b64_tr_b16 %0, %1 offset:%2" : "=&v"(r) : "v"(vb), "i"(OFF) : "memory"); return r;
}
template <int NCB, int D0> __device__ __forceinline__ void pv_one(f32x16& od, int vb, bf16x8 pa0, bf16x8 pa1, bf16x8 pa2, bf16x8 pa3) {
#define VO(ks, half) (D0 * 512 + (ks) * (1024 * NCB) + (half) * (512 * NCB))
    const s16x4 l0 = tr_read<VO(0, 0)>(vb), h0 = tr_read<VO(0, 1)>(vb), l1 = tr_read<VO(1, 0)>(vb), h1 = tr_read<VO(1, 1)>(vb);
    const s16x4 l2 = tr_read<VO(2, 0)>(vb), h2 = tr_read<VO(2, 1)>(vb), l3 = tr_read<VO(3, 0)>(vb), h3 = tr_read<VO(3, 1)>(vb);
#undef VO
    asm volatile("s_waitcnt lgkmcnt(0)" ::: "memory"); SBAR();
#define PK(L, H) (bf16x8){L[0], L[1], L[2], L[3], H[0], H[1], H[2], H[3]}
    od = __builtin_amdgcn_mfma_f32_32x32x16_bf16(pa0, PK(l0, h0), od, 0, 0, 0);
    od = __builtin_amdgcn_mfma_f32_32x32x16_bf16(pa1, PK(l1, h1), od, 0, 0, 0);
    od = __builtin_amdgcn_mfma_f32_32x32x16_bf16(pa2, PK(l2, h2), od, 0, 0, 0);
    od = __builtin_amdgcn_mfma_f32_32x32x16_bf16(pa3, PK(l3, h3), od, 0, 0, 0);
#undef PK
}
template <int NCB> __device__ __forceinline__ void pv_all(f32x16* o, int vb, bf16x8 pa0, bf16x8 pa1, bf16x8 pa2, bf16x8 pa3) {
    pv_one<NCB, 0>(o[0], vb, pa0, pa1, pa2, pa3); pv_one<NCB, 1>(o[1], vb, pa0, pa1, pa2, pa3);
    if constexpr (NCB == 4) { pv_one<NCB, 2>(o[2], vb, pa0, pa1, pa2, pa3); pv_one<NCB, 3>(o[3], vb, pa0, pa1, pa2, pa3); }
}

template <int MODE>
__device__ __forceinline__ void attn_unit(LAS unsigned char* lds, const bf16_t* __restrict__ Qu, const bf16_t* __restrict__ Kh, const bf16_t* __restrict__ Vh, bf16_t* Ou,
                                          float lam, const float* __restrict__ gsub) {
    constexpr int DQK = MODE ? 64 : 96, DV = MODE ? 128 : 64, LDQ = MODE ? 128 : 96, LDK = MODE ? 128 : 96, LDV = DV;
    constexpr int KCPR = LDK / 8, VCPR = LDV / 8, NKCH = 64 * KCPR, NCH = NKCH + 64 * VCPR, NLD = (NCH + 511) / 512, NCB = DV / 32, NQ = DQK / 16, NT = SK / 64;
    int tid_ = threadIdx.x; asm volatile("" : "+v"(tid_));
    const int tid = tid_, wid = __builtin_amdgcn_readfirstlane(tid >> 6), lane = tid & 63, r32 = lane & 31, hi = lane >> 5;
    const int mp = MODE ? (wid >> 2) : 0, qw = MODE ? (wid & 3) : wid;
    LAS float* ws = (LAS float*)(lds + WSOFF) + wid * 64; LAS float* li_l = ws; LAS float* al_l = ws + 32;
    float m_reg = -1e30f, l_reg = 0.f; f32x16 o[NCB]; bf16x8 qr[NQ];
#pragma unroll
    for (int d = 0; d < NCB; ++d) o[d] = f32x16{};
    { const bf16_t* Qw = Qu + (size_t)(qw * 32 + r32) * LDQ + mp * 64 + hi * 8;
#pragma unroll
      for (int d0 = 0; d0 < NQ; ++d0) qr[d0] = *(const bf16x8*)(Qw + d0 * 16); }
    const bf16_t* sp[NLD]; int tstep[NLD], dst[NLD];
#pragma unroll
    for (int i = 0; i < NLD; ++i) { int c = tid + 512 * i; if (c >= NCH) c -= NCH;
        if (c < NKCH) { const int row = c / KCPR, ch = c % KCPR; sp[i] = Kh + row * LDK + ch * 8; tstep[i] = 64 * LDK; dst[i] = KOFF + KSWZ(row, ch * 16); }
        else { const int c2 = c - NKCH; const int row = c2 / VCPR, ch = c2 % VCPR; sp[i] = Vh + row * LDV + ch * 8; tstep[i] = 64 * LDV; dst[i] = VOFF + v_st<NCB>(row, ch * 8); } }
    const int vb0 = (int)(uintptr_t)(lds + VOFF) + v_rd_base(lane);
    const int kcolB = mp * 128;
    bf16x8 sr_[2][NLD];
#define SLOAD(s, t) do { _Pragma("unroll") for (int i_ = 0; i_ < NLD; ++i_) sr_[s][i_] = *(const bf16x8*)(sp[i_] + (size_t)(t) * tstep[i_]); } while (0)
#define SWRITE(b, s) do { _Pragma("unroll") for (int i_ = 0; i_ < NLD; ++i_) *(LAS bf16x8*)(lds + (b) * BUFB + dst[i_]) = sr_[s][i_]; } while (0)
#define SWAIT() asm volatile("s_waitcnt vmcnt(%0)" :: "n"(NLD) : "memory")
#define RESC(a) do { if (__any((a) < 1.f)) { if (hi == 0) al_l[r32] = (a); asm volatile("s_waitcnt lgkmcnt(0)" ::: "memory"); \
    _Pragma("unroll") for (int d = 0; d < NCB; ++d) _Pragma("unroll") for (int r = 0; r < 16; ++r) o[d][r] *= al_l[crow(r, hi)]; } } while (0)
    f32x16 pA0, pA1, pB0, pB1; float alA, alB; bf16x8 pa0, pa1, pa2, pa3;
    __syncthreads();
    SLOAD(0, 0); asm volatile("s_waitcnt vmcnt(0)" ::: "memory"); SWRITE(0, 0); __syncthreads();
    qkt<NQ>(pA0, pA1, lds + KOFF, qr, r32, hi, kcolB); partialSM(pA0, pA1, m_reg, alA);
    SLOAD(1, 1); SLOAD(0, 2);
    SWAIT(); SWRITE(1, 1); __syncthreads();
    for (int j = 1; j + 1 < NT; j += 2) {
        SBAR(); qkt<NQ>(pB0, pB1, lds + KOFF + BUFB, qr, r32, hi, kcolB);
        finishSM(pA0, pA1, alA, l_reg, pa0, pa1, pa2, pa3); SBAR();
        SLOAD(1, j + 2); SBAR();
        pv_all<NCB>(o, vb0, pa0, pa1, pa2, pa3); partialSM(pB0, pB1, m_reg, alB);
        __syncthreads(); SWAIT(); SWRITE(0, 0);
        RESC(alB); __syncthreads();
        SBAR(); qkt<NQ>(pA0, pA1, lds + KOFF, qr, r32, hi, kcolB);
        finishSM(pB0, pB1, alB, l_reg, pa0, pa1, pa2, pa3); SBAR();
        if (j + 3 < NT) SLOAD(0, j + 3); SBAR();
        pv_all<NCB>(o, vb0 + BUFB, pa0, pa1, pa2, pa3); partialSM(pA0, pA1, m_reg, alA);
        __syncthreads(); SWAIT(); SWRITE(1, 1);
        RESC(alA); __syncthreads();
    }
    SBAR(); qkt<NQ>(pB0, pB1, lds + KOFF + BUFB, qr, r32, hi, kcolB);
    finishSM(pA0, pA1, alA, l_reg, pa0, pa1, pa2, pa3); SBAR();
    pv_all<NCB>(o, vb0, pa0, pa1, pa2, pa3); partialSM(pB0, pB1, m_reg, alB);
    __syncthreads(); RESC(alB);
    finishSM(pB0, pB1, alB, l_reg, pa0, pa1, pa2, pa3); SBAR();
    pv_all<NCB>(o, vb0 + BUFB, pa0, pa1, pa2, pa3);
    if (hi == 0) li_l[r32] = l_reg; asm volatile("s_waitcnt lgkmcnt(0)" ::: "memory");
    float rli[16];
#pragma unroll
    for (int r = 0; r < 16; ++r) rli[r] = fast_rcp(li_l[crow(r, hi)]);
    if constexpr (MODE == 0) {
        bf16_t* Ow = Ou + (size_t)(wid * 32) * 1024;
#pragma unroll
        for (int r = 0; r < 16; ++r) { const int orow = crow(r, hi);
#pragma unroll
            for (int d0 = 0; d0 < NCB; ++d0) Ow[(size_t)orow * 1024 + d0 * 32 + r32] = (bf16_t)(cvt_pk_bf16(o[d0][r] * rli[r], 0.f) & 0xffffu); }
    } else {
        __syncthreads();
        LAS float* Ost = (LAS float*)lds;
#pragma unroll
        for (int r = 0; r < 16; ++r) { const int row = mp * 128 + qw * 32 + crow(r, hi);
#pragma unroll
            for (int d0 = 0; d0 < NCB; ++d0) Ost[row * 128 + d0 * 32 + r32] = o[d0][r] * rli[r]; }
        __syncthreads();
        const float g0 = gsub[2 * lane], g1 = gsub[2 * lane + 1];
#pragma unroll 4
        for (int k = 0; k < 16; ++k) { const int row = wid * 16 + k;
            const f32x2 a = *(const LAS f32x2*)(Ost + row * 128 + 2 * lane), b2 = *(const LAS f32x2*)(Ost + (128 + row) * 128 + 2 * lane);
            const float d0 = a.x - lam * b2.x, d1 = a.y - lam * b2.y;
            const float ss = wave_sum(d0 * d0 + d1 * d1);
            const float rs = (fast_rsq(ss * (1.0f / 128.0f) + EPS)) * (1.0f - LAMBDA_INIT);
            *(unsigned*)(Ou + (size_t)row * 1024 + 2 * lane) = cvt_pk_bf16(d0 * rs * g0, d1 * rs * g1); }
    }
#undef SLOAD
#undef SWRITE
#undef SWAIT
#undef RESC
}
#undef KSWZ
#undef SBAR
}

__device__ __forceinline__ void attn_phase(const Ctx& C, unsigned char* ws, const float* gsub) {
    const bf16_t* QM = (const bf16_t*)(ws + WS_QM); const bf16_t* KM = (const bf16_t*)(ws + WS_KM); const bf16_t* VM = (const bf16_t*)(ws + WS_VM);
    const bf16_t* QD = (const bf16_t*)(ws + WS_QD); const bf16_t* KD = (const bf16_t*)(ws + WS_KD); const bf16_t* VD = (const bf16_t*)(ws + WS_VD);
    bf16_t* OA = (bf16_t*)(ws + WS_OA);
    const float lam = *(const float*)(ws + WS_LAM);
    for (int r = 0; r < 4; ++r) {
        const int bh = C.xcd * 4 + r, b = bh >> 3, h = bh & 7, qb = C.slot;
        fa::attn_unit<0>(C.lds, QM + ((size_t)bh * SEQ + qb * 256) * 96, KM + (size_t)bh * SK * 96, VM + (size_t)bh * SK * 64,
                         OA + ((size_t)b * SEQ + qb * 256) * 1024 + h * 64, lam, gsub);
    }
    for (int r = 0; r < 4; ++r) {
        const int bh = C.xcd * 2 + (r >> 1), b = bh >> 2, h = bh & 3, qb = (r & 1) * 32 + C.slot;
        fa::attn_unit<1>(C.lds, QD + ((size_t)bh * SEQ + qb * 128) * 128, KD + (size_t)bh * SK * 128, VD + (size_t)bh * SK * 128,
                         OA + ((size_t)b * SEQ + qb * 128) * 1024 + 512 + h * 128, lam, gsub);
    }
    __syncthreads();
}

#if MK_NAIVE_ATTN
template <int MODE>
__global__ __launch_bounds__(256) void naive_attn(const bf16_t* __restrict__ Q, const bf16_t* __restrict__ K, const bf16_t* __restrict__ V, bf16_t* __restrict__ OA,
                                                  const float* __restrict__ lamp, const float* __restrict__ gsub) {
    constexpr int NH = MODE ? 4 : 8, DQK = MODE ? 64 : 96, LDQ = MODE ? 128 : 96, LDK = LDQ, DV = MODE ? 128 : 64, NMAP = MODE ? 2 : 1;
    const int lane = threadIdx.x & 63; const long gw = (long)blockIdx.x * 4 + (threadIdx.x >> 6);
    const int q = (int)(gw % SEQ); const int bh = (int)(gw / SEQ); const int b = bh / NH, h = bh % NH;
    const bf16_t* Qrow = Q + ((size_t)bh * SEQ + q) * LDQ; const bf16_t* Kh = K + (size_t)bh * SK * LDK; const bf16_t* Vh = V + (size_t)bh * SK * DV;
    float res0 = 0.f, res1 = 0.f; const float lam = *lamp;
    for (int mp = 0; mp < NMAP; ++mp) {
        u32x4 qp[DQK / 8];
#pragma unroll
        for (int i = 0; i < DQK / 8; ++i) qp[i] = *(const u32x4*)(Qrow + mp * 64 + 8 * i);
        float m = -1e30f, l = 0.f, acc0 = 0.f, acc1 = 0.f;
        for (int t = 0; t < SK / 64; ++t) {
            const bf16_t* kr = Kh + (size_t)(t * 64 + lane) * LDK + mp * 64; float s = 0.f;
#pragma unroll
            for (int i = 0; i < DQK / 8; ++i) { const u32x4 kv = *(const u32x4*)(kr + 8 * i);
                s += bf_lo(qp[i].x) * bf_lo(kv.x) + bf_hi(qp[i].x) * bf_hi(kv.x) + bf_lo(qp[i].y) * bf_lo(kv.y) + bf_hi(qp[i].y) * bf_hi(kv.y)
                   + bf_lo(qp[i].z) * bf_lo(kv.z) + bf_hi(qp[i].z) * bf_hi(kv.z) + bf_lo(qp[i].w) * bf_lo(kv.w) + bf_hi(qp[i].w) * bf_hi(kv.w); }
            const float mn = fmaxf(m, wave_max(s)); const float alpha = exp2f(m - mn); const float p = exp2f(s - mn);
            l = l * alpha + wave_sum(p); acc0 *= alpha; acc1 *= alpha; m = mn;
            for (int kk = 0; kk < 64; ++kk) { const float pk = __shfl(p, kk); const bf16_t* vr = Vh + (size_t)(t * 64 + kk) * DV;
                acc0 += pk * bf2f(vr[lane]); if (DV == 128) acc1 += pk * bf2f(vr[64 + lane]); }
        }
        const float il = 1.0f / l;
        if (mp == 0) { res0 = acc0 * il; res1 = acc1 * il; } else { res0 -= lam * acc0 * il; res1 -= lam * acc1 * il; }
    }
    if (MODE == 0) { OA[((size_t)b * SEQ + q) * 1024 + h * 64 + lane] = (bf16_t)(cvt_pk_bf16(res0, 0.f) & 0xffffu); }
    else { const float ss = wave_sum(res0 * res0 + res1 * res1); const float rs = (fast_rsq(ss * (1.0f / 128.0f) + EPS)) * (1.0f - LAMBDA_INIT);
        bf16_t* o = OA + ((size_t)b * SEQ + q) * 1024 + 512 + h * 128;
        o[lane] = (bf16_t)(cvt_pk_bf16(res0 * rs * gsub[lane], 0.f) & 0xffffu); o[64 + lane] = (bf16_t)(cvt_pk_bf16(res1 * rs * gsub[64 + lane], 0.f) & 0xffffu); }
}
#endif
__device__ __forceinline__ int invperm64(int d) { const int a = d >> 5, half = (d >> 4) & 1, i = d & 15; return (a * 4 + (i >> 2)) * 8 + half * 4 + (i & 3); }
__device__ __forceinline__ int invperm32(int d) { const int a = d >> 4, half = (d >> 3) & 1, i = d & 7; return (a * 2 + (i >> 2)) * 8 + half * 4 + (i & 3); }
struct MapWin { __device__ __forceinline__ int operator()(int n) const {
    if (n < 384) return n;
    if (n < 416) return 384 + invperm32(n - 384);
    if (n < 1440) { const int isk = n >= 928; const int rel = n - (isk ? 928 : 416); return (isk ? 1024 : 512) + (rel & ~63) + invperm64(rel & 63); }
    if (n < 1952) return 1536 + (n - 1440);
    return 2048 + (n - 1952); } };
struct MapUq { __device__ __forceinline__ int operator()(int n) const { const int h = n / 96, d = n - 96 * h; return d < 64 ? n : h * 96 + 64 + invperm32(d - 64); } };
struct MapId { int off; __device__ __forceinline__ int operator()(int n) const { return off + n; } };
struct MapW13 { int off; __device__ __forceinline__ int operator()(int f) const { return off + (f >> 7) * 256 + (f & 127); } };

template <class RM>
__device__ __forceinline__ void tr_item(const float* __restrict__ W, int ldw, int k0, int n0, bf16_t* WT, int ldt, int kdst0, const float* kscale, RM rm, LAS float* scr, int lane) {
#pragma unroll 8
    for (int i = 0; i < 32; ++i) { const int kk = 2 * i + (lane >> 5); float v = W[(size_t)(k0 + kk) * ldw + n0 + (lane & 31)]; if (kscale) v *= kscale[k0 + kk]; scr[kk * 33 + (lane & 31)] = v; }
    asm volatile("s_waitcnt lgkmcnt(0)" ::: "memory");
    const int c = lane & 7;
#pragma unroll
    for (int j = 0; j < 4; ++j) { const int n = (lane >> 3) + 8 * j; const LAS float* s = scr + (8 * c) * 33 + n;
        u32x4 o; o.x = cvt_pk_bf16(s[0 * 33], s[1 * 33]); o.y = cvt_pk_bf16(s[2 * 33], s[3 * 33]); o.z = cvt_pk_bf16(s[4 * 33], s[5 * 33]); o.w = cvt_pk_bf16(s[6 * 33], s[7 * 33]);
        *(u32x4*)(WT + (size_t)rm(n0 + n) * ldt + kdst0 + k0 + 8 * c) = o; }
    asm volatile("s_waitcnt lgkmcnt(0)" ::: "memory");
}

__device__ __forceinline__ void p0_prologue(const Ctx& C0, const Args& A) {
    Ctx C = C0; C.tid = threadIdx.x; asm volatile("" : "+v"(C.tid)); C.lane = C.tid & 63;
    unsigned char* ws = A.ws;
    const float* cvec = A.in[1]; const float* cctx = A.in[3]; const float* w_ada = A.in[4]; const float* b_ada = A.in[5];
    if (C.vcu < 96) {
        const int col = C.vcu * 64 + C.lane; float acc[5] = {0.f, 0.f, 0.f, 0.f, 0.f};
        for (int k = C.wave * 128; k < C.wave * 128 + 128; ++k) { const float wv = w_ada[(size_t)k * 6144 + col];
#pragma unroll
            for (int r = 0; r < 5; ++r) { const float cv = (r < 4) ? cvec[r * 1024 + k] : cctx[k]; acc[r] += cv * sigmoidf_(cv) * wv; } }
        LAS float* red = (LAS float*)(C.lds + 73728);
#pragma unroll
        for (int r = 0; r < 5; ++r) red[(C.wave * 5 + r) * 64 + C.lane] = acc[r];
        __syncthreads();
        if (C.tid < 320) { const int r = C.tid >> 6, l = C.tid & 63; float s = 0.f;
#pragma unroll
            for (int w = 0; w < 8; ++w) s += red[(w * 5 + r) * 64 + l];
            ((float*)(ws + WS_MOD))[r * 6144 + C.vcu * 64 + l] = s + b_ada[C.vcu * 64 + l]; }
        __syncthreads();
    }
    if (C.vcu == C.G - 1) {
        float* rope = (float*)(ws + WS_ROPE);
        for (int i = C.tid; i < 2048; i += NTHR) { const int pos = i >> 4, f = i & 15; const float inv = exp2f(-(float)f * (13.287712379549449f / 16.0f)); const float ang = (float)pos * inv;
            rope[i] = cosf(ang); rope[2048 + i] = sinf(ang); }
        for (int i = C.tid; i < 1024; i += NTHR) { const int pos = i >> 3, f = i & 7; const float inv = exp2f(-(float)f * (13.287712379549449f / 8.0f)); const float ang = (float)pos * inv;
            rope[4096 + i] = cosf(ang); rope[5120 + i] = sinf(ang); }
        if (C.wave == 0) { const float* dl = A.in[12]; const float s1 = wave_sum(dl[C.lane] * dl[64 + C.lane]), s2 = wave_sum(dl[128 + C.lane] * dl[192 + C.lane]);
            if (C.lane == 0) *(float*)(ws + WS_LAM) = expf(s1) - expf(s2) + LAMBDA_INIT; }
    }
    LAS float* scr = (LAS float*)(C.lds + C.wave * 8448);
    const int gw = C.vcu * NWAVES + C.wave, NGW = C.G * NWAVES;
    constexpr int I_IN = 16 * 125, I_UQ = 4 * 24, I_UKV = 2 * 32, I_OM = 8 * 32, I_OD = 8 * 32, I_OUT = 16 * 32, I_E = 16 * 16 * 32;
    constexpr int NITEMS = I_IN + I_UQ + I_UKV + I_OM + I_OD + I_OUT + 3 * I_E;
    for (int it = gw; it < NITEMS; it += NGW) {
        int r = it;
        if (r < I_IN) { tr_item(A.in[6], NIN, 64 * (r / 125), 32 * (r % 125), (bf16_t*)(ws + WS_WIN), 1024, 0, nullptr, MapWin{}, scr, C.lane); continue; } r -= I_IN;
        if (r < I_UQ) { tr_item(A.in[8], 768, 64 * (r / 24), 32 * (r % 24), (bf16_t*)(ws + WS_WUQ), 256, 0, A.in[7], MapUq{}, scr, C.lane); continue; } r -= I_UQ;
        if (r < I_UKV) { tr_item(A.in[10], 1024, 64 * (r / 32), 32 * (r % 32), (bf16_t*)(ws + WS_WUKV), 256, 0, A.in[9], MapId{0}, scr, C.lane); continue; } r -= I_UKV;
        if (r < I_OM) { tr_item(A.in[11], 1024, 64 * (r / 32), 32 * (r % 32), (bf16_t*)(ws + WS_WOC), 1024, 0, nullptr, MapId{0}, scr, C.lane); continue; } r -= I_OM;
        if (r < I_OD) { tr_item(A.in[14], 1024, 64 * (r / 32), 32 * (r % 32), (bf16_t*)(ws + WS_WOC), 1024, 512, nullptr, MapId{0}, scr, C.lane); continue; } r -= I_OD;
        if (r < I_OUT) { tr_item(A.in[15], 1024, 64 * (r / 32), 32 * (r % 32), (bf16_t*)(ws + WS_WOUT), 1024, 0, nullptr, MapId{0}, scr, C.lane); continue; } r -= I_OUT;
        const int which = r / I_E; r -= which * I_E; const int e = r / 512, q = r % 512;
        if (which == 0) tr_item(A.in[20] + (size_t)e * 1024 * 1024, 1024, 64 * (q / 32), 32 * (q % 32), (bf16_t*)(ws + WS_W13), 1024, 0, nullptr, MapW13{e * 2048}, scr, C.lane);
        else if (which == 1) tr_item(A.in[21] + (size_t)e * 1024 * 1024, 1024, 64 * (q / 32), 32 * (q % 32), (bf16_t*)(ws + WS_W13), 1024, 0, nullptr, MapW13{e * 2048 + 128}, scr, C.lane);
        else tr_item(A.in[22] + (size_t)e * 1024 * 1024, 1024, 64 * (q / 32), 32 * (q % 32), (bf16_t*)(ws + WS_W2T), 1024, 0, nullptr, MapId{e * 1024}, scr, C.lane);
    }
    const int gt = C.vcu * NTHR + C.tid, NGT = C.G * NTHR; const u32x4 z4 = {0u, 0u, 0u, 0u};
    for (int i = gt; i < 96 * 128; i += NGT) *(u32x4*)(ws + WS_WIN + (size_t)416 * 2048 + (size_t)i * 16) = z4;
    for (int i = gt; i < 1024 * 16; i += NGT) *(u32x4*)(ws + WS_WUKV + (size_t)(i >> 4) * 512 + 256 + (size_t)(i & 15) * 16) = z4;
}

__device__ __forceinline__ void p0b_modulate(const Ctx& C0, const Args& A) {
    Ctx C = C0; C.tid = threadIdx.x; asm volatile("" : "+v"(C.tid)); C.lane = C.tid & 63;
    const float* mod = (const float*)(A.ws + WS_MOD); bf16_t* A1 = (bf16_t*)(A.ws + WS_A1);
    const int gw = C.vcu * NWAVES + C.wave, NGW = C.G * NWAVES;
    for (int r = gw; r < MTOT; r += NGW) {
        const float* src = r < NCTX ? A.in[2] + (size_t)r * 1024 : A.in[0] + (size_t)(r - NCTX) * 1024;
        const float* sh = mod + (r < NCTX ? 4 : ((r - NCTX) >> 13)) * 6144; const float* sc = sh + 1024;
#pragma unroll
        for (int j = 0; j < 4; ++j) { const int d = 4 * C.lane + 256 * j; const f32x4 v = *(const f32x4*)(src + d), s = *(const f32x4*)(sc + d), h = *(const f32x4*)(sh + d);
            const f32x4 o = v * (s + 1.0f) + h; u32x2 w; w.x = cvt_pk_bf16(o[0], o[1]); w.y = cvt_pk_bf16(o[2], o[3]);
            *(u32x2*)(A1 + (size_t)r * 1024 + d) = w; }
    }
}

__device__ __forceinline__ void p4_ln_router(const Ctx& C0, const Args& A) {
    Ctx C = C0; C.tid = threadIdx.x; asm volatile("" : "+v"(C.tid)); C.lane = C.tid & 63;
    float* Z = A.out; bf16_t* H2 = (bf16_t*)(A.ws + WS_H2); float* aff = (float*)(A.ws + WS_AFF); const float* mod = (const float*)(A.ws + WS_MOD);
    LAS float* wrt = (LAS float*)C.lds;
    for (int i = C.tid; i < 16384; i += NTHR) wrt[(i & 15) * 1024 + (i >> 4)] = A.in[18][i];
    __syncthreads();
    f32x4 lg[4], lb[4];
#pragma unroll
    for (int j = 0; j < 4; ++j) { lg[j] = *(const f32x4*)(A.in[16] + 4 * C.lane + 256 * j); lb[j] = *(const f32x4*)(A.in[17] + 4 * C.lane + 256 * j); }
    const int gw = C.vcu * NWAVES + C.wave, NGW = C.G * NWAVES;
    for (int row = gw; row < NLAT; row += NGW) {
        const int b = row >> 13, n = row & 8191; float* zr = Z + (size_t)row * 1024; const float* sh2 = mod + b * 6144 + 3 * 1024; const float* sc2 = mod + b * 6144 + 4 * 1024;
        f32x4 v[4]; float s = 0.f;
#pragma unroll
        for (int j = 0; j < 4; ++j) { v[j] = *(const f32x4*)(zr + 4 * C.lane + 256 * j); s += (v[j][0] + v[j][1]) + (v[j][2] + v[j][3]); }
        const float mean = wave_sum(s) * (1.0f / 1024.0f); float s2 = 0.f;
#pragma unroll
        for (int j = 0; j < 4; ++j) { v[j] = v[j] - mean; s2 += sq4(v[j]); }
        const float rstd = fast_rsq(wave_sum(s2) * (1.0f / 1024.0f) + EPS);
        float p[16];
#pragma unroll
        for (int e = 0; e < 16; ++e) p[e] = 0.f;
#pragma unroll
        for (int j = 0; j < 4; ++j) { const int d = 4 * C.lane + 256 * j; const f32x4 x1 = v[j] * rstd * lg[j] + lb[j];
            *(f32x4*)(zr + d) = x1;
            const f32x4 h = x1 * (*(const f32x4*)(sc2 + d) + 1.0f) + *(const f32x4*)(sh2 + d);
            u32x2 w; w.x = cvt_pk_bf16(h[0], h[1]); w.y = cvt_pk_bf16(h[2], h[3]); *(u32x2*)(H2 + (size_t)row * 1024 + d) = w;
#pragma unroll
            for (int e = 0; e < 16; ++e) { const f32x4 wv = *(const LAS f32x4*)(wrt + e * 1024 + d); p[e] += (h[0] * wv[0] + h[1] * wv[1]) + (h[2] * wv[2] + h[3] * wv[3]); if ((e & 3) == 3) asm volatile("" ::: "memory"); } }
        float mx = -1e30f;
#pragma unroll
        for (int e = 0; e < 16; ++e) { p[e] = wave_sum(p[e]) + A.in[19][e]; mx = fmaxf(mx, p[e]); }
        float den = 0.f;
#pragma unroll
        for (int e = 0; e < 16; ++e) { p[e] = expf(p[e] - mx); den += p[e]; }
        const float inv = 1.0f / den; float mine = 0.f;
#pragma unroll
        for (int e = 0; e < 16; ++e) mine = (C.lane == e) ? p[e] * inv : mine;
        if (C.lane < 16) aff[((size_t)b * 16 + C.lane) * SEQ + n] = mine;
    }
    __syncthreads();
}

__device__ __forceinline__ unsigned block_incl_scan(unsigned v, LAS unsigned* wtot, int lane, int wave, unsigned& total) {
    unsigned x = v;
#pragma unroll
    for (int o = 1; o < 64; o <<= 1) { const unsigned y = __shfl_up(x, o); if (lane >= o) x += y; }
    if (lane == 63) wtot[wave] = x;
    __syncthreads();
    unsigned off = 0, tot = 0;
#pragma unroll
    for (int w = 0; w < 8; ++w) { const unsigned t = wtot[w]; off += (w < wave) ? t : 0u; tot += t; }
    __syncthreads();
    total = tot; return x + off;
}
__device__ __forceinline__ void p5_topk(const Ctx& C0, const Args& A) {
    Ctx C = C0; C.tid = threadIdx.x; asm volatile("" : "+v"(C.tid)); C.lane = C.tid & 63;
    const float* aff = (const float*)(A.ws + WS_AFF); int* idx = (int*)(A.ws + WS_IDX); float* gsel = (float*)(A.ws + WS_GSEL); short* slotmap = (short*)(A.ws + WS_SLOT);
    LAS unsigned* hist = (LAS unsigned*)C.lds; LAS unsigned* wtot = hist + 4096; LAS unsigned* res = wtot + 16;
    for (int be = C.vcu; be < NB * NE; be += C.G) {
        const int b = be >> 4, e = be & 15; unsigned key[16];
#pragma unroll
        for (int j = 0; j < 4; ++j) { const u32x4 k4 = *(const u32x4*)(aff + (size_t)be * SEQ + C.tid * 16 + 4 * j); key[4 * j] = k4.x; key[4 * j + 1] = k4.y; key[4 * j + 2] = k4.z; key[4 * j + 3] = k4.w; }
        unsigned prefix = 0u, mask = 0u, need = CAP;
#pragma unroll
        for (int pass = 0; pass < 3; ++pass) {
            const int shift = pass == 0 ? 20 : (pass == 1 ? 8 : 0), nb = pass == 2 ? 256 : 4096;
            for (int i = C.tid; i < nb; i += NTHR) hist[i] = 0u;
            __syncthreads();
#pragma unroll
            for (int k = 0; k < 16; ++k) if ((key[k] & mask) == prefix) atomicAdd((unsigned*)(hist + ((key[k] >> shift) & (unsigned)(nb - 1))), 1u);
            __syncthreads();
            const int per = nb / NTHR > 0 ? nb / NTHR : 1; const int lo = C.tid * per; unsigned s = 0u;
            if (lo < nb) for (int d = 0; d < per; ++d) s += hist[lo + d];
            unsigned total; const unsigned incl = block_incl_scan(s, wtot, C.lane, C.wave, total);
            unsigned running = total - incl;
            if (lo < nb) for (int d = per - 1; d >= 0; --d) { const unsigned hv = hist[lo + d]; if (running < need && need <= running + hv) { res[0] = (unsigned)(lo + d); res[1] = running; } running += hv; }
            __syncthreads();
            prefix |= res[0] << shift; mask |= (unsigned)(nb - 1) << shift; need -= res[1];
            __syncthreads();
        }
        const unsigned T = prefix; unsigned cg = 0u, ce = 0u;
#pragma unroll
        for (int k = 0; k < 16; ++k) { cg += key[k] > T ? 1u : 0u; ce += key[k] == T ? 1u : 0u; }
        unsigned total; const unsigned packed = cg | (ce << 16); const unsigned excl = block_incl_scan(packed, wtot, C.lane, C.wave, total) - packed;
        unsigned eqr = excl >> 16; unsigned slot = (excl & 0xffffu) + (eqr < need ? eqr : need);
#pragma unroll
        for (int k = 0; k < 16; ++k) { const int n = C.tid * 16 + k; const bool iseq = key[k] == T; const bool sel = key[k] > T || (iseq && eqr < need); eqr += iseq ? 1u : 0u;
            slotmap[((size_t)b * SEQ + n) * 16 + e] = sel ? (short)slot : (short)-1;
            if (sel) { idx[be * CAP + slot] = n; gsel[be * CAP + slot] = __uint_as_float(key[k]); ++slot; } }
        __syncthreads();
    }
}
__device__ __forceinline__ void p5b_gather(const Ctx& C0, const Args& A) {
    Ctx C = C0; C.tid = threadIdx.x; asm volatile("" : "+v"(C.tid)); C.lane = C.tid & 63;
    const int* idx = (const int*)(A.ws + WS_IDX); const bf16_t* H2 = (const bf16_t*)(A.ws + WS_H2); bf16_t* XE = (bf16_t*)(A.ws + WS_XE);
    const int gw = C.vcu * NWAVES + C.wave, NGW = C.G * NWAVES;
    for (int r = gw; r < NB * NE * CAP; r += NGW) { const int b = r >> 14; const int n = idx[r];
        const bf16_t* s = H2 + ((size_t)b * SEQ + n) * 1024; bf16_t* d = XE + (size_t)r * 1024;
        const u32x4 v0 = *(const u32x4*)(s + 8 * C.lane), v1 = *(const u32x4*)(s + 512 + 8 * C.lane);
        *(u32x4*)(d + 8 * C.lane) = v0; *(u32x4*)(d + 512 + 8 * C.lane) = v1; }
}
__device__ __forceinline__ void p8_final(const Ctx& C0, const Args& A) {
    Ctx C = C0; C.tid = threadIdx.x; asm volatile("" : "+v"(C.tid)); C.lane = C.tid & 63;
    float* X1 = A.out; const bf16_t* YE = (const bf16_t*)(A.ws + WS_YE); const short* slotmap = (const short*)(A.ws + WS_SLOT); const float* mod = (const float*)(A.ws + WS_MOD);
    f32x4 lg[4], lb[4];
#pragma unroll
    for (int j = 0; j < 4; ++j) { lg[j] = *(const f32x4*)(A.in[23] + 4 * C.lane + 256 * j); lb[j] = *(const f32x4*)(A.in[24] + 4 * C.lane + 256 * j); }
    const int gw = C.vcu * NWAVES + C.wave, NGW = C.G * NWAVES;
    for (int row = gw; row < NLAT; row += NGW) {
        const int b = row >> 13; float* xr = X1 + (size_t)row * 1024; const float* g2 = mod + b * 6144 + 5 * 1024;
        const int myslot = (int)slotmap[(size_t)row * 16 + (C.lane & 15)];
        f32x4 mo[4];
#pragma unroll
        for (int j = 0; j < 4; ++j) mo[j] = (f32x4){0.f, 0.f, 0.f, 0.f};
        for (int e = 0; e < 16; ++e) { const int sl = __shfl(myslot, e);
            if (sl >= 0) { const bf16_t* yr = YE + ((size_t)(b * 16 + e) * CAP + sl) * 1024;
#pragma unroll
                for (int j = 0; j < 4; ++j) { const u32x2 w = *(const u32x2*)(yr + 4 * C.lane + 256 * j); mo[j] += (f32x4){bf_lo(w.x), bf_hi(w.x), bf_lo(w.y), bf_hi(w.y)}; } } }
        f32x4 v[4]; float s = 0.f;
#pragma unroll
        for (int j = 0; j < 4; ++j) { const int d = 4 * C.lane + 256 * j; v[j] = *(const f32x4*)(xr + d) * ALPHA + *(const f32x4*)(g2 + d) * mo[j]; s += (v[j][0] + v[j][1]) + (v[j][2] + v[j][3]); }
        const float mean = wave_sum(s) * (1.0f / 1024.0f); float s2 = 0.f;
#pragma unroll
        for (int j = 0; j < 4; ++j) { v[j] = v[j] - mean; s2 += sq4(v[j]); }
        const float rstd = fast_rsq(wave_sum(s2) * (1.0f / 1024.0f) + EPS);
#pragma unroll
        for (int j = 0; j < 4; ++j) *(f32x4*)(xr + 4 * C.lane + 256 * j) = v[j] * rstd * lg[j] + lb[j];
    }
}
#define XB_TMO      128
#define XB_XCNT(j)  (256  + 64 * (j))
#define XB_XSUB(j)  (1280 + 64 * (j))
#define XB_XGEN(j)  (2304 + 64 * (j))
#define XB_TOP      3328
#define XB_TOPGEN   3392
#define XCD_BAR_WORDS 3456
#define XB_SPIN_CAP (1u << 18)
__device__ __forceinline__ unsigned xb_ld(unsigned* p)              { return __hip_atomic_load(p, __ATOMIC_RELAXED, __HIP_MEMORY_SCOPE_AGENT); }
__device__ __forceinline__ unsigned xb_add(unsigned* p, unsigned v) { return __hip_atomic_fetch_add(p, v, __ATOMIC_RELAXED, __HIP_MEMORY_SCOPE_AGENT); }
__device__ __forceinline__ unsigned xb_xcc_id() { return (unsigned)__builtin_amdgcn_s_getreg((3 << 11) | 20) & 0xFu; }
#define XB_SPIN(cond, bar) do { unsigned _sp = 0; while (cond) { __builtin_amdgcn_s_sleep(1); \
    if ((++_sp & 255u) == 0u) { if (xb_ld(&(bar)[XB_TMO])) break; if (_sp > XB_SPIN_CAP) { atomicAdd(&(bar)[XB_TMO], 1u); break; } } } } while (0)
struct XcdBarrier { unsigned* bar; unsigned x; volatile LAS unsigned* st; };
__device__ __forceinline__ XcdBarrier xcd_barrier_post(unsigned* bar, volatile LAS unsigned* st) {
    XcdBarrier b; b.bar = bar; b.x = xb_xcc_id(); b.st = st;
    if (threadIdx.x == 0) (void)xb_add(&bar[XB_XCNT(b.x)], 1u);
    return b;
}
__device__ __forceinline__ void xcd_barrier_complete(unsigned* bar, unsigned x, unsigned& nloc, unsigned& nx) {
    const unsigned G = gridDim.x;
    unsigned sum, cnt, mine, sp = 0u;
    for (;;) {
        sum = 0u; cnt = 0u; mine = 0u;
#pragma unroll
        for (unsigned j = 0; j < 16; ++j) { const unsigned c = xb_ld(&bar[XB_XCNT(j)]); sum += c; cnt += (c > 0u) ? 1u : 0u; mine = (j == x) ? c : mine; }
        if (sum == G) break;
        __builtin_amdgcn_s_sleep(1);
        if ((++sp & 255u) == 0u) { if (xb_ld(&bar[XB_TMO])) break; if (sp > XB_SPIN_CAP) { atomicAdd(&bar[XB_TMO], 1u); break; } }
    }
    nloc = mine > 0u ? mine : 1u; nx = cnt > 0u ? cnt : 1u;
}
__device__ __forceinline__ void xcd_barrier(const XcdBarrier& b) {
    asm volatile("s_waitcnt vmcnt(0)" ::: "memory");
    __syncthreads();
    if (threadIdx.x == 0) {
        unsigned* bar = b.bar;
        __builtin_amdgcn_s_waitcnt(0);
        unsigned nloc = b.st[0], nx = b.st[1];
        if (nloc == 0u) { xcd_barrier_complete(bar, b.x, nloc, nx); b.st[0] = nloc; b.st[1] = nx; }
        const unsigned old = xb_add(&bar[XB_XSUB(b.x)], 1u);
        const unsigned gen = old / nloc;
        if (old + 1u == (gen + 1u) * nloc) {
            __builtin_amdgcn_fence(__ATOMIC_RELEASE, "agent");
            asm volatile("s_waitcnt vmcnt(0)" ::: "memory");
            const unsigned og = xb_add(&bar[XB_TOP], 1u);
            const unsigned tg = og / nx;
            if (og + 1u == (tg + 1u) * nx) xb_add(&bar[XB_TOPGEN], 1u);
            else XB_SPIN(xb_ld(&bar[XB_TOPGEN]) == tg, bar);
            __builtin_amdgcn_fence(__ATOMIC_ACQUIRE, "agent");
            xb_add(&bar[XB_XGEN(b.x)], 1u);
            asm volatile("s_waitcnt vmcnt(0)" ::: "memory");
        } else {
            XB_SPIN(xb_ld(&bar[XB_XGEN(b.x)]) == gen, bar);
            __builtin_amdgcn_fence(__ATOMIC_ACQUIRE, "agent");
            asm volatile("s_waitcnt vmcnt(0)" ::: "memory");
        }
    }
    __syncthreads();
}

constexpr int NPHASE = 13;
__global__ void __launch_bounds__(NTHR, 2) mk(Args A) {
    extern __shared__ __attribute__((aligned(16))) unsigned char lds_raw[];
    Ctx C; C.lds = (LAS unsigned char*)lds_raw; C.lds_g = lds_raw;
    C.tid = threadIdx.x; C.lane = 0; C.wave = __builtin_amdgcn_readfirstlane(C.tid >> 6);
    C.G = gridDim.x; { const int bx = blockIdx.x; C.xcd = bx & 7; C.slot = bx >> 3; C.vcu = (bx & 7) * (C.G >> 3) + (bx >> 3); }
    unsigned char* ws = A.ws; const int lo = A.ph_lo, hi = A.ph_hi;
#if MK_ONE_LAUNCH
    volatile LAS unsigned* bst = (volatile LAS unsigned*)(C.lds + LDS_BYTES - 64);
    if (threadIdx.x < 2) bst[threadIdx.x] = 0u;
    __syncthreads();
    const XcdBarrier xbar = xcd_barrier_post((unsigned*)(ws + WS_CTL), bst);
#define SEAM(k) do { if (lo <= (k) && (k) + 1 < hi) { if ((k) == 0) cg::this_grid().sync(); else xcd_barrier(xbar); } } while (0)
#else
#define SEAM(k) do { } while (0)
#endif
#ifndef DBG_ONLY
#define DBG_ONLY -1
#endif
#ifndef DBG_SKIP_MASK
#define DBG_SKIP_MASK 0
#endif
#define IN(k) ((DBG_ONLY < 0 || DBG_ONLY == (k)) && !((DBG_SKIP_MASK >> (k)) & 1) && lo <= (k) && (k) < hi)
    const float* rope = (const float*)(ws + WS_ROPE);
    const int bx = blockIdx.x;
    if (IN(0)) { p0_prologue(C, A); } SEAM(0);
    if (IN(1)) { p0b_modulate(C, A); } SEAM(1);
    if (IN(2)) {
        Sched1 S{C.G, bx, (const char*)(ws + WS_A1), (const char*)(ws + WS_WIN)};
        Epi1 E{(bf16_t*)(ws + WS_P0B), (float*)(ws + WS_SSQ), (bf16_t*)(ws + WS_KR), (bf16_t*)(ws + WS_QD), (bf16_t*)(ws + WS_KD), (bf16_t*)(ws + WS_VD),
#ifdef DBG_GT_WS
            (bf16_t*)(ws + (326ull << 20)),
#else
            (bf16_t*)A.out,
#endif
            rope};
        pg8::gemm_phase(C.lds, pg8::Gemm{1024, 1024, 1024}, S, E);
    } SEAM(2);
    if (IN(3)) {
        SchedUQ Sq{C.G, bx, (const char*)(ws + WS_P0B), (const char*)(ws + WS_WUQ)}; SchedUKV Sk{C.G, bx, (const char*)(ws + WS_P0B), (const char*)(ws + WS_WUKV)};
        SchedU S{Sq, Sk, C.G, bx};
        EpiU E{EpiUQ{(const float*)(ws + WS_SSQ), (bf16_t*)(ws + WS_QM), rope}, EpiUKV{(const float*)(ws + WS_SSQ), (const bf16_t*)(ws + WS_KR), (bf16_t*)(ws + WS_KM), (bf16_t*)(ws + WS_VM)}};
        pg8::gemm_phase(C.lds, pg8::Gemm{256, 512, 256}, S, E);
    } SEAM(3);
#if !MK_NAIVE_ATTN
    if (IN(4)) { attn_phase(C, ws, A.in[13]); }
#endif
    SEAM(4);
    if (IN(5)) {
        SchedY S{C.G, bx, (const char*)(ws + WS_OA), (const char*)(ws + WS_WOC)}; EpiY E{(const bf16_t*)A.out, (bf16_t*)(ws + WS_Y)};
        pg8::gemm_phase(C.lds, pg8::Gemm{512, 1024, 1024}, S, E);
    } SEAM(5);
    if (IN(6)) {
        SchedZ S{C.G, bx, (const char*)(ws + WS_Y), (const char*)(ws + WS_WOUT)}; EpiZ E{A.in[0], (const float*)(ws + WS_MOD), A.out};
        pg8::gemm_phase(C.lds, pg8::Gemm{1024, 1024, 1024}, S, E);
    } SEAM(6);
    if (IN(7)) { p4_ln_router(C, A); } SEAM(7);
    if (IN(8)) { p5_topk(C, A); } SEAM(8);
    if (IN(9)) { p5b_gather(C, A); } SEAM(9);
    if (IN(10)) {
        SchedM1 S{C.xcd, C.slot, (const char*)(ws + WS_XE), (const char*)(ws + WS_W13)}; EpiM1 E{(bf16_t*)(ws + WS_HID)};
        pg8::gemm_phase(C.lds, pg8::Gemm{1024, 1024, 1024}, S, E);
    } SEAM(10);
    if (IN(11)) {
        SchedM2 S{C.xcd, C.slot, (const char*)(ws + WS_HID), (const char*)(ws + WS_W2T)}; EpiM2 E{(const float*)(ws + WS_GSEL), (bf16_t*)(ws + WS_YE)};
        pg8::gemm_phase(C.lds, pg8::Gemm{1024, 1024, 1024}, S, E);
    } SEAM(11);
    if (IN(12)) { p8_final(C, A); }
#undef IN
#undef SEAM
}

#ifdef DBG_COPY_OFF
__global__ void dbg_copy(u32x4* dst, const u32x4* src, size_t n16) { for (size_t i = blockIdx.x * 256ull + threadIdx.x; i < n16; i += gridDim.x * 256ull) dst[i] = src[i]; }
#endif
extern "C" void kernel_launch(void* const* d_in, const int* in_sizes, int n_in, void* d_out, int out_size, void* d_ws, size_t ws_size, hipStream_t stream) {
    static int ready = 0;
    if (ready == 0) {
        if (n_in != 25 || in_sizes[0] != NLAT * DM || out_size != NLAT * DM || ws_size < WS_NEED) {
            fprintf(stderr, "kernel_launch: unexpected shapes (n_in %d, x %d, out %d, ws %zu; need ws >= %zu)\n", n_in, n_in > 0 ? in_sizes[0] : -1, out_size, ws_size, (size_t)WS_NEED); ready = -1; return; }
        if (hipFuncSetAttribute((const void*)mk, hipFuncAttributeMaxDynamicSharedMemorySize, LDS_BYTES) != hipSuccess) { fprintf(stderr, "kernel_launch: hipFuncSetAttribute failed\n"); ready = -1; return; }
        int dev = 0, cus = 0, per_cu = 0;
        (void)hipGetDevice(&dev); (void)hipDeviceGetAttribute(&cus, hipDeviceAttributeMultiprocessorCount, dev);
        (void)hipOccupancyMaxActiveBlocksPerMultiprocessor(&per_cu, (const void*)mk, NTHR, LDS_BYTES);
        if (cus != 256 || per_cu < 1) { fprintf(stderr, "kernel_launch: needs 256 CUs with one resident workgroup each (cus %d, per_cu %d)\n", cus, per_cu); ready = -1; return; }
        ready = 1;
    }
    if (ready < 0) return;
    Args a{};
    for (int i = 0; i < 25; ++i) a.in[i] = (const float*)d_in[i];
    a.out = (float*)d_out; a.ws = (unsigned char*)d_ws;
#if MK_ONE_LAUNCH
    a.ph_lo = 0; a.ph_hi = NPHASE;
    if (hipMemsetAsync((char*)d_ws + WS_CTL, 0, XCD_BAR_WORDS * 4, stream) != hipSuccess) { fprintf(stderr, "kernel_launch: memset of the barrier words failed\n"); return; }
    void* kargs[] = {&a};
    hipError_t e = hipLaunchCooperativeKernel((const void*)mk, dim3(256), dim3(NTHR), kargs, LDS_BYTES, stream);
    if (e != hipSuccess) fprintf(stderr, "kernel_launch: cooperative launch failed: %s\n", hipGetErrorString(e));
#else
#ifndef DBG_LAST_PHASE
#define DBG_LAST_PHASE 99
#endif
    for (int ph = 0; ph < NPHASE && ph <= DBG_LAST_PHASE; ++ph) {
#if MK_NAIVE_ATTN
        if (ph == 4) {
            unsigned char* ws = (unsigned char*)d_ws;
            naive_attn<0><<<NB * 8 * SEQ / 4, 256, 0, stream>>>((const bf16_t*)(ws + WS_QM), (const bf16_t*)(ws + WS_KM), (const bf16_t*)(ws + WS_VM), (bf16_t*)(ws + WS_OA), (const float*)(ws + WS_LAM), (const float*)d_in[13]);
            naive_attn<1><<<NB * 4 * SEQ / 4, 256, 0, stream>>>((const bf16_t*)(ws + WS_QD), (const bf16_t*)(ws + WS_KD), (const bf16_t*)(ws + WS_VD), (bf16_t*)(ws + WS_OA), (const float*)(ws + WS_LAM), (const float*)d_in[13]);
            continue;
        }
#endif
        a.ph_lo = ph; a.ph_hi = ph + 1;
        hipLaunchKernelGGL(mk, dim3(256), dim3(NTHR), LDS_BYTES, stream, a);
    }
#ifdef DBG_COPY_OFF
    dbg_copy<<<2048, 256, 0, stream>>>((u32x4*)d_out, (const u32x4*)((unsigned char*)d_ws + (size_t)DBG_COPY_OFF), (size_t)DBG_COPY_BYTES / 16);
#endif
    hipError_t e = hipPeekAtLastError();
    if (e != hipSuccess) fprintf(stderr, "kernel_launch: launch failed: %s\n", hipGetErrorString(e));
#endif
}
```

```cpp
#include <hip/hip_runtime.h>
#include <hip/hip_cooperative_groups.h>
#include <cstdio>
#include <cstdint>
namespace cg = cooperative_groups;

#ifndef MK_ONE_LAUNCH
#define MK_ONE_LAUNCH 1
#endif
#ifndef MK_SLOWK
#define MK_SLOWK 0
#endif
#ifndef MK_NAIVE_ATTN
#define MK_NAIVE_ATTN 0
#endif

#define LAS __attribute__((address_space(3)))
#define GAS __attribute__((address_space(1)))
typedef unsigned short bf16_t;
typedef short bf16x8 __attribute__((ext_vector_type(8)));
typedef short s16x4 __attribute__((ext_vector_type(4)));
typedef float f32x2 __attribute__((ext_vector_type(2)));
typedef float f32x4 __attribute__((ext_vector_type(4)));
typedef float f32x16 __attribute__((ext_vector_type(16)));
typedef unsigned u32x2 __attribute__((ext_vector_type(2)));
typedef unsigned u32x4 __attribute__((ext_vector_type(4)));

constexpr int DM = 1024, NB = 4, SEQ = 8192, CTXL = 256, SK = SEQ + CTXL;
constexpr int NLAT = NB * SEQ, NCTX = NB * CTXL, MTOT = NCTX + NLAT;
constexpr int NE = 16, CAP = 1024, FFD = 1024, NIN = 4000;
constexpr float EPS = 1e-6f, LOG2E = 1.4426950408889634f;
constexpr float MLA_QS = 0.10206207261596577f * LOG2E;
constexpr float DIFF_QS = 0.125f * LOG2E;
constexpr float ALPHA = 1.189207115002721f;
constexpr float LAMBDA_INIT = 0.2f;
constexpr int NWAVES = 8, NTHR = 512;

constexpr size_t MiB = 1u << 20;
constexpr size_t WS_CTL = 0;
constexpr size_t WS_MOD = 1 * MiB;
constexpr size_t WS_ROPE = 1 * MiB + 256 * 1024;
constexpr size_t WS_LAM = 1 * MiB + 512 * 1024;
constexpr size_t WS_KMAX = 1 * MiB + 640 * 1024;
template <int K> __device__ __forceinline__ float swz_xor(float v) { return __int_as_float(__builtin_amdgcn_ds_swizzle(__float_as_int(v), 0x1f | (K << 10))); }
__device__ __forceinline__ float half_sum(float v) { auto rr = __builtin_amdgcn_permlane32_swap(__float_as_uint(v), __float_as_uint(v), false, false); return __uint_as_float(rr[0]) + __uint_as_float(rr[1]); }
__device__ __forceinline__ float sum_fq(float v) { v += swz_xor<16>(v); return half_sum(v); }
__device__ __forceinline__ float wmax16(float v) { v = fmaxf(v, swz_xor<1>(v)); v = fmaxf(v, swz_xor<2>(v)); v = fmaxf(v, swz_xor<4>(v)); v = fmaxf(v, swz_xor<8>(v)); return v; }
constexpr size_t WS_SSQ = 2 * MiB;
constexpr size_t WS_KR = 4 * MiB;
constexpr size_t WS_AFF = 7 * MiB;
constexpr size_t WS_IDX = 9 * MiB;
constexpr size_t WS_GSEL = 9 * MiB + 512 * 1024;
constexpr size_t WS_SLOT = 10 * MiB;
constexpr size_t WS_WIN = 16 * MiB;
constexpr size_t WS_WUQ = 24 * MiB;
constexpr size_t WS_WUKV = 25 * MiB;
constexpr size_t WS_WOC = 26 * MiB;
constexpr size_t WS_WOUT = 28 * MiB;
constexpr size_t WS_W13 = 32 * MiB;
constexpr size_t WS_W2T = 96 * MiB;
constexpr size_t WS_A1 = 128 * MiB;
constexpr size_t WS_P0B = 194 * MiB;
constexpr size_t WS_QD = 228 * MiB;
constexpr size_t WS_KD = 260 * MiB;
constexpr size_t WS_VD = 293 * MiB;
constexpr size_t WS_QM = 326 * MiB;
constexpr size_t WS_KM = 374 * MiB;
constexpr size_t WS_VM = 424 * MiB;
constexpr size_t WS_OA = 128 * MiB;
constexpr size_t WS_Y = 192 * MiB;
constexpr size_t WS_H2 = 128 * MiB;
constexpr size_t WS_X1B = 192 * MiB;
constexpr size_t WS_OL = 256 * MiB;
constexpr size_t WS_XE = 256 * MiB;
constexpr size_t WS_HID = 384 * MiB;
constexpr size_t WS_YE = 256 * MiB;
constexpr size_t WS_NEED = 512 * MiB;

constexpr int LDS_BYTES = 156672;

typedef __bf16 bf16x2_t __attribute__((ext_vector_type(2)));
__device__ __forceinline__ unsigned cvt_pk_bf16(float lo, float hi) { const f32x2 v = {lo, hi}; const bf16x2_t b = __builtin_convertvector(v, bf16x2_t); return __builtin_bit_cast(unsigned, b); }
__device__ __forceinline__ float bf_lo(unsigned w) { return __uint_as_float(w << 16); }
__device__ __forceinline__ float bf_hi(unsigned w) { return __uint_as_float(w & 0xffff0000u); }
__device__ __forceinline__ float bf2f(bf16_t h) { return __uint_as_float(((unsigned)h) << 16); }
__device__ __forceinline__ float fast_exp2(float x) { return __builtin_amdgcn_exp2f(x); }
__device__ __forceinline__ float fast_rcp(float x) { return __builtin_amdgcn_rcpf(x); }
__device__ __forceinline__ float fast_rsq(float x) { return __builtin_amdgcn_rsqf(x); }
__device__ __forceinline__ float sigmoidf_(float x) { return fast_rcp(1.0f + fast_exp2(-x * LOG2E)); }
__device__ __forceinline__ float wave_sum(float v) {
#pragma unroll
    for (int o = 1; o < 64; o <<= 1) v += __shfl_xor(v, o);
    return v;
}
__device__ __forceinline__ float wave_max(float v) {
#pragma unroll
    for (int o = 1; o < 64; o <<= 1) v = fmaxf(v, __shfl_xor(v, o));
    return v;
}

__device__ __forceinline__ int lane_id() { return (int)__builtin_amdgcn_mbcnt_hi(~0u, __builtin_amdgcn_mbcnt_lo(~0u, 0u)); }
struct Args { const float* in[25]; float* out; unsigned char* ws; int ph_lo, ph_hi; };
typedef const __attribute__((address_space(4))) Args* KA;
__device__ __forceinline__ KA kargs() { KA p = (KA)__builtin_amdgcn_kernarg_segment_ptr(); asm volatile("" : "+s"(p)); return p; }

struct Ctx {
    LAS unsigned char* lds; unsigned char* lds_g;
    int tid, lane, wave, G, vcu, xcd, slot;
};

namespace pg8 {
constexpr int BM = 256, BK = 64, HALF = 128, HTB = HALF * BK * 2, STAGE_BYTES = 8 * HTB;
__host__ __device__ __forceinline__ int lds_byte(int r, int c) { const int st = (r >> 4) * 2 + (c >> 5), rr = r & 15, cc = c & 31, ob = rr * 64 + cc * 2; return st * 1024 + (ob ^ (((ob >> 9) & 1) << 5)); }
__host__ __device__ __forceinline__ void stage_rc(int b, int& R, int& C) { const int st = b / 1024, sb = b % 1024, swz = sb ^ (((sb >> 9) & 1) << 5); R = (st >> 1) * 16 + swz / 64; C = (st & 1) * 32 + (swz % 64) / 2; }
__host__ __device__ __forceinline__ int perm32(int rho) { const int n = rho >> 4, i = rho & 15; return 8 * (i >> 2) + 4 * n + (i & 3); }
struct Unit { int pm, pn, aux; };
struct Gemm { int K, lda, ldb; };

#define ACC_ZERO() do { _Pragma("unroll") for (int a_ = 0; a_ < 2; ++a_) _Pragma("unroll") for (int b_ = 0; b_ < 2; ++b_) _Pragma("unroll") for (int m_ = 0; m_ < 4; ++m_) _Pragma("unroll") for (int n_ = 0; n_ < 2; ++n_) acc[a_][b_][m_][n_] = (f32x4){0.f, 0.f, 0.f, 0.f}; } while (0)

#if MK_SLOWK
template <class Epi, class Sched, bool GATHER = false>
__device__ __forceinline__ void gemm_phase(int wave, LAS unsigned char* lds, const Gemm g, const Sched& S, const Epi& E, const LAS int* rowsL = nullptr) {
    const int tid = wave * 64 + lane_id(), wid = __builtin_amdgcn_readfirstlane(tid >> 6), lane = tid & 63, wr = wid >> 2, wc = wid & 3, fr = lane & 15, fq = lane >> 4;
    f32x4 acc[2][2][4][2];
    ACC_ZERO();
    Unit cur;
    for (int ui = 0; S.next(ui, cur); ++ui) {
        const char* cA = S.a_ptr(cur); const char* cB = S.b_ptr(cur);
        for (int k0 = 0; k0 < g.K; k0 += 32) {
            bf16x8 At[2][4], Bt[2][2];
#pragma unroll
            for (int ai = 0; ai < 2; ++ai)
#pragma unroll
                for (int m = 0; m < 4; ++m) At[ai][m] = *(const bf16x8*)(cA + ((size_t)(128 * ai + 64 * wr + 16 * m + fr) * g.lda + k0 + 8 * fq) * 2);
#pragma unroll
            for (int bj = 0; bj < 2; ++bj)
#pragma unroll
                for (int n = 0; n < 2; ++n) { const int sl = 16 * n + fr; const int row = 128 * bj + 32 * wc + (Epi::PERM ? perm32(sl) : sl);
                    Bt[bj][n] = *(const bf16x8*)(cB + ((size_t)row * g.ldb + k0 + 8 * fq) * 2); }
#pragma unroll
            for (int ai = 0; ai < 2; ++ai)
#pragma unroll
                for (int bj = 0; bj < 2; ++bj)
#pragma unroll
                    for (int m = 0; m < 4; ++m)
#pragma unroll
                        for (int n = 0; n < 2; ++n) acc[ai][bj][m][n] = __builtin_amdgcn_mfma_f32_16x16x32_bf16(Bt[bj][n], At[ai][m], acc[ai][bj][m][n], 0, 0, 0);
        }
        E(acc, cur, wr, wc, fr, fq);
        if (!E.keep(cur)) ACC_ZERO();
    }
}
#else
template <class Epi, class Sched, bool GATHER = false>
__device__ __forceinline__ void gemm_phase(int wave, LAS unsigned char* lds, const Gemm g, const Sched& S, const Epi& E, const LAS int* rowsL = nullptr) {
#ifndef PG8_ALIGN_EPI
#define PG8_ALIGN_EPI true
#endif
    constexpr bool ALIGN_EPI = PG8_ALIGN_EPI;
    int tid_ = wave * 64 + lane_id(); asm volatile("" : "+v"(tid_));
    const int tid = tid_, wid = __builtin_amdgcn_readfirstlane(tid >> 6), lane = tid & 63, wr = wid >> 2, wc = wid & 3, fr = lane & 15, fq = lane >> 4;
    const int K = g.K, nt = K / BK;
    unsigned voffA[2], voffB[2];
#pragma unroll
    for (int i = 0; i < 2; ++i) { int R, C; stage_rc(tid * 16 + i * 8192, R, C); const int Rb = Epi::PERM ? ((R & ~31) + perm32(R & 31)) : R;
        voffA[i] = (unsigned)(R * g.lda + C) * 2u; voffB[i] = (unsigned)(Rb * g.ldb + C) * 2u; }
    unsigned vc[2][2] = {{0u, 0u}, {0u, 0u}}, vn[2][2] = {{0u, 0u}, {0u, 0u}}; int gR[2] = {0, 0}, gC[2] = {0, 0};
    if constexpr (GATHER) {
#pragma unroll
        for (int i = 0; i < 2; ++i) stage_rc(tid * 16 + i * 8192, gR[i], gC[i]);
    }
#define PG8_GOFFS(dst, ord) do { _Pragma("unroll") for (int h_ = 0; h_ < 2; ++h_) _Pragma("unroll") for (int i_ = 0; i_ < 2; ++i_) \
        dst[h_][i_] = (unsigned)(rowsL[(ord) * 256 + h_ * 128 + gR[i_]] * g.lda + gC[i_]) * 2u; } while (0)
#define PG8_STAGE_A(bufoff, gbase0, h, nextflag) do { if constexpr (GATHER) { const unsigned vv_[2] = {(nextflag) ? vn[h][0] : vc[h][0], (nextflag) ? vn[h][1] : vc[h][1]}; PG8_STAGE(bufoff, gbase0, vv_); } \
        else { PG8_STAGE(bufoff, (gbase0) + (h) * hstepA, voffA); } } while (0)
    const size_t kstep = (size_t)(BK * 2);
    const size_t hstepA = (size_t)HALF * g.lda * 2, hstepB = (size_t)HALF * g.ldb * 2;
    const unsigned ldsw = (unsigned)wid * 1024u;
    const int aoff = lds_byte(wr * 64 + fr, fq * 8), boff = lds_byte(wc * 32 + fr, fq * 8);
#define PG8_SA(b, h) (((b) * 2 + (h)) * HTB)
#define PG8_SB(b, h) ((4 + (b) * 2 + (h)) * HTB)
#define PG8_STAGE(bufoff, gbase, voff) do { _Pragma("unroll") for (int _i = 0; _i < 2; ++_i) \
        __builtin_amdgcn_global_load_lds((const unsigned*)((const char*)(gbase) + (voff)[_i]), (LAS unsigned*)(lds + (bufoff) + ldsw + _i * 8192), 16, 0, 0); } while (0)
#define PG8_LDA(dst, b, h) do { _Pragma("unroll") for (int m = 0; m < 4; ++m) _Pragma("unroll") for (int k = 0; k < 2; ++k) dst[m][k] = *(const LAS bf16x8*)(lds + PG8_SA(b, h) + aoff + m * 2048 + k * 1024); } while (0)
#define PG8_LDB(dst, b, h) do { _Pragma("unroll") for (int n = 0; n < 2; ++n) _Pragma("unroll") for (int k = 0; k < 2; ++k) dst[n][k] = *(const LAS bf16x8*)(lds + PG8_SB(b, h) + boff + n * 2048 + k * 1024); } while (0)
#define PG8_MMA(ai, bj, At, Bt) do { __builtin_amdgcn_s_setprio(1); _Pragma("unroll") for (int m = 0; m < 4; ++m) _Pragma("unroll") for (int n = 0; n < 2; ++n) _Pragma("unroll") for (int k = 0; k < 2; ++k) \
        acc[ai][bj][m][n] = __builtin_amdgcn_mfma_f32_16x16x32_bf16(Bt[n][k], At[m][k], acc[ai][bj][m][n], 0, 0, 0); __builtin_amdgcn_s_setprio(0); } while (0)
#define PG8_WAIT_V(n) asm volatile("s_waitcnt vmcnt(" #n ")" ::: "memory")
#define PG8_WAIT_L(n) asm volatile("s_waitcnt lgkmcnt(" #n ")" ::: "memory")
#define PG8_BAR __builtin_amdgcn_s_barrier()
#define PG8_SCHED __builtin_amdgcn_sched_barrier(0)
    Unit cur, nxt; int ui = 0;
    if (!S.next(0, cur)) return;
#ifdef PG8_STAGGER_US
    if (Epi::STAGGER) {
      const unsigned long long until = __builtin_amdgcn_s_memrealtime() + (unsigned long long)((blockIdx.x >> 3) & 7) * (PG8_STAGGER_US * 10ull);
      while (__builtin_amdgcn_s_memrealtime() < until) __builtin_amdgcn_s_sleep(4); }
#endif
    f32x4 acc[2][2][4][2];
    ACC_ZERO();
    bf16x8 At[4][2], B0[2][2], B1[2][2];
    const char* cA = S.a_ptr(cur); const char* cB = S.b_ptr(cur);
    if constexpr (GATHER) PG8_GOFFS(vc, 0);
    PG8_STAGE(PG8_SB(0, 0), cB, voffB); PG8_STAGE(PG8_SB(0, 1), cB + hstepB, voffB); PG8_STAGE_A(PG8_SA(0, 0), cA, 0, false); PG8_STAGE_A(PG8_SA(0, 1), cA, 1, false);
    if (wr == 1) PG8_BAR;
    PG8_WAIT_V(2); PG8_BAR;
    PG8_STAGE(PG8_SB(1, 0), cB + kstep, voffB); PG8_STAGE_A(PG8_SA(1, 0), cA + kstep, 0, false); PG8_STAGE(PG8_SB(1, 1), cB + hstepB + kstep, voffB);
    PG8_WAIT_V(6); PG8_BAR;
    for (;;) {
        const bool has_next = S.next(ui + 1, nxt);
        const char* nA = has_next ? S.a_ptr(nxt) : cA; const char* nB = has_next ? S.b_ptr(nxt) : cB;
        if constexpr (GATHER) { if (has_next) PG8_GOFFS(vn, ui + 1); else { vn[0][0] = vc[0][0]; vn[0][1] = vc[0][1]; vn[1][0] = vc[1][0]; vn[1][1] = vc[1][1]; } }
        for (int t = 0; t < nt; t += 2) {
            const bool last = (t == nt - 2);
            const char* a1 = cA + (size_t)(t + 1) * kstep;
            const char* a2 = last ? nA : cA + (size_t)(t + 2) * kstep; const char* b2 = last ? nB : cB + (size_t)(t + 2) * kstep;
            const char* a3 = a2 + kstep; const char* b3 = b2 + kstep;
            PG8_LDB(B0, 0, 0); PG8_LDB(B1, 0, 1); PG8_SCHED; PG8_LDA(At, 0, 0); PG8_STAGE_A(PG8_SA(1, 1), a1, 1, false);
            PG8_WAIT_V(8); PG8_WAIT_L(0); PG8_BAR; PG8_MMA(0, 0, At, B0); PG8_MMA(0, 1, At, B1); PG8_BAR; PG8_SCHED;
            PG8_LDA(At, 0, 1); PG8_STAGE(PG8_SB(0, 0), b2, voffB); PG8_STAGE(PG8_SB(0, 1), b2 + hstepB, voffB); PG8_STAGE_A(PG8_SA(0, 0), a2, 0, last);
            PG8_WAIT_V(8); PG8_WAIT_L(0); PG8_BAR; PG8_MMA(1, 0, At, B0); PG8_MMA(1, 1, At, B1); PG8_BAR; PG8_SCHED;
            PG8_LDB(B0, 1, 0); PG8_LDB(B1, 1, 1); PG8_SCHED; PG8_LDA(At, 1, 0); PG8_STAGE_A(PG8_SA(0, 1), a2, 1, last);
            PG8_WAIT_V(8); PG8_WAIT_L(0); PG8_BAR; PG8_MMA(0, 0, At, B0); PG8_MMA(0, 1, At, B1); PG8_BAR; PG8_SCHED;
            PG8_LDA(At, 1, 1); PG8_STAGE(PG8_SB(1, 0), b3, voffB); PG8_STAGE(PG8_SB(1, 1), b3 + hstepB, voffB); PG8_STAGE_A(PG8_SA(1, 0), a3, 0, last);
            PG8_WAIT_V(8); PG8_WAIT_L(0); PG8_BAR; PG8_MMA(1, 0, At, B0); PG8_MMA(1, 1, At, B1); PG8_BAR; PG8_SCHED;
        }
        if constexpr (ALIGN_EPI) { if (wr == 0) PG8_BAR; }
        E(acc, cur, wr, wc, fr, fq);
#ifdef MK_EPI_DRAIN
        PG8_WAIT_V(0);
#endif
        if (!has_next) break;
        if (!E.keep(cur)) ACC_ZERO();
        cur = nxt; cA = nA; cB = nB; ++ui;
        if constexpr (GATHER) { vc[0][0] = vn[0][0]; vc[0][1] = vn[0][1]; vc[1][0] = vn[1][0]; vc[1][1] = vn[1][1]; }
        if constexpr (ALIGN_EPI) { if (wr == 1) PG8_BAR; }
    }
    PG8_WAIT_V(0);
    if constexpr (!ALIGN_EPI) { if (wr == 0) PG8_BAR; }
    PG8_BAR;
#undef PG8_GOFFS
#undef PG8_STAGE_A
#undef PG8_SA
#undef PG8_SB
#undef PG8_STAGE
#undef PG8_LDA
#undef PG8_LDB
#undef PG8_MMA
#undef PG8_WAIT_V
#undef PG8_WAIT_L
#undef PG8_BAR
#undef PG8_SCHED
}
#endif
}
using pg8::Unit;

__device__ __forceinline__ void static_order(int L, int nM, int nN, int& pm, int& pn) {
    const int nwg = nM * nN; int wgid = L;
    { const int q = nwg / 8, r = nwg % 8, xcd = wgid % 8, off = wgid / 8; wgid = (xcd < r ? xcd * (q + 1) : r * (q + 1) + (xcd - r) * q) + off; }
    const int nig = 8 * nN, gid = wgid / nig, fm = gid * 8, gsz = (nM - fm) < 8 ? (nM - fm) : 8;
    pm = fm + ((wgid % nig) % gsz); pn = (wgid % nig) / gsz;
}
#ifndef EPI_NT
#define EPI_NT 0
#endif
__device__ __forceinline__ void st16(void* p, u32x4 v) { if (EPI_NT) __builtin_nontemporal_store(v, (u32x4*)p); else *(u32x4*)p = v; }
__device__ __forceinline__ u32x4 pack8(f32x4 a, f32x4 b) { u32x4 w; w.x = cvt_pk_bf16(a[0], a[1]); w.y = cvt_pk_bf16(a[2], a[3]); w.z = cvt_pk_bf16(b[0], b[1]); w.w = cvt_pk_bf16(b[2], b[3]); return w; }
__device__ __forceinline__ void rope4(f32x4& x1, f32x4& x2, f32x4 c, f32x4 s) { const f32x4 o1 = x1 * c - x2 * s, o2 = x2 * c + x1 * s; x1 = o1; x2 = o2; }
__device__ __forceinline__ float sq4(f32x4 v) { return (v[0] * v[0] + v[1] * v[1]) + (v[2] * v[2] + v[3] * v[3]); }

struct Sched1 {
    int G, c; const char* A1; const char* WIN; int ctxmode;
    __device__ __forceinline__ bool next(int i, Unit& u) const {
        u.aux = 0;
        if (ctxmode == 1) { if (i > 0 || c >= 20) return false; u.pm = c / 5; const int j = c % 5; u.pn = (j == 0) ? 1 : (3 + j); return true; }
        if (ctxmode == 3) {
            if (c < 20) { if (i == 0) { u.pm = c / 5; const int j = c % 5; u.pn = (j == 0) ? 1 : (3 + j); return true; } --i; }
            const int L3 = i * G + c; if (L3 >= 2048) return false;
            int pm, pn; static_order(L3, 128, 16, pm, pn); u.pm = pm + 4; u.pn = pn; return true; }
        int L = i * G + c;
        if (L < 2048) { int pm, pn; static_order(L, 128, 16, pm, pn); u.pm = pm + 4; u.pn = pn; return true; }
        if (ctxmode == 0) return false;
        L -= 2048; if (L >= 20) return false;
        u.pm = L / 5; const int j = L % 5; u.pn = (j == 0) ? 1 : (3 + j); return true;
    }
    __device__ __forceinline__ const char* a_ptr(const Unit& u) const { return A1 + (size_t)u.pm * 256 * 1024 * 2; }
    __device__ __forceinline__ const char* b_ptr(const Unit& u) const { return WIN + (size_t)u.pn * 256 * 1024 * 2; }
};
#ifndef E1_ROPE_LDS
#define E1_ROPE_LDS 1
#endif
struct Epi1 {
    static constexpr bool PERM = true, STAGGER = true;
    bf16_t* P0B; float* SSQ; bf16_t* KR; bf16_t* QD; bf16_t* KD; bf16_t* VD; bf16_t* GT; const float* rope; unsigned* KMAX; const LAS float* ropeL;
    unsigned* ready;
    __device__ __forceinline__ bool keep(const Unit&) const { return false; }
    __device__ __forceinline__ void operator()(f32x4 (&acc)[2][2][4][2], const Unit& u, int wr, int wc, int fr, int fq) const {
        asm volatile("" : "+v"(fr), "+v"(fq));
        const bool isctx = u.pm < 4; int b, tbase;
        if (isctx) { b = u.pm; tbase = 0; } else { const int lt = u.pm - 4; b = lt >> 5; tbase = (lt & 31) * 256; }
        const int pn = u.pn;
        const int lr0 = 64 * wr + fr, cw = 32 * wc + 8 * fq;
#define E1_ROWS(...) _Pragma("unroll") for (int ai = 0; ai < 2; ++ai) _Pragma("unroll") for (int m = 0; m < 4; ++m) { const int lr = 128 * ai + 16 * m + lr0; const int t = tbase + lr; __VA_ARGS__ asm volatile("" ::: "memory"); }
        if (pn == 0) {
            bf16_t* P = P0B + (size_t)u.pm * 256 * 512 + cw; float* SQ = SSQ + (size_t)u.pm * 256 * 8 + wc;
            E1_ROWS({ (void)t; float ss = 0.f;
                _Pragma("unroll") for (int bj = 0; bj < 2; ++bj) { const f32x4 v0 = acc[ai][bj][m][0], v1 = acc[ai][bj][m][1]; ss += sq4(v0) + sq4(v1); *(u32x4*)(P + lr * 512 + 128 * bj) = pack8(v0, v1); }
                ss = sum_fq(ss); if (fq == 0) SQ[lr * 8] = ss; })
        } else if (pn == 1) {
            bf16_t* P = P0B + (size_t)u.pm * 256 * 512 + 256 + cw; float* SQ = SSQ + (size_t)u.pm * 256 * 8 + 4 + wc; bf16_t* KRb = KR + (size_t)b * SK * 32 + 8 * fq;
            const int axis = fq >> 1, sub = fq & 1; float kmx = 0.f;
            E1_ROWS({ const f32x4 v0 = acc[ai][0][m][0], v1 = acc[ai][0][m][1]; float ss = sq4(v0) + sq4(v1);
                *(u32x4*)(P + lr * 512) = pack8(v0, v1);
                ss = sum_fq(ss); if (fq == 0) SQ[lr * 8] = ss;
                f32x4 w0 = acc[ai][1][m][0], w1 = acc[ai][1][m][1];
                *(u32x4*)(P + lr * 512 + 128) = pack8(w0, w1);
                if (wc == 0) { const int kidx = isctx ? lr : 256 + t;
                    if (!isctx) { const int pos = axis ? (t & 63) : (t >> 6); const f32x4 c = *(const LAS f32x4*)(ropeL + 4096 + pos * 8 + 4 * sub), s = *(const LAS f32x4*)(ropeL + 5120 + pos * 8 + 4 * sub); rope4(w0, w1, c, s); }
                    float s2 = sq4(w0) + sq4(w1); s2 = sum_fq(s2); kmx = fmaxf(kmx, s2);
                    *(u32x4*)(KRb + kidx * 32) = pack8(w0, w1); } })
            if (wc == 0) { const float mx = wmax16(kmx); if ((fr | fq) == 0) atomicMax(KMAX + 64 + b, __float_as_uint(mx)); }
        }
        if (pn < 2 && ready) {
            asm volatile("s_waitcnt vmcnt(0)" ::: "memory"); __syncthreads();
            if ((wr | wc) == 0 && (fr | fq) == 0) { __builtin_amdgcn_fence(__ATOMIC_RELEASE, "agent"); (void)__hip_atomic_fetch_add(ready, 1u, __ATOMIC_RELAXED, __HIP_MEMORY_SCOPE_AGENT); }
        }
        if (pn < 2) {
        } else if (pn < 6) {
            const bool isq = pn < 4; const int h0 = 2 * (isq ? pn - 2 : pn - 4); const int axis = wc & 1;
            bf16_t* Qb = QD + (size_t)(b * 4 + h0) * SEQ * 128 + cw; bf16_t* Kb = KD + (size_t)(b * 4 + h0) * SK * 128 + cw; float kmx[2] = {0.f, 0.f};
            E1_ROWS({ const int kidx = isctx ? lr : 256 + t; const int pos = axis ? (t & 63) : (t >> 6);
                f32x4 c = {1.f, 1.f, 1.f, 1.f}, s = {0.f, 0.f, 0.f, 0.f};
#if E1_ROPE_LDS
                if (!isctx) { c = *(const LAS f32x4*)(ropeL + pos * 16 + 4 * fq); s = *(const LAS f32x4*)(ropeL + 2048 + pos * 16 + 4 * fq); }
#else
                if (!isctx) { c = *(const f32x4*)(rope + pos * 16 + 4 * fq); s = *(const f32x4*)(rope + 2048 + pos * 16 + 4 * fq); }
#endif
                _Pragma("unroll") for (int bj = 0; bj < 2; ++bj) { f32x4 v0 = acc[ai][bj][m][0], v1 = acc[ai][bj][m][1]; rope4(v0, v1, c, s);
                    if (isq) { v0 = v0 * DIFF_QS; v1 = v1 * DIFF_QS; float s2 = sq4(v0) + sq4(v1); s2 = sum_fq(s2); kmx[bj] = fmaxf(kmx[bj], s2);
                        *(u32x4*)(Qb + (bj * SEQ + t) * 128) = pack8(v0, v1); }
                    else { float s2 = sq4(v0) + sq4(v1); s2 = sum_fq(s2); kmx[bj] = fmaxf(kmx[bj], s2);
                        *(u32x4*)(Kb + (bj * SK + kidx) * 128) = pack8(v0, v1); } } })
            {
                _Pragma("unroll") for (int bj = 0; bj < 2; ++bj) { const float mx = wmax16(kmx[bj]); if ((fr | fq) == 0) atomicMax(KMAX + (isq ? 132 : 68) + (b * 4 + h0 + bj) * 4 + wc, __float_as_uint(mx)); } }
        } else if (pn < 8) {
            bf16_t* Vb = VD + (size_t)(b * 4 + 2 * (pn - 6)) * SK * 128 + cw;
            E1_ROWS({ const int kidx = isctx ? lr : 256 + t;
                _Pragma("unroll") for (int bj = 0; bj < 2; ++bj) *(u32x4*)(Vb + (bj * SK + kidx) * 128) = pack8(acc[ai][bj][m][0], acc[ai][bj][m][1]); })
        } else {
            bf16_t* Gb = GT + (size_t)(u.pm - 4) * 256 * 2048 + (pn - 8) * 256 + cw;
            E1_ROWS({ (void)t;
                _Pragma("unroll") for (int bj = 0; bj < 2; ++bj) { f32x4 v0 = acc[ai][bj][m][0], v1 = acc[ai][bj][m][1];
                    #ifndef DBG_RAW_GATES
                    _Pragma("unroll") for (int j = 0; j < 4; ++j) { v0[j] = sigmoidf_(v0[j]); v1[j] = sigmoidf_(v1[j]); }
#endif

                    st16(Gb + lr * 2048 + 128 * bj, pack8(v0, v1)); } })
        }
#undef E1_ROWS
    }
};

struct SchedUQ {
    int G, c; const char* P0B; const char* WUQ;
    __device__ __forceinline__ bool next(int i, Unit& u) const { const int L = i * G + c; if (L >= 384) return false; u.pn = L % 3; u.pm = L / 3; u.aux = 0; return true; }
    __device__ __forceinline__ const char* a_ptr(const Unit& u) const { return P0B + ((size_t)(NCTX + 256 * u.pm) * 512) * 2; }
    __device__ __forceinline__ const char* b_ptr(const Unit& u) const { return WUQ + (size_t)u.pn * 256 * 256 * 2; }
};
struct EpiUQ {
    static constexpr bool PERM = true, STAGGER = false;
    const float* SSQ; bf16_t* QM; const LAS float* ropeL;
    __device__ __forceinline__ bool keep(const Unit&) const { return false; }
    __device__ __forceinline__ void operator()(f32x4 (&acc)[2][2][4][2], const Unit& u, int wr, int wc, int fr, int fq) const {
        asm volatile("" : "+v"(fr), "+v"(fq));
        const int b = u.pm >> 5, tbase = (u.pm & 31) * 256;
        const float* SQ = SSQ + (size_t)(NCTX + u.pm * 256) * 8; bf16_t* Qb = QM + (size_t)b * 8 * SEQ * 96;
        int hh[2], dd[2];
#pragma unroll
        for (int bj = 0; bj < 2; ++bj) { const int c = 256 * u.pn + 128 * bj + 32 * wc + 8 * fq; hh[bj] = c / 96; dd[bj] = c - 96 * hh[bj]; }
        float rsv[8];
#pragma unroll
        for (int i = 0; i < 8; ++i) { const int lr = 128 * (i >> 2) + 64 * wr + 16 * (i & 3) + fr; const f32x4 sq = *(const f32x4*)(SQ + lr * 8);
            rsv[i] = fast_rsq(((sq[0] + sq[1]) + (sq[2] + sq[3])) * (1.0f / 256.0f) + EPS); }
#pragma unroll
        for (int ai = 0; ai < 2; ++ai)
#pragma unroll
            for (int m = 0; m < 4; ++m) {
                const int lr = 128 * ai + 64 * wr + 16 * m + fr; const int t = tbase + lr;
                const float rs = rsv[ai * 4 + m];
#pragma unroll
                for (int bj = 0; bj < 2; ++bj) { const int h = hh[bj], d = dd[bj];
                    f32x4 v0 = acc[ai][bj][m][0] * rs, v1 = acc[ai][bj][m][1] * rs;
                    if (d >= 64) { const int g = (d - 64) >> 3, axis = g >> 1, sub = g & 1; const int pos = axis ? (t & 63) : (t >> 6);
                        const f32x4 cc = *(const LAS f32x4*)(ropeL + pos * 8 + 4 * sub), ss = *(const LAS f32x4*)(ropeL + 1024 + pos * 8 + 4 * sub); rope4(v0, v1, cc, ss); }
                    v0 = v0 * MLA_QS; v1 = v1 * MLA_QS;
                    *(u32x4*)(Qb + (h * SEQ + t) * 96 + d) = pack8(v0, v1); }
                asm volatile("" ::: "memory");
            }
    }
};
struct SchedUKV {
    int G, c; const char* P0B; const char* WUKV;
    __device__ __forceinline__ bool next(int i, Unit& u) const { const int L = i * G + c; if (L >= 528) return false; u.pn = L & 3; u.pm = L >> 2; u.aux = 0; return true; }
    __device__ __forceinline__ const char* a_ptr(const Unit& u) const { return P0B + ((size_t)(256 * u.pm) * 512 + 256) * 2; }
    __device__ __forceinline__ const char* b_ptr(const Unit& u) const { return WUKV + (size_t)u.pn * 256 * 256 * 2; }
};
struct EpiUKV {
    static constexpr bool PERM = true, STAGGER = false;
    const float* SSQ; const bf16_t* KR; bf16_t* KM; bf16_t* VM; unsigned* KMAX;
    __device__ __forceinline__ bool keep(const Unit&) const { return false; }
    __device__ __forceinline__ void operator()(f32x4 (&acc)[2][2][4][2], const Unit& u, int wr, int wc, int fr, int fq) const {
        asm volatile("" : "+v"(fr), "+v"(fq));
        const bool isctx = u.pm < 4; int b, tbase;
        if (isctx) { b = u.pm; tbase = 0; } else { const int lt = u.pm - 4; b = lt >> 5; tbase = 256 + (lt & 31) * 256; }
        const float* SQ = SSQ + (size_t)(u.pm * 256) * 8 + 4; const bf16_t* KRb = KR + (size_t)b * SK * 32 + 8 * fq;
        bf16_t* Kb = KM + (size_t)(b * 8 + 2 * u.pn) * SK * 96; bf16_t* Vb = VM + (size_t)(b * 8 + 2 * u.pn) * SK * 64;
        float kmx[2] = {0.f, 0.f};
        float rsv[8];
#pragma unroll
        for (int i = 0; i < 8; ++i) { const int lr = 128 * (i >> 2) + 64 * wr + 16 * (i & 3) + fr; const f32x4 sq = *(const f32x4*)(SQ + lr * 8);
            rsv[i] = fast_rsq(((sq[0] + sq[1]) + (sq[2] + sq[3])) * (1.0f / 128.0f) + EPS); }
#pragma unroll
        for (int ai = 0; ai < 2; ++ai)
#pragma unroll
            for (int m = 0; m < 4; ++m) {
                const int lr = 128 * ai + 64 * wr + 16 * m + fr; const int kidx = tbase + lr;
                const float rs = rsv[ai * 4 + m];
#pragma unroll
                for (int bj = 0; bj < 2; ++bj) { const int row = bj * SK + kidx;
                    const f32x4 k0 = acc[ai][bj][m][0] * rs, k1 = acc[ai][bj][m][1] * rs;
                    if (wc < 2) { float s2 = sq4(k0) + sq4(k1); s2 = sum_fq(s2); kmx[bj] = fmaxf(kmx[bj], s2); }
                    const u32x4 w = pack8(k0, k1);
                    if (wc < 2) *(u32x4*)(Kb + row * 96 + 32 * wc + 8 * fq) = w; else *(u32x4*)(Vb + row * 64 + 32 * (wc - 2) + 8 * fq) = w; }
                asm volatile("" ::: "memory");
            }
        if (wc == 0) {
            u32x4 kr[8];
#pragma unroll
            for (int i = 0; i < 8; ++i) { const int lr = 128 * (i >> 2) + 64 * wr + 16 * (i & 3) + fr; kr[i] = *(const u32x4*)(KRb + (tbase + lr) * 32); }
#pragma unroll
            for (int i = 0; i < 8; ++i) { const int lr = 128 * (i >> 2) + 64 * wr + 16 * (i & 3) + fr; const int kidx = tbase + lr;
#pragma unroll
                for (int bj = 0; bj < 2; ++bj) *(u32x4*)(Kb + (bj * SK + kidx) * 96 + 64 + 8 * fq) = kr[i]; }
        }
        if (wc < 2) {
#pragma unroll
            for (int bj = 0; bj < 2; ++bj) { const float mx = wmax16(kmx[bj]); if ((fr | fq) == 0) atomicMax(KMAX + (b * 8 + 2 * u.pn + bj) * 2 + wc, __float_as_uint(mx)); }
        }
    }
};

struct SchedY {
    int G, c; const char* OA; const char* WOC;
    __device__ __forceinline__ bool next(int i, Unit& u) const { if (i >= 4) return false; const int T = (i >> 1) * G + c; if (T >= 512) return false;
        int pm, pn; static_order(T, 128, 4, pm, pn); u.pm = pm; u.pn = pn; u.aux = i & 1; return true; }
    __device__ __forceinline__ const char* a_ptr(const Unit& u) const { return OA + ((size_t)u.pm * 256 * 1024 + u.aux * 512) * 2; }
    __device__ __forceinline__ const char* b_ptr(const Unit& u) const { return WOC + ((size_t)u.pn * 256 * 1024 + u.aux * 512) * 2; }
};
#ifdef EPIY_OLD
struct EpiY {
    static constexpr bool PERM = true, STAGGER = false;
    const bf16_t* GT; bf16_t* Y;
    __device__ __forceinline__ bool keep(const Unit& u) const { return u.aux == 0; }
    __device__ __forceinline__ void operator()(f32x4 (&acc)[2][2][4][2], const Unit& u, int wr, int wc, int fr, int fq) const {
        asm volatile("" : "+v"(fr), "+v"(fq));
#pragma unroll
        for (int ai = 0; ai < 2; ++ai)
#pragma unroll
            for (int m = 0; m < 4; ++m) {
                const size_t rr = (size_t)u.pm * 256 + 128 * ai + 64 * wr + 16 * m + fr;
#pragma unroll
                for (int bj = 0; bj < 2; ++bj) { const int c = 256 * u.pn + 128 * bj + 32 * wc + 8 * fq;
                    const u32x4 gb = *(const u32x4*)(GT + rr * 2048 + 1024 + c);
                    f32x4 b0 = {bf_lo(gb.x), bf_hi(gb.x), bf_lo(gb.y), bf_hi(gb.y)}, b1 = {bf_lo(gb.z), bf_hi(gb.z), bf_lo(gb.w), bf_hi(gb.w)};
                    if (u.aux == 0) {
                        const u32x4 ga = *(const u32x4*)(GT + rr * 2048 + c);
                        const f32x4 a0 = {bf_lo(ga.x), bf_hi(ga.x), bf_lo(ga.y), bf_hi(ga.y)}, a1 = {bf_lo(ga.z), bf_hi(ga.z), bf_lo(ga.w), bf_hi(ga.w)};
#pragma unroll
                        for (int j = 0; j < 4; ++j) { acc[ai][bj][m][0][j] *= (b0[j] > 0.f ? a0[j] * fast_rcp(b0[j]) : 0.f); acc[ai][bj][m][1][j] *= (b1[j] > 0.f ? a1[j] * fast_rcp(b1[j]) : 0.f); }
                    } else {
                        *(u32x4*)(Y + rr * 1024 + c) = pack8(acc[ai][bj][m][0] * b0, acc[ai][bj][m][1] * b1);
                    } }
            }
    }
};

#else
struct EpiY {
    static constexpr bool PERM = true, STAGGER = false;
    const bf16_t* GT; bf16_t* Y;
    __device__ __forceinline__ bool keep(const Unit& u) const { return u.aux == 0; }
    __device__ __forceinline__ void operator()(f32x4 (&acc)[2][2][4][2], const Unit& u, int wr, int wc, int fr, int fq) const {
        asm volatile("" : "+v"(fr), "+v"(fq));
        const bf16_t* Gp = GT + ((size_t)u.pm * 256 + 64 * wr + fr) * 2048 + 256 * u.pn + 32 * wc + 8 * fq;
        if (u.aux == 0) {
#pragma unroll
            for (int ai = 0; ai < 2; ++ai)
#pragma unroll
                for (int m = 0; m < 4; ++m)
#pragma unroll
                    for (int bj = 0; bj < 2; ++bj) { const bf16_t* g = Gp + (128 * ai + 16 * m) * 2048 + 128 * bj;
                        const u32x4 gb = *(const u32x4*)(g + 1024), ga = *(const u32x4*)g;
                        const f32x4 b0 = {bf_lo(gb.x), bf_hi(gb.x), bf_lo(gb.y), bf_hi(gb.y)}, b1 = {bf_lo(gb.z), bf_hi(gb.z), bf_lo(gb.w), bf_hi(gb.w)};
                        const f32x4 a0 = {bf_lo(ga.x), bf_hi(ga.x), bf_lo(ga.y), bf_hi(ga.y)}, a1 = {bf_lo(ga.z), bf_hi(ga.z), bf_lo(ga.w), bf_hi(ga.w)};
#pragma unroll
                        for (int j = 0; j < 4; ++j) { acc[ai][bj][m][0][j] *= (b0[j] > 0.f ? a0[j] * fast_rcp(b0[j]) : 0.f); acc[ai][bj][m][1][j] *= (b1[j] > 0.f ? a1[j] * fast_rcp(b1[j]) : 0.f); } }
        } else {
            bf16_t* Yp = Y + ((size_t)u.pm * 256 + 64 * wr + fr) * 1024 + 256 * u.pn + 32 * wc + 8 * fq;
#pragma unroll
            for (int ai = 0; ai < 2; ++ai) {
                u32x4 gbv[4][2];
#pragma unroll
                for (int m = 0; m < 4; ++m)
#pragma unroll
                    for (int bj = 0; bj < 2; ++bj) gbv[m][bj] = *(const u32x4*)(Gp + (128 * ai + 16 * m) * 2048 + 128 * bj + 1024);
#pragma unroll
                for (int m = 0; m < 4; ++m)
#pragma unroll
                    for (int bj = 0; bj < 2; ++bj) { const u32x4 gb = gbv[m][bj];
                        const f32x4 b0 = {bf_lo(gb.x), bf_hi(gb.x), bf_lo(gb.y), bf_hi(gb.y)}, b1 = {bf_lo(gb.z), bf_hi(gb.z), bf_lo(gb.w), bf_hi(gb.w)};
                        *(u32x4*)(Yp + (128 * ai + 16 * m) * 1024 + 128 * bj) = pack8(acc[ai][bj][m][0] * b0, acc[ai][bj][m][1] * b1); }
                asm volatile("" ::: "memory");
            }
        }
    }
};

#endif
struct SchedZ {
    int G, c; const char* Y; const char* WOUT;
    __device__ __forceinline__ bool next(int i, Unit& u) const { const int L = i * G + c; if (L >= 512) return false; int pm, pn; static_order(L, 128, 4, pm, pn); u.pm = pm; u.pn = pn; u.aux = 0; return true; }
    __device__ __forceinline__ const char* a_ptr(const Unit& u) const { return Y + (size_t)u.pm * 256 * 1024 * 2; }
    __device__ __forceinline__ const char* b_ptr(const Unit& u) const { return WOUT + (size_t)u.pn * 256 * 1024 * 2; }
};
struct EpiZ {
    static constexpr bool PERM = true, STAGGER = false;
    const float* mod; bf16_t* OL;
    __device__ __forceinline__ bool keep(const Unit&) const { return false; }
    __device__ __forceinline__ void operator()(f32x4 (&acc)[2][2][4][2], const Unit& u, int wr, int wc, int fr, int fq) const {
        asm volatile("" : "+v"(fr), "+v"(fq));
        const int b = u.pm >> 5; const float* g1 = mod + b * 6144 + 2048 + 256 * u.pn + 32 * wc + 8 * fq;
        bf16_t* O = OL + (size_t)u.pm * 256 * 1024 + 256 * u.pn + 32 * wc + 8 * fq;
        f32x4 gq[2][2];
#pragma unroll
        for (int bj = 0; bj < 2; ++bj) { gq[bj][0] = *(const f32x4*)(g1 + 128 * bj); gq[bj][1] = *(const f32x4*)(g1 + 128 * bj + 4); }
#pragma unroll
        for (int bj = 0; bj < 2; ++bj) { const f32x4 g0 = gq[bj][0], g4 = gq[bj][1];
#pragma unroll
            for (int ai = 0; ai < 2; ++ai)
#pragma unroll
                for (int m = 0; m < 4; ++m) { const int lr = 128 * ai + 64 * wr + 16 * m + fr;
                    *(u32x4*)(O + lr * 1024 + 128 * bj) = pack8(acc[ai][bj][m][0] * g0, acc[ai][bj][m][1] * g4); } }
    }
};

struct SchedM1 {
    int xcd, slot; const char* XE; const char* W13;
    __device__ __forceinline__ bool next(int i, Unit& u) const { if (i >= 8) return false; const int e = 2 * xcd + (i >> 2), ap = (i & 3) * 4 + (slot >> 3);
        u.pn = slot & 7; u.pm = ((ap >> 2) * 16 + e) * 4 + (ap & 3); u.aux = e; return true; }
    __device__ __forceinline__ const char* a_ptr(const Unit& u) const { return XE + (size_t)(u.pm >> 6) * SEQ * 1024 * 2; }
    __device__ __forceinline__ const char* b_ptr(const Unit& u) const { return W13 + ((size_t)u.aux * 2048 + u.pn * 256) * 1024 * 2; }
};
struct EpiM1 {
    static constexpr bool PERM = true, STAGGER = true;
    bf16_t* HID; int abl;
    __device__ __forceinline__ bool keep(const Unit&) const { return false; }
    __device__ __forceinline__ void operator()(f32x4 (&acc)[2][2][4][2], const Unit& u, int wr, int wc, int fr, int fq) const {
        asm volatile("" : "+v"(fr), "+v"(fq));
        if (abl == 2) return;
#pragma unroll
        for (int ai = 0; ai < 2; ++ai)
#pragma unroll
            for (int m = 0; m < 4; ++m) { const size_t row = (size_t)u.pm * 256 + 128 * ai + 64 * wr + 16 * m + fr;
                f32x4 h0, h1;
#pragma unroll
                for (int j = 0; j < 4; ++j) { const float a0 = acc[ai][0][m][0][j], a1 = acc[ai][0][m][1][j];
                    h0[j] = a0 * sigmoidf_(a0) * acc[ai][1][m][0][j]; h1[j] = a1 * sigmoidf_(a1) * acc[ai][1][m][1][j]; }
                const u32x4 pk = pack8(h0, h1);
                if (abl == 0) st16(HID + row * 1024 + 128 * u.pn + 32 * wc + 8 * fq, pk);
                else if (abl == 3) { u32x2 p2; p2[0] = pk[0] ^ pk[2]; p2[1] = pk[1] ^ pk[3]; *(u32x2*)(HID + row * 1024 + 128 * u.pn + 32 * wc + 8 * fq) = p2; }
                else if (abl == 4) st16(HID + ((size_t)(blockIdx.x * 16) + (row & 15)) * 1024 + 128 * u.pn + 32 * wc + 8 * fq, pk);
                else if (abl == 5) { if (ai == 0 && m == 0) st16(HID + row * 1024 + 128 * u.pn + 32 * wc + 8 * fq, pk); else asm volatile("" :: "v"(pk)); }
                else asm volatile("" :: "v"(pk)); }
    }
};
struct SchedM2 {
    int xcd, slot; const char* HID; const char* W2T;
    __device__ __forceinline__ bool next(int i, Unit& u) const { if (i >= 4) return false; const int e = 2 * xcd + (i >> 1), ap = (i & 1) * 8 + (slot >> 2);
        u.pn = slot & 3; u.pm = ((ap >> 2) * 16 + e) * 4 + (ap & 3); u.aux = e; return true; }
    __device__ __forceinline__ const char* a_ptr(const Unit& u) const { return HID + (size_t)u.pm * 256 * 1024 * 2; }
    __device__ __forceinline__ const char* b_ptr(const Unit& u) const { return W2T + ((size_t)u.aux * 1024 + u.pn * 256) * 1024 * 2; }
};
struct EpiM2 {
    static constexpr bool PERM = true, STAGGER = true;
    const float* GSEL; bf16_t* YE;
    __device__ __forceinline__ bool keep(const Unit&) const { return false; }
    __device__ __forceinline__ void operator()(f32x4 (&acc)[2][2][4][2], const Unit& u, int wr, int wc, int fr, int fq) const {
        asm volatile("" : "+v"(fr), "+v"(fq));
#ifndef EPIM2_OLD
        float gv[8];
#pragma unroll
        for (int i = 0; i < 8; ++i) gv[i] = GSEL[(size_t)u.pm * 256 + 128 * (i >> 2) + 64 * wr + 16 * (i & 3) + fr];
#endif
#ifdef DBG_M2_FENCE
        asm volatile("s_waitcnt vmcnt(0)" ::: "memory");
#endif
#pragma unroll
        for (int ai = 0; ai < 2; ++ai)
#pragma unroll
            for (int m = 0; m < 4; ++m) { const size_t row = (size_t)u.pm * 256 + 128 * ai + 64 * wr + 16 * m + fr;
#ifdef EPIM2_OLD
                const float g = GSEL[row];
#else
                const float g = gv[ai * 4 + m];
#endif
#pragma unroll
                for (int bj = 0; bj < 2; ++bj)
                    st16(YE + row * 1024 + 256 * u.pn + 128 * bj + 32 * wc + 8 * fq, pack8(acc[ai][bj][m][0] * g, acc[ai][bj][m][1] * g)); }
    }
};

struct SchedU {
    SchedUQ q; SchedUKV kv; int G, c;
    __device__ __forceinline__ bool next(int i, Unit& u) const {
#ifdef DBG_UREP
        if (i >= 4 * (DBG_UREP + 1)) return false; int L = (i & 3) * G + c; if (L >= 912) L -= 512;
#else
        if (c < 0) return false;
        const int L = i * G + c; if (L >= 912) return false;
#endif
        if (L < 384) { u.pn = L % 3; u.pm = L / 3; u.aux = 0; } else { const int L2 = L - 384; u.pn = L2 & 3; u.pm = L2 >> 2; u.aux = 1; } return true; }
    __device__ __forceinline__ const char* a_ptr(const Unit& u) const { return u.aux == 0 ? q.a_ptr(u) : kv.a_ptr(u); }
    __device__ __forceinline__ const char* b_ptr(const Unit& u) const { return u.aux == 0 ? q.b_ptr(u) : kv.b_ptr(u); }
};
struct EpiU {
    static constexpr bool PERM = true, STAGGER = false;
    EpiUQ q; EpiUKV kv;
    __device__ __forceinline__ bool keep(const Unit&) const { return false; }
    __device__ __forceinline__ void operator()(f32x4 (&acc)[2][2][4][2], const Unit& u, int wr, int wc, int fr, int fq) const {
        if (u.aux == 0) q(acc, u, wr, wc, fr, fq); else kv(acc, u, wr, wc, fr, fq);
    }
};
namespace fa {
#define KSWZ(row, colB) ((row) * 256 + ((colB) ^ (((row) & 15) << 4)))
#define SBAR() __builtin_amdgcn_sched_barrier(0)
__device__ __forceinline__ int crow(int r, int hi) { return (r & 3) + 8 * (r >> 2) + 4 * hi; }
constexpr float THRL = 11.0f;
constexpr int VOFF = 0, KOFF = 32768, BUFB = 16384, WSOFF = 131072;

__device__ __forceinline__ void partialSM(f32x16& p0, f32x16& p1, float& m_reg, float& alpha) {
    float pmax = p0[0];
#pragma unroll
    for (int r = 1; r < 16; ++r) pmax = fmaxf(pmax, p0[r]);
#pragma unroll
    for (int r = 0; r < 16; ++r) pmax = fmaxf(pmax, p1[r]);
    { auto rr = __builtin_amdgcn_permlane32_swap(__float_as_uint(pmax), __float_as_uint(pmax), false, false);
      pmax = fmaxf(__uint_as_float(rr[0]), __uint_as_float(rr[1])); }
    float mn;
    if (__builtin_expect(__all(pmax - m_reg <= THRL), 1)) { mn = m_reg; alpha = 1.f; }
    else { mn = fmaxf(m_reg, pmax); alpha = fast_exp2(m_reg - mn); m_reg = mn; }
#pragma unroll
    for (int r = 0; r < 16; ++r) { p0[r] -= mn; p1[r] -= mn; }
#pragma unroll
    for (int r = 0; r < 16; ++r) p0[r] = fast_exp2(p0[r]);
}
__device__ __forceinline__ void finishSM(f32x16& p0, f32x16& p1, float alpha, float& l_reg, bf16x8& pa0, bf16x8& pa1, bf16x8& pa2, bf16x8& pa3) {
#pragma unroll
    for (int r = 0; r < 16; ++r) p1[r] = fast_exp2(p1[r]);
    float ps = 0.f;
#pragma unroll
    for (int r = 0; r < 16; ++r) ps += p0[r];
#pragma unroll
    for (int r = 0; r < 16; ++r) ps += p1[r];
    { auto rr = __builtin_amdgcn_permlane32_swap(__float_as_uint(ps), __float_as_uint(ps), false, false);
      ps = __uint_as_float(rr[0]) + __uint_as_float(rr[1]); }
    l_reg = l_reg * alpha + ps;
#define PK4(P, BASE, OUT) do { unsigned a0 = cvt_pk_bf16(P[BASE + 0], P[BASE + 1]), a1 = cvt_pk_bf16(P[BASE + 2], P[BASE + 3]);   \
    unsigned b0 = cvt_pk_bf16(P[BASE + 4], P[BASE + 5]), b1 = cvt_pk_bf16(P[BASE + 6], P[BASE + 7]);                              \
    auto r0 = __builtin_amdgcn_permlane32_swap(a0, b0, false, false); auto r1 = __builtin_amdgcn_permlane32_swap(a1, b1, false, false); \
    u32x4 w = {r0[0], r1[0], r0[1], r1[1]}; OUT = __builtin_bit_cast(bf16x8, w); } while (0)
    PK4(p0, 0, pa0); PK4(p0, 8, pa1); PK4(p1, 0, pa2); PK4(p1, 8, pa3);
#undef PK4
}
template <int NQ>
__device__ __forceinline__ void qkt(f32x16& p0, f32x16& p1, const LAS unsigned char* Ks, const bf16x8* qr, int r32, int hi, int kcolB) {
    p0 = f32x16{}; p1 = f32x16{};
#pragma unroll
    for (int d0 = 0; d0 < NQ; ++d0) { const int cb = kcolB + (d0 * 16 + hi * 8) * 2;
        const bf16x8 b0 = *(const LAS bf16x8*)(Ks + KSWZ(r32, cb));
        const bf16x8 b1 = *(const LAS bf16x8*)(Ks + KSWZ(32 + r32, cb));
        p0 = __builtin_amdgcn_mfma_f32_32x32x16_bf16(b0, qr[d0], p0, 0, 0, 0);
        p1 = __builtin_amdgcn_mfma_f32_32x32x16_bf16(b1, qr[d0], p1, 0, 0, 0); }
}
template <int NCB> __device__ __forceinline__ int v_st(int k, int c) { const int kk = k; return ((kk >> 3) * NCB + (c >> 5)) * 512 + ((kk & 7) * 32 + (c & 31)) * 2; }
__device__ __forceinline__ int v_rd_base(int lane) { return ((lane & 3) << 3) | (((lane >> 2) & 3) << 6) | (((lane >> 4) & 1) << 5) | (((lane >> 5) & 1) << 8); }
template <int OFF> __device__ __forceinline__ s16x4 tr_read(int vb) {
    s16x4 r; asm volatile("ds_read_b64_tr_b16 %0, %1 offset:%2" : "=&v"(r) : "v"(vb), "i"(OFF) : "memory"); return r;
}
template <int NCB, int D0> __device__ __forceinline__ void pv_one(f32x16& od, int vb, bf16x8 pa0, bf16x8 pa1, bf16x8 pa2, bf16x8 pa3) {
#define VO(ks, half) (D0 * 512 + (ks) * (1024 * NCB) + (half) * (512 * NCB))
    const s16x4 l0 = tr_read<VO(0, 0)>(vb), h0 = tr_read<VO(0, 1)>(vb), l1 = tr_read<VO(1, 0)>(vb), h1 = tr_read<VO(1, 1)>(vb);
    const s16x4 l2 = tr_read<VO(2, 0)>(vb), h2 = tr_read<VO(2, 1)>(vb), l3 = tr_read<VO(3, 0)>(vb), h3 = tr_read<VO(3, 1)>(vb);
#undef VO
    asm volatile("s_waitcnt lgkmcnt(0)" ::: "memory"); SBAR();
#define PK(L, H) (bf16x8){L[0], L[1], L[2], L[3], H[0], H[1], H[2], H[3]}
    od = __builtin_amdgcn_mfma_f32_32x32x16_bf16(pa0, PK(l0, h0), od, 0, 0, 0);
    od = __builtin_amdgcn_mfma_f32_32x32x16_bf16(pa1, PK(l1, h1), od, 0, 0, 0);
    od = __builtin_amdgcn_mfma_f32_32x32x16_bf16(pa2, PK(l2, h2), od, 0, 0, 0);
    od = __builtin_amdgcn_mfma_f32_32x32x16_bf16(pa3, PK(l3, h3), od, 0, 0, 0);
#undef PK
}
template <int NCB> __device__ __forceinline__ void pv_all(f32x16* o, int vb, bf16x8 pa0, bf16x8 pa1, bf16x8 pa2, bf16x8 pa3) {
    pv_one<NCB, 0>(o[0], vb, pa0, pa1, pa2, pa3); pv_one<NCB, 1>(o[1], vb, pa0, pa1, pa2, pa3);
    if constexpr (NCB == 4) { pv_one<NCB, 2>(o[2], vb, pa0, pa1, pa2, pa3); pv_one<NCB, 3>(o[3], vb, pa0, pa1, pa2, pa3); }
}

typedef short v4i16_t __attribute__((ext_vector_type(4)));
__device__ __forceinline__ s16x4 vtr(const LAS unsigned char* p) { return __builtin_bit_cast(s16x4, __builtin_amdgcn_ds_read_tr16_b64_v4i16((LAS v4i16_t*)p)); }
template <int LO, int N, int ABL = 0, bool SUM = true> __device__ __forceinline__ void expsum(f32x16& p0, f32x16& p1, float (&ls)[4], int lo_rt, float msub) {
#pragma unroll
    for (int q = 0; q < N; ++q) { const int r = lo_rt + q;
        if (r < 16) { const float e = (ABL & 1) ? (p0[r] - msub) : fast_exp2(p0[r] - msub); p0[r] = e; if (SUM) ls[0] += e; } else if (r < 32) { const float e = (ABL & 1) ? (p1[r - 16] - msub) : fast_exp2(p1[r - 16] - msub); p1[r - 16] = e; if (SUM) ls[0] += e; } }
}
#define PK4(P, BASE, OUT) do { const u32x4 w_ = {cvt_pk_bf16(P[BASE + 0], P[BASE + 1]), cvt_pk_bf16(P[BASE + 2], P[BASE + 3]), cvt_pk_bf16(P[BASE + 4], P[BASE + 5]), cvt_pk_bf16(P[BASE + 6], P[BASE + 7])}; \
    OUT = __builtin_bit_cast(bf16x8, w_); } while (0)

#ifndef ROWSUM_MFMA
#define ROWSUM_MFMA 0
#endif
#ifdef ATT_NOSGB
#define SGB(mask, n) do { } while (0)
#else
#define SGB(mask, n) __builtin_amdgcn_sched_group_barrier(mask, n, 0)
#endif
template <int ABL> __device__ __forceinline__ f32x16 mfma_a(bf16x8 a, bf16x8 b, f32x16 c) { if constexpr (ABL & 2) { asm volatile("" :: "v"(a), "v"(b)); return c; } else return __builtin_amdgcn_mfma_f32_32x32x16_bf16(a, b, c, 0, 0, 0); }
template <int ABL> __device__ __forceinline__ bf16x8 ldsrd_a(const LAS unsigned char* p, bf16x8 alt) { if constexpr (ABL & 16) { asm volatile("" : "+v"(alt)); return alt; } else return *(const LAS bf16x8*)p; }
template <int NQ, int NCB, bool DOQK, bool DOPV, int SHIFT, int ABL, int NEXB>
__device__ __forceinline__ void tile_step(f32x16& c0, f32x16& c1, f32x16& p0, f32x16& p1, f32x16 (&o)[NCB], f32x16& lacc, const LAS unsigned char* Kb, const int (&ka)[NQ],
                                          const bf16x8 (&qr)[NQ], const f32x16& negm, float msub, const LAS unsigned char* Vb) {
    const f32x16 zero16 = {};
    constexpr int NG = 2 * NQ, NM = 4 * NCB;
    SBAR();
    if constexpr (DOQK) {
#pragma unroll
        for (int d0 = 0; d0 < NQ; ++d0) {
            const bf16x8 kf0 = ldsrd_a<ABL>(Kb + ka[d0], qr[d0]), kf1 = ldsrd_a<ABL>(Kb + ka[d0] + 8192, qr[d0]);
            if (d0 == 0) { c0 = mfma_a<ABL>(kf0, qr[d0], (SHIFT == 1) ? negm : zero16); c1 = mfma_a<ABL>(kf1, qr[d0], (SHIFT == 1) ? negm : zero16); }
            else { c0 = mfma_a<ABL>(kf0, qr[d0], c0); c1 = mfma_a<ABL>(kf1, qr[d0], c1); }
        }
    }
    if constexpr (DOPV) {
#define VO(d0, ks, half) ((d0) * 512 + (ks) * (1024 * NCB) + (half) * (512 * NCB))
        bf16x8 pa[4];
        { float ls_[4] = {0.f, 0.f, 0.f, 0.f}; ls_[0] = lacc[0]; expsum<0, 32 - NEXB, ABL, !ROWSUM_MFMA>(p0, p1, ls_, 0, msub);
          PK4(p0, 0, pa[0]); PK4(p0, 8, pa[1]);
          if constexpr (NEXB > 0) expsum<0, NEXB, ABL, !ROWSUM_MFMA>(p0, p1, ls_, 32 - NEXB, msub);
          PK4(p1, 0, pa[2]); PK4(p1, 8, pa[3]);
          if (!ROWSUM_MFMA) lacc[0] = ls_[0]; }
        const u32x4 one4 = {0x3f803f80u, 0x3f803f80u, 0x3f803f80u, 0x3f803f80u}; const bf16x8 ones = __builtin_bit_cast(bf16x8, one4);
#pragma unroll
        for (int idx = 0; idx < NM; ++idx) { const int ks = idx / NCB, d0 = idx % NCB;
#if ROWSUM_MFMA
            if (d0 == 0) lacc = mfma_a<ABL>(pa[ks], ones, lacc);
#endif
            bf16x8 vf;
            if constexpr (ABL & 16) { vf = pa[ks]; asm volatile("" : "+v"(vf)); } else { const s16x4 vl = vtr(Vb + VO(d0, ks, 0)), vh = vtr(Vb + VO(d0, ks, 1)); vf = (bf16x8){vl[0], vl[1], vl[2], vl[3], vh[0], vh[1], vh[2], vh[3]}; }
            o[d0] = mfma_a<ABL>(pa[ks], vf, o[d0]);
        }
#undef VO
    }
#ifndef ATT_PACKFRONT
#define ATT_PACKFRONT 0
#endif
#ifndef ATT_MFMA2
#define ATT_MFMA2 0
#endif
#ifndef ATT_VAH_MLA
#define ATT_VAH_MLA 8
#endif
#ifndef ATT_VAH_DIFF
#define ATT_VAH_DIFF 4
#endif
#ifndef ATT_FRONT
#define ATT_FRONT 8
#endif
#ifndef ATT_KAHEAD
#define ATT_KAHEAD 2
#endif
    constexpr int VAH = (NCB == 4) ? ATT_VAH_DIFF : ATT_VAH_MLA;
    constexpr int VPER = (SHIFT == 2) ? 1 : 0;
    constexpr int NEXA = 32 - NEXB, FRONT = DOQK ? ATT_FRONT : NEXA, HALFM = NM / 2;
#ifndef ATT_KAHEAD_DIFF
#define ATT_KAHEAD_DIFF ATT_KAHEAD
#endif
#ifndef ATT_VSTART
#define ATT_VSTART 4
#endif
    constexpr int KAH_ = (NCB == 4) ? ATT_KAHEAD_DIFF : ATT_KAHEAD;
    constexpr int KFIRST = (KAH_ >= NG) ? NG : KAH_;
    if constexpr (DOQK) SGB(0x100, KFIRST);
    if constexpr (DOPV && FRONT > 0) { SGB(0x400, FRONT); if constexpr (VPER > 0) SGB(0x002, FRONT * VPER); }
    if constexpr (DOQK) {
        constexpr int PER = (NEXA - FRONT + NG - 1) / NG;
#pragma unroll
        for (int g = 0; g < NG; ++g) {
            if (ATT_MFMA2) { if (g & 1) continue;
                if (KFIRST + g < NG) SGB(0x100, 2);
                SGB(0x008, 2);
                if constexpr (DOPV) { if constexpr (PER > 0) { SGB(0x400, 2 * PER); if constexpr (VPER > 0) SGB(0x002, 2 * PER * VPER); } if (g >= NG - ATT_VSTART) SGB(0x100, (4 * VAH) / ATT_VSTART); }
                continue; }
            if (KFIRST + g < NG) SGB(0x100, 1);
            SGB(0x008, 1);
            if constexpr (DOPV) { if constexpr (PER > 0) { SGB(0x400, PER); if constexpr (VPER > 0) SGB(0x002, PER * VPER); } if (g >= NG - ATT_VSTART) SGB(0x100, (2 * VAH) / ATT_VSTART); }
        }
    }
    if constexpr (DOPV) {
        if constexpr (!DOQK) SGB(0x100, 2 * VAH);
        SGB(0x002, ATT_PACKFRONT ? 16 : 8);
        constexpr int PERB = NEXB > 0 ? (NEXB + HALFM - 1) / HALFM : 0;
#pragma unroll
        for (int idx = 0; idx < NM + (ROWSUM_MFMA ? 4 : 0); ++idx) {
            if (idx + VAH < NM) SGB(0x100, 2);
            if constexpr (NEXB > 0) { if (idx == HALFM) SGB(0x002, 8); }
            SGB(0x008, 1);
            if constexpr (NEXB > 0) { if (idx < HALFM) { SGB(0x400, PERB); if constexpr (VPER > 0) SGB(0x002, PERB * VPER); } }
            else { if (!ATT_PACKFRONT && idx < 4) SGB(0x002, 2); }
        }
    }
    if constexpr (DOQK) asm volatile("" : "+v"(c0), "+v"(c1));
    if constexpr (DOPV) {
#pragma unroll
        for (int d = 0; d < NCB; ++d) asm volatile("" : "+v"(o[d]));
        asm volatile("" : "+v"(lacc));
    }
    SBAR();
}

template <int MODE> struct AU { static constexpr int DQK = MODE ? 64 : 96, DV = MODE ? 128 : 64, LDK = MODE ? 128 : 96, NQ = DQK / 16, NLD = (64 * (LDK / 8) + 64 * (DV / 8) + 511) / 512; };
template <int MODE, int ABL, int SHIFT>
__device__ __forceinline__ void attn_unit(LAS unsigned char* lds, const bf16_t* __restrict__ Qu, const bf16_t* __restrict__ Kh, const bf16_t* __restrict__ Vh, bf16_t* Ou,
                                          float kmax0, float kmax1, float lam, const float* __restrict__ gsub, int wave,
                                          const bf16_t* __restrict__ Qn, const bf16_t* __restrict__ Kn, const bf16_t* __restrict__ Vn, bf16x8 (&qr)[AU<MODE>::NQ], bf16x8 (&sr_)[AU<MODE>::NLD]) {
    constexpr int DQK = MODE ? 64 : 96, DV = MODE ? 128 : 64, LDQ = MODE ? 128 : 96, LDK = MODE ? 128 : 96, LDV = DV;
    constexpr int KCPR = LDK / 8, VCPR = LDV / 8, NKCH = 64 * KCPR, NCH = NKCH + 64 * VCPR, NLD = (NCH + 511) / 512, NCB = DV / 32, NQ = DQK / 16, NT = SK / 64;
    static_assert(NQ == AU<MODE>::NQ && NLD == AU<MODE>::NLD, "AU mismatch");
    constexpr int NEXB = 0;
    int tid_ = wave * 64 + lane_id(); asm volatile("" : "+v"(tid_));
    const int tid = tid_, wid = wave, lane = tid & 63, r32 = lane & 31, hi = lane >> 5;
    const int mp = MODE ? (wid >> 2) : 0, qw = MODE ? (wid & 3) : wid;
    f32x16 o[NCB];
#pragma unroll
    for (int d = 0; d < NCB; ++d) o[d] = f32x16{};
    float qss = 0.f;
    const int qoff = (qw * 32 + r32) * LDQ + mp * 64 + hi * 8;
#pragma unroll
    for (int d0 = 0; d0 < NQ; ++d0) {
#pragma unroll
        for (int j = 0; j < 8; ++j) { const float v = bf2f((bf16_t)qr[d0][j]); qss += v * v; } }
    { auto rr = __builtin_amdgcn_permlane32_swap(__float_as_uint(qss), __float_as_uint(qss), false, false); qss = __uint_as_float(rr[0]) + __uint_as_float(rr[1]); }
    const float Mrow = 1.02f * sqrtf(qss) * (mp ? kmax1 : kmax0) + 0.5f;
    f32x16 negm = {}; const float msub = (SHIFT == 2) ? Mrow : 0.f;
    if constexpr (SHIFT == 1) {
#pragma unroll
        for (int r = 0; r < 16; ++r) negm[r] = -Mrow;
        asm volatile("" : "+v"(negm)); }
    unsigned voff[NLD]; int dst[NLD]; bool isk[NLD];
#pragma unroll
    for (int i = 0; i < NLD; ++i) { int c = tid + 512 * i; if (c >= NCH) c -= NCH;
        if (MODE) isk[i] = (i < 2); else isk[i] = (i == 0) || ((i == 1) == (wid < 4));
        if (c < NKCH) { const int row = c / KCPR, ch = c % KCPR; voff[i] = (row * LDK + ch * 8) * 2; dst[i] = KOFF + BUFB + KSWZ(row, ch * 16); }
        else { const int c2 = c - NKCH; const int row = c2 / VCPR, ch = c2 % VCPR; voff[i] = (row * LDV + ch * 8) * 2; dst[i] = VOFF + v_st<NCB>(row, ch * 8); } }
    int ka[NQ];
#pragma unroll
    for (int d0 = 0; d0 < NQ; ++d0) ka[d0] = KSWZ(r32, mp * 128 + (d0 * 16 + hi * 8) * 2);
    const LAS unsigned char* Kb0 = lds + KOFF; const LAS unsigned char* Vb0 = lds + VOFF + v_rd_base(lane);
#define STAGE_LOAD_AT(KB, VB, j) do { const char* kb_ = (const char*)((KB) + (long)((j) + 1) * (64 * LDK)); const char* vb_ = (const char*)((VB) + (long)(j) * (64 * LDV)); \
        _Pragma("unroll") for (int i_ = 0; i_ < NLD; ++i_) sr_[i_] = *(const bf16x8*)((isk[i_] ? kb_ : vb_) + voff[i_]); } while (0)
#define STAGE_LOAD(j) STAGE_LOAD_AT(Kh, Vh, j)
#define STAGE_WRITE(jodd) do { _Pragma("unroll") for (int i_ = 0; i_ < NLD; ++i_) *(LAS bf16x8*)(lds + (dst[i_] ^ ((jodd) ? BUFB : 0))) = sr_[i_]; } while (0)
    f32x16 sA0, sA1, sB0, sB1, lacc = {};
    __syncthreads();
    STAGE_WRITE(1); STAGE_LOAD(0);
    __syncthreads();
    tile_step<NQ, NCB, true, false, SHIFT, ABL, NEXB>(sA0, sA1, sA0, sA1, o, lacc, Kb0, ka, qr, negm, msub, Vb0);
    STAGE_WRITE(0); STAGE_LOAD(1);
    __syncthreads();
#define ITER(C0, C1, P0, P1, todd, t) do { \
        tile_step<NQ, NCB, true, true, SHIFT, ABL, NEXB>(C0, C1, P0, P1, o, lacc, Kb0 + ((todd) ? BUFB : 0), ka, qr, negm, msub, Vb0 + ((todd) ? 0 : BUFB)); \
        STAGE_WRITE(todd); if (!(ABL & 4)) STAGE_LOAD((t) + 1); \
        if (!(ABL & 8)) __syncthreads(); } while (0)
    if (!(ABL & 32))
    for (int t = 1; t + 1 < NT; t += 2) {
        ITER(sB0, sB1, sA0, sA1, 1, t);
        ITER(sA0, sA1, sB0, sB1, 0, t + 1);
    }
    {
        tile_step<NQ, NCB, true, true, SHIFT, ABL, NEXB>(sB0, sB1, sA0, sA1, o, lacc, Kb0 + BUFB, ka, qr, negm, msub, Vb0);
        STAGE_WRITE(1);
        { long dq = Qn - Qu; asm volatile("" : "+s"(dq));
            if constexpr (MODE == 0) { long dk = Kn - Kh, dv = Vn - Vh; asm volatile("" : "+s"(dk), "+s"(dv)); STAGE_LOAD_AT(Kh + dk, Vh + dv, -1); }
#pragma unroll
            for (int d0 = 0; d0 < NQ; ++d0) qr[d0] = *(const bf16x8*)(Qu + dq + qoff + d0 * 16); }
        if (!(ABL & 8)) __syncthreads(); }
    tile_step<NQ, NCB, false, true, SHIFT, ABL, NEXB>(sB0, sB1, sB0, sB1, o, lacc, Kb0, ka, qr, negm, msub, Vb0 + BUFB);
#undef ITER
    float rli[16];
#if ROWSUM_MFMA
#pragma unroll
    for (int r = 0; r < 16; ++r) rli[r] = fast_rcp(lacc[r]);
#else
    { float l_reg = lacc[0]; LAS float* li_l = (LAS float*)(lds + WSOFF) + wid * 64;
      auto rr = __builtin_amdgcn_permlane32_swap(__float_as_uint(l_reg), __float_as_uint(l_reg), false, false); l_reg = __uint_as_float(rr[0]) + __uint_as_float(rr[1]);
      if (hi == 0) li_l[r32] = l_reg; asm volatile("s_waitcnt lgkmcnt(0)" ::: "memory");
#pragma unroll
      for (int r = 0; r < 16; ++r) rli[r] = fast_rcp(li_l[crow(r, hi)]); }
#endif
    if constexpr (MODE == 0) {
        bf16_t* Ow = Ou + (size_t)(wid * 32) * 1024;
#pragma unroll
        for (int r = 0; r < 16; ++r) { const int orow = crow(r, hi);
#pragma unroll
            for (int d0 = 0; d0 < NCB; ++d0) Ow[(size_t)orow * 1024 + d0 * 32 + r32] = (bf16_t)(cvt_pk_bf16(o[d0][r] * rli[r], 0.f) & 0xffffu); }
    } else {
        __syncthreads();
        LAS float* Ost = (LAS float*)lds;
#pragma unroll
        for (int r = 0; r < 16; ++r) { const int row = mp * 128 + qw * 32 + crow(r, hi);
#pragma unroll
            for (int d0 = 0; d0 < NCB; ++d0) Ost[row * 128 + d0 * 32 + r32] = o[d0][r] * rli[r]; }
        __syncthreads();
        const float g0 = gsub[2 * lane], g1 = gsub[2 * lane + 1];
        { long dk = Kn - Kh, dv = Vn - Vh; asm volatile("" : "+s"(dk), "+s"(dv)); STAGE_LOAD_AT(Kh + dk, Vh + dv, -1); }
#pragma unroll 4
        for (int k = 0; k < 16; ++k) { const int row = wid * 16 + k;
            const f32x2 a = *(const LAS f32x2*)(Ost + row * 128 + 2 * lane), b2 = *(const LAS f32x2*)(Ost + (128 + row) * 128 + 2 * lane);
            const float d0 = a.x - lam * b2.x, d1 = a.y - lam * b2.y;
            const float ss = wave_sum(d0 * d0 + d1 * d1);
            const float rs = (fast_rsq(ss * (1.0f / 128.0f) + EPS)) * (1.0f - LAMBDA_INIT);
            *(unsigned*)(Ou + (size_t)row * 1024 + 2 * lane) = cvt_pk_bf16(d0 * rs * g0, d1 * rs * g1); }
    }
#undef STAGE_LOAD
#undef STAGE_LOAD_AT
#undef STAGE_WRITE
}
template <int MODE>
__device__ __forceinline__ void attn_prefetch(const bf16_t* __restrict__ Qu, const bf16_t* __restrict__ Kh, const bf16_t* __restrict__ Vh, int wave, bf16x8 (&qr)[AU<MODE>::NQ], bf16x8 (&sr_)[AU<MODE>::NLD]) {
    constexpr int DV = MODE ? 128 : 64, LDQ = MODE ? 128 : 96, LDK = MODE ? 128 : 96, LDV = DV;
    constexpr int KCPR = LDK / 8, VCPR = LDV / 8, NKCH = 64 * KCPR, NCH = NKCH + 64 * VCPR, NLD = AU<MODE>::NLD, NQ = AU<MODE>::NQ;
    int tid_ = wave * 64 + lane_id(); asm volatile("" : "+v"(tid_));
    const int tid = tid_, wid = wave, lane = tid & 63, r32 = lane & 31, hi = lane >> 5;
    const int mp = MODE ? (wid >> 2) : 0, qw = MODE ? (wid & 3) : wid;
    const int qoff = (qw * 32 + r32) * LDQ + mp * 64 + hi * 8;
#pragma unroll
    for (int d0 = 0; d0 < NQ; ++d0) qr[d0] = *(const bf16x8*)(Qu + qoff + d0 * 16);
#pragma unroll
    for (int i = 0; i < NLD; ++i) { int c = tid + 512 * i; if (c >= NCH) c -= NCH;
        const bool isk = MODE ? (i < 2) : ((i == 0) || ((i == 1) == (wid < 4)));
        unsigned vo; if (c < NKCH) { const int row = c / KCPR, ch = c % KCPR; vo = (row * LDK + ch * 8) * 2; } else { const int c2 = c - NKCH; const int row = c2 / VCPR, ch = c2 % VCPR; vo = (row * LDV + ch * 8) * 2; }
        sr_[i] = *(const bf16x8*)((isk ? (const char*)Kh : (const char*)(Vh - 64 * LDV)) + vo); }
}
#undef PK4
#undef KSWZ
#undef SBAR
}

template <int ABL>
__device__ __forceinline__ void attn_phase(const Ctx& C, unsigned char* ws, const float* gsub) {
    const bf16_t* QM = (const bf16_t*)(ws + WS_QM); const bf16_t* KM = (const bf16_t*)(ws + WS_KM); const bf16_t* VM = (const bf16_t*)(ws + WS_VM);
    const bf16_t* QD = (const bf16_t*)(ws + WS_QD); const bf16_t* KD = (const bf16_t*)(ws + WS_KD); const bf16_t* VD = (const bf16_t*)(ws + WS_VD);
    bf16_t* OA = (bf16_t*)(ws + WS_OA); const float* KMX = (const float*)(ws + WS_KMAX);
    const float lam = *(const float*)(ws + WS_LAM);
    if (!(ABL & 64)) {
        bf16x8 qrM[fa::AU<0>::NQ], srM[fa::AU<0>::NLD];
        { const int bh = C.xcd * 4; fa::attn_prefetch<0>(QM + ((size_t)bh * SEQ + C.slot * 256) * 96, KM + (size_t)bh * SK * 96, VM + (size_t)bh * SK * 64, C.wave, qrM, srM); }
#pragma unroll 1
        for (int r = 0; r < 4; ++r) {
            const int bh = C.xcd * 4 + r, b = bh >> 3, h = bh & 7, qb = C.slot;
            const float kmax = sqrtf(KMX[bh * 2] + KMX[bh * 2 + 1] + KMX[64 + b]);
            const int bn = r < 3 ? bh + 1 : bh;
            fa::attn_unit<0, ABL, 1>(C.lds, QM + ((size_t)bh * SEQ + qb * 256) * 96, KM + (size_t)bh * SK * 96, VM + (size_t)bh * SK * 64,
                             OA + ((size_t)b * SEQ + qb * 256) * 1024 + h * 64, kmax, kmax, lam, gsub, C.wave,
                             QM + ((size_t)bn * SEQ + qb * 256) * 96, KM + (size_t)bn * SK * 96, VM + (size_t)bn * SK * 64, qrM, srM);
        }
    }
    if (!(ABL & 128)) {
        bf16x8 qrD[fa::AU<1>::NQ], srD[fa::AU<1>::NLD];
        { const int bh = C.xcd * 2; fa::attn_prefetch<1>(QD + ((size_t)bh * SEQ + C.slot * 128) * 128, KD + (size_t)bh * SK * 128, VD + (size_t)bh * SK * 128, C.wave, qrD, srD); }
#pragma unroll 1
        for (int r = 0; r < 4; ++r) {
            const int bh = C.xcd * 2 + (r >> 1), b = bh >> 2, h = bh & 3, qb = (r & 1) * 32 + C.slot;
            const float km0 = sqrtf(KMX[68 + bh * 4] + KMX[68 + bh * 4 + 1]), km1 = sqrtf(KMX[68 + bh * 4 + 2] + KMX[68 + bh * 4 + 3]);
            const float qm0 = sqrtf(KMX[132 + bh * 4] + KMX[132 + bh * 4 + 1]), qm1 = sqrtf(KMX[132 + bh * 4 + 2] + KMX[132 + bh * 4 + 3]);
            const bf16_t* Qp = QD + ((size_t)bh * SEQ + qb * 128) * 128; bf16_t* Op = OA + ((size_t)b * SEQ + qb * 128) * 1024 + 512 + h * 128;
            const int rn = r < 3 ? r + 1 : r, bhn = C.xcd * 2 + (rn >> 1), qbn = (rn & 1) * 32 + C.slot;
            const bf16_t* Qn = QD + ((size_t)bhn * SEQ + qbn * 128) * 128; const bf16_t* Kn = KD + (size_t)bhn * SK * 128; const bf16_t* Vn = VD + (size_t)bhn * SK * 128;
            if (fmaxf(qm0 * km0, qm1 * km1) * 1.02f < 100.0f) fa::attn_unit<1, ABL, 0>(C.lds, Qp, KD + (size_t)bh * SK * 128, VD + (size_t)bh * SK * 128, Op, km0, km1, lam, gsub, C.wave, Qn, Kn, Vn, qrD, srD);
            else fa::attn_unit<1, ABL, 2>(C.lds, Qp, KD + (size_t)bh * SK * 128, VD + (size_t)bh * SK * 128, Op, km0, km1, lam, gsub, C.wave, Qn, Kn, Vn, qrD, srD);
        }
    }
    __syncthreads();
}

#if MK_NAIVE_ATTN
template <int MODE>
__global__ __launch_bounds__(256) void naive_attn(const bf16_t* __restrict__ Q, const bf16_t* __restrict__ K, const bf16_t* __restrict__ V, bf16_t* __restrict__ OA,
                                                  const float* __restrict__ lamp, const float* __restrict__ gsub) {
    constexpr int NH = MODE ? 4 : 8, DQK = MODE ? 64 : 96, LDQ = MODE ? 128 : 96, LDK = LDQ, DV = MODE ? 128 : 64, NMAP = MODE ? 2 : 1;
    const int lane = threadIdx.x & 63; const long gw = (long)blockIdx.x * 4 + (threadIdx.x >> 6);
    const int q = (int)(gw % SEQ); const int bh = (int)(gw / SEQ); const int b = bh / NH, h = bh % NH;
    const bf16_t* Qrow = Q + ((size_t)bh * SEQ + q) * LDQ; const bf16_t* Kh = K + (size_t)bh * SK * LDK; const bf16_t* Vh = V + (size_t)bh * SK * DV;
    float res0 = 0.f, res1 = 0.f; const float lam = *lamp;
    for (int mp = 0; mp < NMAP; ++mp) {
        u32x4 qp[DQK / 8];
#pragma unroll
        for (int i = 0; i < DQK / 8; ++i) qp[i] = *(const u32x4*)(Qrow + mp * 64 + 8 * i);
        float m = -1e30f, l = 0.f, acc0 = 0.f, acc1 = 0.f;
        for (int t = 0; t < SK / 64; ++t) {
            const bf16_t* kr = Kh + (size_t)(t * 64 + lane) * LDK + mp * 64; float s = 0.f;
#pragma unroll
            for (int i = 0; i < DQK / 8; ++i) { const u32x4 kv = *(const u32x4*)(kr + 8 * i);
                s += bf_lo(qp[i].x) * bf_lo(kv.x) + bf_hi(qp[i].x) * bf_hi(kv.x) + bf_lo(qp[i].y) * bf_lo(kv.y) + bf_hi(qp[i].y) * bf_hi(kv.y)
                   + bf_lo(qp[i].z) * bf_lo(kv.z) + bf_hi(qp[i].z) * bf_hi(kv.z) + bf_lo(qp[i].w) * bf_lo(kv.w) + bf_hi(qp[i].w) * bf_hi(kv.w); }
            const float mn = fmaxf(m, wave_max(s)); const float alpha = exp2f(m - mn); const float p = exp2f(s - mn);
            l = l * alpha + wave_sum(p); acc0 *= alpha; acc1 *= alpha; m = mn;
            for (int kk = 0; kk < 64; ++kk) { const float pk = __shfl(p, kk); const bf16_t* vr = Vh + (size_t)(t * 64 + kk) * DV;
                acc0 += pk * bf2f(vr[lane]); if (DV == 128) acc1 += pk * bf2f(vr[64 + lane]); }
        }
        const float il = 1.0f / l;
        if (mp == 0) { res0 = acc0 * il; res1 = acc1 * il; } else { res0 -= lam * acc0 * il; res1 -= lam * acc1 * il; }
    }
    if (MODE == 0) { OA[((size_t)b * SEQ + q) * 1024 + h * 64 + lane] = (bf16_t)(cvt_pk_bf16(res0, 0.f) & 0xffffu); }
    else { const float ss = wave_sum(res0 * res0 + res1 * res1); const float rs = (fast_rsq(ss * (1.0f / 128.0f) + EPS)) * (1.0f - LAMBDA_INIT);
        bf16_t* o = OA + ((size_t)b * SEQ + q) * 1024 + 512 + h * 128;
        o[lane] = (bf16_t)(cvt_pk_bf16(res0 * rs * gsub[lane], 0.f) & 0xffffu); o[64 + lane] = (bf16_t)(cvt_pk_bf16(res1 * rs * gsub[64 + lane], 0.f) & 0xffffu); }
}
#endif
__device__ __forceinline__ int invperm64(int d) { const int a = d >> 5, half = (d >> 4) & 1, i = d & 15; return (a * 4 + (i >> 2)) * 8 + half * 4 + (i & 3); }
__device__ __forceinline__ int invperm32(int d) { const int a = d >> 4, half = (d >> 3) & 1, i = d & 7; return (a * 2 + (i >> 2)) * 8 + half * 4 + (i & 3); }
struct MapWin { __device__ __forceinline__ int operator()(int n) const {
    if (n < 384) return n;
    if (n < 416) return 384 + invperm32(n - 384);
    if (n < 1440) { const int isk = n >= 928; const int rel = n - (isk ? 928 : 416); return (isk ? 1024 : 512) + (rel & ~63) + invperm64(rel & 63); }
    if (n < 1952) return 1536 + (n - 1440);
    return 2048 + (n - 1952); } };
struct MapUq { __device__ __forceinline__ int operator()(int n) const { const int h = n / 96, d = n - 96 * h; return d < 64 ? n : h * 96 + 64 + invperm32(d - 64); } };
struct MapId { int off; __device__ __forceinline__ int operator()(int n) const { return off + n; } };
struct MapW13 { int off; __device__ __forceinline__ int operator()(int f) const { return off + (f >> 7) * 256 + (f & 127); } };

struct TrSrc { const float* W; int ldw, k0, n0; };
__device__ __forceinline__ void tr_load(const TrSrc& t, f32x4 (&v)[8], int lane) {
#pragma unroll
    for (int i = 0; i < 8; ++i) v[i] = *(const f32x4*)(t.W + (size_t)(t.k0 + 8 * i + (lane >> 3)) * t.ldw + t.n0 + (lane & 7) * 4);
}
template <class RM>
__device__ __forceinline__ void tr_store(f32x4 (&v)[8], int k0, int n0, bf16_t* WT, int ldt, int kdst0, const float* kscale, RM rm, LAS float* scr, int lane) {
#pragma unroll
    for (int i = 0; i < 8; ++i) { const int kk = 8 * i + (lane >> 3); f32x4 w = v[i]; if (kscale) w = w * kscale[k0 + kk]; LAS float* d = scr + kk * 33 + (lane & 7) * 4;
        d[0] = w[0]; d[1] = w[1]; d[2] = w[2]; d[3] = w[3]; }
    asm volatile("s_waitcnt lgkmcnt(0)" ::: "memory");
    const int c = lane & 7;
#pragma unroll
    for (int j = 0; j < 4; ++j) { const int n = (lane >> 3) + 8 * j; const LAS float* s = scr + (8 * c) * 33 + n;
        u32x4 o; o.x = cvt_pk_bf16(s[0 * 33], s[1 * 33]); o.y = cvt_pk_bf16(s[2 * 33], s[3 * 33]); o.z = cvt_pk_bf16(s[4 * 33], s[5 * 33]); o.w = cvt_pk_bf16(s[6 * 33], s[7 * 33]);
        *(u32x4*)(WT + (size_t)rm(n0 + n) * ldt + kdst0 + k0 + 8 * c) = o; }
    asm volatile("s_waitcnt lgkmcnt(0)" ::: "memory");
}
template <class RM>
__device__ __forceinline__ void tr_item(const float* __restrict__ W, int ldw, int k0, int n0, bf16_t* WT, int ldt, int kdst0, const float* kscale, RM rm, LAS float* scr, int lane) {
    f32x4 v[8]; tr_load(TrSrc{W, ldw, k0, n0}, v, lane); tr_store(v, k0, n0, WT, ldt, kdst0, kscale, rm, scr, lane);
}
namespace p0i { constexpr int I_IN = 16 * 125, I_UQ = 4 * 24, I_UKV = 2 * 32, I_OM = 8 * 32, I_OD = 8 * 32, I_OUT = 16 * 32, I_E = 16 * 16 * 32;
    constexpr int NITEMS = I_IN + I_UQ + I_UKV + I_OM + I_OD + I_OUT + 2 * I_E; }
__device__ __forceinline__ TrSrc p0_item_src(KA A, int it) {
    using namespace p0i; int r = it;
    if (r < I_IN) return TrSrc{A->in[6], NIN, 64 * (r / 125), 32 * (r % 125)}; r -= I_IN;
    if (r < I_UQ) return TrSrc{A->in[8], 768, 64 * (r / 24), 32 * (r % 24)}; r -= I_UQ;
    if (r < I_UKV) return TrSrc{A->in[10], 1024, 64 * (r / 32), 32 * (r % 32)}; r -= I_UKV;
    if (r < I_OM) return TrSrc{A->in[11], 1024, 64 * (r / 32), 32 * (r % 32)}; r -= I_OM;
    if (r < I_OD) return TrSrc{A->in[14], 1024, 64 * (r / 32), 32 * (r % 32)}; r -= I_OD;
    if (r < I_OUT) return TrSrc{A->in[15], 1024, 64 * (r / 32), 32 * (r % 32)}; r -= I_OUT;
    const int which = r / I_E; r -= which * I_E; const int e = r / 512, q = r % 512;
    return TrSrc{(which == 0 ? A->in[20] : A->in[21]) + (size_t)e * 1024 * 1024, 1024, 64 * (q / 32), 32 * (q % 32)};
}
__device__ __forceinline__ void p0_item_store(KA A, unsigned char* ws, int it, f32x4 (&v)[8], LAS float* scr, int lane) {
    using namespace p0i; int r = it;
    if (r < I_IN) { tr_store(v, 64 * (r / 125), 32 * (r % 125), (bf16_t*)(ws + WS_WIN), 1024, 0, nullptr, MapWin{}, scr, lane); return; } r -= I_IN;
    if (r < I_UQ) { tr_store(v, 64 * (r / 24), 32 * (r % 24), (bf16_t*)(ws + WS_WUQ), 256, 0, A->in[7], MapUq{}, scr, lane); return; } r -= I_UQ;
    if (r < I_UKV) { tr_store(v, 64 * (r / 32), 32 * (r % 32), (bf16_t*)(ws + WS_WUKV), 256, 0, A->in[9], MapId{0}, scr, lane); return; } r -= I_UKV;
    if (r < I_OM) { tr_store(v, 64 * (r / 32), 32 * (r % 32), (bf16_t*)(ws + WS_WOC), 1024, 0, nullptr, MapId{0}, scr, lane); return; } r -= I_OM;
    if (r < I_OD) { tr_store(v, 64 * (r / 32), 32 * (r % 32), (bf16_t*)(ws + WS_WOC), 1024, 512, nullptr, MapId{0}, scr, lane); return; } r -= I_OD;
    if (r < I_OUT) { tr_store(v, 64 * (r / 32), 32 * (r % 32), (bf16_t*)(ws + WS_WOUT), 1024, 0, nullptr, MapId{0}, scr, lane); return; } r -= I_OUT;
    const int which = r / I_E; r -= which * I_E; const int e = r / 512, q = r % 512;
    tr_store(v, 64 * (q / 32), 32 * (q % 32), (bf16_t*)(ws + WS_W13), 1024, 0, nullptr, MapW13{e * 2048 + (which ? 128 : 0)}, scr, lane);
}

#ifndef P0_SHARE_BUSY
#define P0_SHARE_BUSY 5
#endif
__device__ __forceinline__ void p0_prologue(const Ctx& C0, KA A) {
    Ctx C = C0; C.tid = C.wave * 64 + lane_id(); asm volatile("" : "+v"(C.tid)); C.lane = C.tid & 63;
    unsigned char* ws = A->ws;
    const float* cvec = A->in[1]; const float* cctx = A->in[3]; const float* w_ada = A->in[4]; const float* b_ada = A->in[5];
    if (C.vcu < 96) {
        LAS float* sl = (LAS float*)(C.lds + 86016);
        for (int i = C.tid; i < 5 * 1024; i += NTHR) { const float cv = (i < 4096) ? cvec[i] : cctx[i - 4096]; sl[i] = cv * sigmoidf_(cv); }
        __syncthreads();
        const int col = C.vcu * 64 + C.lane; float acc[5] = {0.f, 0.f, 0.f, 0.f, 0.f};
#pragma unroll 32
        for (int k = C.wave * 128; k < C.wave * 128 + 128; ++k) { const float wv = w_ada[(size_t)k * 6144 + col];
#pragma unroll
            for (int r = 0; r < 5; ++r) acc[r] += sl[r * 1024 + k] * wv; }
        LAS float* red = (LAS float*)(C.lds + 73728);
#pragma unroll
        for (int r = 0; r < 5; ++r) red[(C.wave * 5 + r) * 64 + C.lane] = acc[r];
        __syncthreads();
        if (C.tid < 320) { const int r = C.tid >> 6, l = C.tid & 63; float s = 0.f;
#pragma unroll
            for (int w = 0; w < 8; ++w) s += red[(w * 5 + r) * 64 + l];
            ((float*)(ws + WS_MOD))[r * 6144 + C.vcu * 64 + l] = s + b_ada[C.vcu * 64 + l]; }
        __syncthreads();
    }
    if (C.vcu == C.G - 1) {
        if (C.tid < 196) ((unsigned*)(ws + WS_KMAX))[C.tid] = 0u;
        float* rope = (float*)(ws + WS_ROPE);
        for (int i = C.tid; i < 2048; i += NTHR) { const int pos = i >> 4, f = i & 15; const float inv = exp2f(-(float)f * (13.287712379549449f / 16.0f)); const float ang = (float)pos * inv;
            rope[i] = cosf(ang); rope[2048 + i] = sinf(ang); }
        for (int i = C.tid; i < 1024; i += NTHR) { const int pos = i >> 3, f = i & 7; const float inv = exp2f(-(float)f * (13.287712379549449f / 8.0f)); const float ang = (float)pos * inv;
            rope[4096 + i] = cosf(ang); rope[5120 + i] = sinf(ang); }
        if (C.wave == 0) { const float* dl = A->in[12]; const float s1 = wave_sum(dl[C.lane] * dl[64 + C.lane]), s2 = wave_sum(dl[128 + C.lane] * dl[192 + C.lane]);
            if (C.lane == 0) *(float*)(ws + WS_LAM) = expf(s1) - expf(s2) + LAMBDA_INIT; }
    }
    LAS float* scr = (LAS float*)(C.lds + C.wave * 8448);
    {
        constexpr int NBUSY = 97, SHARE_BUSY = P0_SHARE_BUSY;
        constexpr int N_B = NBUSY * NWAVES * SHARE_BUSY;
        const bool busy = C.vcu < 96 || C.vcu == C.G - 1;
        const int widx = busy ? ((C.vcu < 96 ? C.vcu : 96) * NWAVES + C.wave) : ((C.vcu - 96) * NWAVES + C.wave);
        const int stride = busy ? NBUSY * NWAVES : (C.G - NBUSY) * NWAVES;
        const int first = busy ? widx : N_B + widx, end = busy ? N_B : p0i::NITEMS;
        f32x4 v[8];
        if (first < end) tr_load(p0_item_src(A, first), v, C.lane);
        for (int it = first; it < end; it += stride) {
            const int nx = (it + stride < end) ? it + stride : it;
            f32x4 vn[8]; tr_load(p0_item_src(A, nx), vn, C.lane);
            p0_item_store(A, ws, it, v, scr, C.lane);
#pragma unroll
            for (int i = 0; i < 8; ++i) v[i] = vn[i];
        }
    }
    const int gt = C.vcu * NTHR + C.tid, NGT = C.G * NTHR; const u32x4 z4 = {0u, 0u, 0u, 0u};
    for (int i = gt; i < 96 * 128; i += NGT) *(u32x4*)(ws + WS_WIN + (size_t)416 * 2048 + (size_t)i * 16) = z4;
    for (int i = gt; i < 1024 * 16; i += NGT) *(u32x4*)(ws + WS_WUKV + (size_t)(i >> 4) * 512 + 256 + (size_t)(i & 15) * 16) = z4;
}

__device__ __forceinline__ void mod_row(KA A, const float* mod, bf16_t* A1, int r, int lane) {
    const float* src = r < NCTX ? A->in[2] + (size_t)r * 1024 : A->in[0] + (size_t)(r - NCTX) * 1024;
    const float* sh = mod + (r < NCTX ? 4 : ((r - NCTX) >> 13)) * 6144; const float* sc = sh + 1024;
#pragma unroll
    for (int j = 0; j < 4; ++j) { const int d = 4 * lane + 256 * j; const f32x4 v = *(const f32x4*)(src + d), s = *(const f32x4*)(sc + d), h = *(const f32x4*)(sh + d);
        const f32x4 o = v * (s + 1.0f) + h; u32x2 w; w.x = cvt_pk_bf16(o[0], o[1]); w.y = cvt_pk_bf16(o[2], o[3]);
        *(u32x2*)(A1 + (size_t)r * 1024 + d) = w; }
}
__device__ __forceinline__ void p0b_modulate(const Ctx& C0, KA A, int bx, bool ctxsplit) {
    Ctx C = C0; C.tid = C.wave * 64 + lane_id(); asm volatile("" : "+v"(C.tid)); C.lane = C.tid & 63;
    const float* mod = (const float*)(A->ws + WS_MOD); bf16_t* A1 = (bf16_t*)(A->ws + WS_A1);
    if (!ctxsplit) {
        const int gw = C.vcu * NWAVES + C.wave, NGW = C.G * NWAVES;
        f32x4 xin[4];
        { const float* src = gw < NCTX ? A->in[2] + (size_t)gw * 1024 : A->in[0] + (size_t)(gw - NCTX) * 1024;
#pragma unroll
          for (int j = 0; j < 4; ++j) xin[j] = *(const f32x4*)(src + 4 * C.lane + 256 * j); }
        int cm = -1; f32x4 sv1[4], hv[4];
        for (int r = gw; r < MTOT; r += NGW) {
            const int mi = r < NCTX ? 4 : ((r - NCTX) >> 13);
            if (mi != cm) { cm = mi; const float* sh = mod + mi * 6144; const float* sc = sh + 1024;
#pragma unroll
                for (int j = 0; j < 4; ++j) { const int d = 4 * C.lane + 256 * j; sv1[j] = *(const f32x4*)(sc + d) + 1.0f; hv[j] = *(const f32x4*)(sh + d); } }
            f32x4 cur[4];
#pragma unroll
            for (int j = 0; j < 4; ++j) cur[j] = xin[j];
            { const int nr = (r + NGW < MTOT) ? r + NGW : r; const float* src = nr < NCTX ? A->in[2] + (size_t)nr * 1024 : A->in[0] + (size_t)(nr - NCTX) * 1024;
#pragma unroll
              for (int j = 0; j < 4; ++j) xin[j] = *(const f32x4*)(src + 4 * C.lane + 256 * j); }
#pragma unroll
            for (int j = 0; j < 4; ++j) { const int d = 4 * C.lane + 256 * j;
                const f32x4 o = cur[j] * sv1[j] + hv[j]; u32x2 w; w.x = cvt_pk_bf16(o[0], o[1]); w.y = cvt_pk_bf16(o[2], o[3]);
                *(u32x2*)(A1 + (size_t)r * 1024 + d) = w; }
        }
    } else if (bx < 20) {
        const int r0 = (bx / 5) * 256 + C.wave * 32;
        for (int r = r0; r < r0 + 32; ++r) mod_row(A, mod, A1, r, C.lane);
        __threadfence(); __syncthreads();
    } else {
        const int gw = (bx - 20) * NWAVES + C.wave, NGW = (C.G - 20) * NWAVES;
        for (int r = NCTX + gw; r < MTOT; r += NGW) mod_row(A, mod, A1, r, C.lane);
    }
}

__device__ __forceinline__ void p4_ln_router(const Ctx& C0, KA A) {
    Ctx C = C0; C.tid = C.wave * 64 + lane_id(); asm volatile("" : "+v"(C.tid)); C.lane = C.tid & 63;
    bf16_t* X1B = (bf16_t*)(A->ws + WS_X1B); const bf16_t* OL = (const bf16_t*)(A->ws + WS_OL); const float* X = A->in[0]; bf16_t* H2 = (bf16_t*)(A->ws + WS_H2); float* aff = (float*)(A->ws + WS_AFF); const float* mod = (const float*)(A->ws + WS_MOD);
    LAS float* wrt = (LAS float*)C.lds;
    for (int i = C.tid; i < 16384; i += NTHR) wrt[(i & 15) * 1024 + (i >> 4)] = A->in[18][i];
    __syncthreads();
    f32x4 lg[4], lb[4];
#pragma unroll
    for (int j = 0; j < 4; ++j) { lg[j] = *(const f32x4*)(A->in[16] + 4 * C.lane + 256 * j); lb[j] = *(const f32x4*)(A->in[17] + 4 * C.lane + 256 * j); }
    const int gw = C.vcu * NWAVES + C.wave, NGW = C.G * NWAVES;
    f32x4 xin[4]; u32x2 oin[4];
#pragma unroll
    for (int j = 0; j < 4; ++j) { const int d = 4 * C.lane + 256 * j; xin[j] = *(const f32x4*)(X + (size_t)gw * 1024 + d); oin[j] = *(const u32x2*)(OL + (size_t)gw * 1024 + d); }
    int cb = -1; f32x4 sc2p[4], sh2v[4];
    const float rbias = A->in[19][(C.lane >> 2) & 15];
    for (int row = gw; row < NLAT; row += NGW) {
        const int b = row >> 13, n = row & 8191; bf16_t* zr = X1B + (size_t)row * 1024;
        if (b != cb) { cb = b; const float* sh2 = mod + b * 6144 + 3 * 1024; const float* sc2 = mod + b * 6144 + 4 * 1024;
#pragma unroll
            for (int j = 0; j < 4; ++j) { const int d = 4 * C.lane + 256 * j; sc2p[j] = *(const f32x4*)(sc2 + d) + 1.0f; sh2v[j] = *(const f32x4*)(sh2 + d); } }
        f32x4 v[4]; float s = 0.f;
#pragma unroll
        for (int j = 0; j < 4; ++j) { v[j] = xin[j] * ALPHA + (f32x4){bf_lo(oin[j].x), bf_hi(oin[j].x), bf_lo(oin[j].y), bf_hi(oin[j].y)}; s += (v[j][0] + v[j][1]) + (v[j][2] + v[j][3]); }
        { const int nrow = (row + NGW < NLAT) ? row + NGW : row;
#pragma unroll
          for (int j = 0; j < 4; ++j) { const int d = 4 * C.lane + 256 * j; xin[j] = *(const f32x4*)(X + (size_t)nrow * 1024 + d); oin[j] = *(const u32x2*)(OL + (size_t)nrow * 1024 + d); } }
        const float mean = wave_sum(s) * (1.0f / 1024.0f); float s2 = 0.f;
#pragma unroll
        for (int j = 0; j < 4; ++j) { v[j] = v[j] - mean; s2 += sq4(v[j]); }
        const float rstd = fast_rsq(wave_sum(s2) * (1.0f / 1024.0f) + EPS);
        float p[16];
#pragma unroll
        for (int e = 0; e < 16; ++e) p[e] = 0.f;
#pragma unroll
        for (int j = 0; j < 4; ++j) { const int d = 4 * C.lane + 256 * j; const f32x4 x1 = v[j] * rstd * lg[j] + lb[j];
            { u32x2 w1; w1.x = cvt_pk_bf16(x1[0], x1[1]); w1.y = cvt_pk_bf16(x1[2], x1[3]); *(u32x2*)(zr + d) = w1; }
            const f32x4 h = x1 * sc2p[j] + sh2v[j];
            u32x2 w; w.x = cvt_pk_bf16(h[0], h[1]); w.y = cvt_pk_bf16(h[2], h[3]); *(u32x2*)(H2 + (size_t)row * 1024 + d) = w;
#pragma unroll
            for (int e = 0; e < 16; ++e) { const f32x4 wv = *(const LAS f32x4*)(wrt + e * 1024 + d); p[e] += (h[0] * wv[0] + h[1] * wv[1]) + (h[2] * wv[2] + h[3] * wv[3]); if ((e & 3) == 3) asm volatile("" ::: "memory"); } }
        const bool h5 = (C.lane & 32) != 0, h4 = (C.lane & 16) != 0, h3 = (C.lane & 8) != 0, h2b = (C.lane & 4) != 0;
#pragma unroll
        for (int e = 0; e < 8; ++e) { const float keep = h5 ? p[e + 8] : p[e], send = h5 ? p[e] : p[e + 8];
            auto rr = __builtin_amdgcn_permlane32_swap(__float_as_uint(send), __float_as_uint(send), false, false); p[e] = keep + __uint_as_float(h5 ? rr[0] : rr[1]); }
#pragma unroll
        for (int e = 0; e < 4; ++e) { const float keep = h4 ? p[e + 4] : p[e], send = h4 ? p[e] : p[e + 4]; p[e] = keep + swz_xor<16>(send); }
#pragma unroll
        for (int e = 0; e < 2; ++e) { const float keep = h3 ? p[e + 2] : p[e], send = h3 ? p[e] : p[e + 2]; p[e] = keep + swz_xor<8>(send); }
        { const float keep = h2b ? p[1] : p[0], send = h2b ? p[0] : p[1]; p[0] = keep + swz_xor<4>(send); }
        p[0] += swz_xor<2>(p[0]); p[0] += swz_xor<1>(p[0]);
        const int myexp = (C.lane >> 2) & 15;
        const float logit = p[0] + rbias;
        float mx = logit; mx = fmaxf(mx, swz_xor<4>(mx)); mx = fmaxf(mx, swz_xor<8>(mx)); mx = fmaxf(mx, swz_xor<16>(mx));
        { auto rr = __builtin_amdgcn_permlane32_swap(__float_as_uint(mx), __float_as_uint(mx), false, false); mx = fmaxf(__uint_as_float(rr[0]), __uint_as_float(rr[1])); }
        const float ex = expf(logit - mx); float den = ex; den += swz_xor<4>(den); den += swz_xor<8>(den); den += swz_xor<16>(den); den = half_sum(den);
        if ((C.lane & 3) == 0) aff[((size_t)b * 16 + myexp) * SEQ + n] = ex / den;
    }
    __syncthreads();
}

__device__ __forceinline__ unsigned block_incl_scan(unsigned v, LAS unsigned* wtot, int lane, int wave, unsigned& total) {
    unsigned x = v;
#pragma unroll
    for (int o = 1; o < 64; o <<= 1) { const unsigned y = __shfl_up(x, o); if (lane >= o) x += y; }
    if (lane == 63) wtot[wave] = x;
    __syncthreads();
    unsigned off = 0, tot = 0;
#pragma unroll
    for (int w = 0; w < 8; ++w) { const unsigned t = wtot[w]; off += (w < wave) ? t : 0u; tot += t; }
    __syncthreads();
    total = tot; return x + off;
}
__device__ __forceinline__ void p5_topk(const Ctx& C0, KA A) {
    Ctx C = C0; C.tid = C.wave * 64 + lane_id(); asm volatile("" : "+v"(C.tid)); C.lane = C.tid & 63;
    const float* aff = (const float*)(A->ws + WS_AFF); int* idx = (int*)(A->ws + WS_IDX); float* gsel = (float*)(A->ws + WS_GSEL); short* slotmap = (short*)(A->ws + WS_SLOT);
    LAS unsigned* hist = (LAS unsigned*)C.lds; LAS unsigned* wtot = hist + 4096; LAS unsigned* res = wtot + 16;
    if (C.vcu >= NB * NE) {
        LAS float* scr = (LAS float*)(C.lds + C.wave * 8448); unsigned char* ws = A->ws;
        const int gw2 = (C.vcu - NB * NE) * NWAVES + C.wave, NGW2 = (C.G - NB * NE) * NWAVES;
        f32x4 v[8]; const float* w2 = A->in[22];
        if (gw2 < 16 * 512) tr_load(TrSrc{w2 + (size_t)(gw2 / 512) * 1024 * 1024, 1024, 64 * ((gw2 % 512) / 32), 32 * (gw2 % 32)}, v, C.lane);
        for (int r = gw2; r < 16 * 512; r += NGW2) { const int e = r / 512, q = r % 512;
            const int rn = (r + NGW2 < 16 * 512) ? r + NGW2 : r; f32x4 vn[8];
            tr_load(TrSrc{w2 + (size_t)(rn / 512) * 1024 * 1024, 1024, 64 * ((rn % 512) / 32), 32 * (rn % 32)}, vn, C.lane);
            tr_store(v, 64 * (q / 32), 32 * (q % 32), (bf16_t*)(ws + WS_W2T), 1024, 0, nullptr, MapId{e * 1024}, scr, C.lane);
#pragma unroll
            for (int i = 0; i < 8; ++i) v[i] = vn[i]; }
    }
    for (int be = C.vcu; be < NB * NE; be += C.G) {
        const int b = be >> 4, e = be & 15; unsigned key[16];
#pragma unroll
        for (int j = 0; j < 4; ++j) { const u32x4 k4 = *(const u32x4*)(aff + (size_t)be * SEQ + C.tid * 16 + 4 * j); key[4 * j] = k4.x; key[4 * j + 1] = k4.y; key[4 * j + 2] = k4.z; key[4 * j + 3] = k4.w; }
        unsigned prefix = 0u, mask = 0u, need = CAP;
#pragma unroll
        for (int pass = 0; pass < 3; ++pass) {
            const int shift = pass == 0 ? 20 : (pass == 1 ? 8 : 0), nb = pass == 2 ? 256 : 4096;
            for (int i = C.tid; i < nb; i += NTHR) hist[i] = 0u;
            __syncthreads();
#pragma unroll
            for (int k = 0; k < 16; ++k) if ((key[k] & mask) == prefix) atomicAdd((unsigned*)(hist + ((key[k] >> shift) & (unsigned)(nb - 1))), 1u);
            __syncthreads();
            const int per = nb / NTHR > 0 ? nb / NTHR : 1; const int lo = C.tid * per; unsigned s = 0u;
            if (lo < nb) for (int d = 0; d < per; ++d) s += hist[lo + d];
            unsigned total; const unsigned incl = block_incl_scan(s, wtot, C.lane, C.wave, total);
            unsigned running = total - incl;
            if (lo < nb) for (int d = per - 1; d >= 0; --d) { const unsigned hv = hist[lo + d]; if (running < need && need <= running + hv) { res[0] = (unsigned)(lo + d); res[1] = running; } running += hv; }
            __syncthreads();
            prefix |= res[0] << shift; mask |= (unsigned)(nb - 1) << shift; need -= res[1];
            __syncthreads();
        }
        const unsigned T = prefix; unsigned cg = 0u, ce = 0u;
#pragma unroll
        for (int k = 0; k < 16; ++k) { cg += key[k] > T ? 1u : 0u; ce += key[k] == T ? 1u : 0u; }
        unsigned total; const unsigned packed = cg | (ce << 16); const unsigned excl = block_incl_scan(packed, wtot, C.lane, C.wave, total) - packed;
        unsigned eqr = excl >> 16; unsigned slot = (excl & 0xffffu) + (eqr < need ? eqr : need);
#pragma unroll
        for (int k = 0; k < 16; ++k) { const int n = C.tid * 16 + k; const bool iseq = key[k] == T; const bool sel = key[k] > T || (iseq && eqr < need); eqr += iseq ? 1u : 0u;
            slotmap[(size_t)be * SEQ + n] = sel ? (short)slot : (short)-1;
            if (sel) { idx[be * CAP + slot] = n; gsel[be * CAP + slot] = __uint_as_float(key[k]); ++slot; } }
        __syncthreads();
    }
}
__device__ __forceinline__ void p5b_gather(const Ctx& C0, KA A) {
    Ctx C = C0; C.tid = C.wave * 64 + lane_id(); asm volatile("" : "+v"(C.tid)); C.lane = C.tid & 63;
    const int* idx = (const int*)(A->ws + WS_IDX); const bf16_t* H2 = (const bf16_t*)(A->ws + WS_H2); bf16_t* XE = (bf16_t*)(A->ws + WS_XE);
    const int gw = C.vcu * NWAVES + C.wave, NGW = C.G * NWAVES;
    for (int r = gw; r < NB * NE * CAP; r += NGW) { const int b = r >> 14; const int n = idx[r];
        const bf16_t* s = H2 + ((size_t)b * SEQ + n) * 1024; bf16_t* d = XE + (size_t)r * 1024;
        const u32x4 v0 = *(const u32x4*)(s + 8 * C.lane), v1 = *(const u32x4*)(s + 512 + 8 * C.lane);
        *(u32x4*)(d + 8 * C.lane) = v0; *(u32x4*)(d + 512 + 8 * C.lane) = v1; }
}
__device__ __forceinline__ void p8_final(const Ctx& C0, KA A) {
    Ctx C = C0; C.tid = C.wave * 64 + lane_id(); asm volatile("" : "+v"(C.tid)); C.lane = C.tid & 63;
    float* OUT = A->out; const bf16_t* X1B = (const bf16_t*)(A->ws + WS_X1B); const bf16_t* YE = (const bf16_t*)(A->ws + WS_YE); const short* slotmap = (const short*)(A->ws + WS_SLOT); const float* mod = (const float*)(A->ws + WS_MOD);
    f32x4 lg[4], lb[4];
#pragma unroll
    for (int j = 0; j < 4; ++j) { lg[j] = *(const f32x4*)(A->in[23] + 4 * C.lane + 256 * j); lb[j] = *(const f32x4*)(A->in[24] + 4 * C.lane + 256 * j); }
    const int gw = C.vcu * NWAVES + C.wave, NGW = C.G * NWAVES;
    u32x2 xv[4]; int myslot;
    { const int row = gw; const int b = row >> 13;
#pragma unroll
      for (int j = 0; j < 4; ++j) xv[j] = *(const u32x2*)(X1B + (size_t)row * 1024 + 4 * C.lane + 256 * j);
      myslot = (int)slotmap[((size_t)b * 16 + (C.lane & 15)) * SEQ + (row & (SEQ - 1))]; }
    f32x4 ov[4]; float* op = nullptr; int cb = -1; f32x4 gg[4];
#define P8_FLUSH() do { if (op) { _Pragma("unroll") for (int j = 0; j < 4; ++j) *(f32x4*)(op + 4 * C.lane + 256 * j) = ov[j]; op = nullptr; } } while (0)
    for (int row = gw; row < NLAT; row += NGW) {
        const int b = row >> 13; float* xr = OUT + (size_t)row * 1024;
        const int nrow = (row + NGW < NLAT) ? row + NGW : row; const int nb = nrow >> 13;
        u32x2 nxv[4];
#pragma unroll
        for (int j = 0; j < 4; ++j) nxv[j] = *(const u32x2*)(X1B + (size_t)nrow * 1024 + 4 * C.lane + 256 * j);
        const int nslot = (int)slotmap[((size_t)nb * 16 + (C.lane & 15)) * SEQ + (nrow & (SEQ - 1))];
        if (b != cb) { cb = b; const float* g2 = mod + b * 6144 + 5 * 1024;
#pragma unroll
            for (int j = 0; j < 4; ++j) gg[j] = *(const f32x4*)(g2 + 4 * C.lane + 256 * j); }
        f32x4 mo[4];
#pragma unroll
        for (int j = 0; j < 4; ++j) mo[j] = (f32x4){0.f, 0.f, 0.f, 0.f};
        unsigned m = (unsigned)(__ballot(myslot >= 0) & 0xffffull);
        while (m) {
            const int e0 = __builtin_ctz(m); m &= m - 1u; const bool two = m != 0u; const int e1 = two ? __builtin_ctz(m) : e0; if (two) m &= m - 1u;
            const bf16_t* y0 = YE + ((size_t)(b * 16 + e0) * CAP + __shfl(myslot, e0)) * 1024; const bf16_t* y1 = YE + ((size_t)(b * 16 + e1) * CAP + __shfl(myslot, e1)) * 1024;
            u32x2 w0[4], w1[4];
#pragma unroll
            for (int j = 0; j < 4; ++j) { w0[j] = *(const u32x2*)(y0 + 4 * C.lane + 256 * j); w1[j] = *(const u32x2*)(y1 + 4 * C.lane + 256 * j); }
            P8_FLUSH();
            const float k1 = two ? 1.0f : 0.0f;
#pragma unroll
            for (int j = 0; j < 4; ++j) mo[j] += (f32x4){bf_lo(w0[j].x), bf_hi(w0[j].x), bf_lo(w0[j].y), bf_hi(w0[j].y)} + (f32x4){bf_lo(w1[j].x), bf_hi(w1[j].x), bf_lo(w1[j].y), bf_hi(w1[j].y)} * k1;
        }
        P8_FLUSH();
        f32x4 v[4]; float s = 0.f;
#pragma unroll
        for (int j = 0; j < 4; ++j) { v[j] = (f32x4){bf_lo(xv[j].x), bf_hi(xv[j].x), bf_lo(xv[j].y), bf_hi(xv[j].y)} * ALPHA + gg[j] * mo[j]; s += (v[j][0] + v[j][1]) + (v[j][2] + v[j][3]); }
        const float mean = wave_sum(s) * (1.0f / 1024.0f); float s2 = 0.f;
#pragma unroll
        for (int j = 0; j < 4; ++j) { v[j] = v[j] - mean; s2 += sq4(v[j]); }
        const float rstd = fast_rsq(wave_sum(s2) * (1.0f / 1024.0f) + EPS);
#pragma unroll
        for (int j = 0; j < 4; ++j) ov[j] = v[j] * rstd * lg[j] + lb[j];
        op = xr;
#pragma unroll
        for (int j = 0; j < 4; ++j) xv[j] = nxv[j];
        myslot = nslot;
    }
    P8_FLUSH();
#undef P8_FLUSH
}
#define XB_TMO      128
#define XB_XCNT(j)  (256  + 64 * (j))
#define XB_XSUB(j)  (1280 + 64 * (j))
#define XB_XGEN(j)  (2304 + 64 * (j))
#define XB_TOP      3328
#define XB_TOPGEN   3392
#define XB_P0B      3520
#define XCD_BAR_WORDS 3584
#define XB_SPIN_CAP (1u << 18)
#ifndef MK_SPLIT23
#define MK_SPLIT23 MK_ONE_LAUNCH
#endif
__device__ __forceinline__ unsigned xb_ld(unsigned* p)              { return __hip_atomic_load(p, __ATOMIC_RELAXED, __HIP_MEMORY_SCOPE_AGENT); }
__device__ __forceinline__ unsigned xb_add(unsigned* p, unsigned v) { return __hip_atomic_fetch_add(p, v, __ATOMIC_RELAXED, __HIP_MEMORY_SCOPE_AGENT); }
__device__ __forceinline__ unsigned xb_xcc_id() { return (unsigned)__builtin_amdgcn_s_getreg((3 << 11) | 20) & 0xFu; }
#define XB_SPIN(cond, bar) do { unsigned _sp = 0; while (cond) { __builtin_amdgcn_s_sleep(1); \
    if ((++_sp & 255u) == 0u) { if (xb_ld(&(bar)[XB_TMO])) break; if (_sp > XB_SPIN_CAP) { atomicAdd(&(bar)[XB_TMO], 1u); break; } } } } while (0)
struct XcdBarrier { unsigned* bar; unsigned x; volatile LAS unsigned* st; int wave; };
__device__ __forceinline__ XcdBarrier xcd_barrier_post(unsigned* bar, volatile LAS unsigned* st, int wave) {
    XcdBarrier b; b.bar = bar; b.x = xb_xcc_id(); b.st = st; b.wave = wave;
    if (wave == 0 && lane_id() == 0) (void)xb_add(&bar[XB_XCNT(b.x)], 1u);
    return b;
}
__device__ __forceinline__ void xcd_barrier_complete(unsigned* bar, unsigned x, unsigned& nloc, unsigned& nx) {
    const unsigned G = gridDim.x;
    unsigned sum, cnt, mine, sp = 0u;
    for (;;) {
        sum = 0u; cnt = 0u; mine = 0u;
#pragma unroll
        for (unsigned j = 0; j < 16; ++j) { const unsigned c = xb_ld(&bar[XB_XCNT(j)]); sum += c; cnt += (c > 0u) ? 1u : 0u; mine = (j == x) ? c : mine; }
        if (sum == G) break;
        __builtin_amdgcn_s_sleep(1);
        if ((++sp & 255u) == 0u) { if (xb_ld(&bar[XB_TMO])) break; if (sp > XB_SPIN_CAP) { atomicAdd(&bar[XB_TMO], 1u); break; } }
    }
    nloc = mine > 0u ? mine : 1u; nx = cnt > 0u ? cnt : 1u;
}
__device__ __forceinline__ void xcd_barrier(const XcdBarrier& b) {
    asm volatile("s_waitcnt vmcnt(0)" ::: "memory");
    __syncthreads();
    if (b.wave == 0 && lane_id() == 0) {
        unsigned* bar = b.bar;
        __builtin_amdgcn_s_waitcnt(0);
        unsigned nloc = b.st[0], nx = b.st[1];
        if (nloc == 0u) { xcd_barrier_complete(bar, b.x, nloc, nx); b.st[0] = nloc; b.st[1] = nx; }
        const unsigned old = xb_add(&bar[XB_XSUB(b.x)], 1u);
        const unsigned gen = old / nloc;
        if (old + 1u == (gen + 1u) * nloc) {
            __builtin_amdgcn_fence(__ATOMIC_RELEASE, "agent");
            asm volatile("s_waitcnt vmcnt(0)" ::: "memory");
            const unsigned og = xb_add(&bar[XB_TOP], 1u);
            const unsigned tg = og / nx;
            if (og + 1u == (tg + 1u) * nx) xb_add(&bar[XB_TOPGEN], 1u);
            else XB_SPIN(xb_ld(&bar[XB_TOPGEN]) == tg, bar);
            __builtin_amdgcn_fence(__ATOMIC_ACQUIRE, "agent");
            xb_add(&bar[XB_XGEN(b.x)], 1u);
            asm volatile("s_waitcnt vmcnt(0)" ::: "memory");
        } else {
            XB_SPIN(xb_ld(&bar[XB_XGEN(b.x)]) == gen, bar);
            __builtin_amdgcn_fence(__ATOMIC_ACQUIRE, "agent");
            asm volatile("s_waitcnt vmcnt(0)" ::: "memory");
        }
    }
    __syncthreads();
}

#ifndef MK_CTX_IN_MOD
#define MK_CTX_IN_MOD 0
#endif
__device__ __forceinline__ void ph_gemm1(const Ctx& C, KA A, int bx, int ctxmode) {
    unsigned char* ws = A->ws; const float* rope = (const float*)(ws + WS_ROPE);
    Sched1 S{C.G, bx, (const char*)(ws + WS_A1), (const char*)(ws + WS_WIN), ctxmode};
    {
        const int tid = C.wave * 64 + lane_id();
        ((LAS u32x4*)(C.lds + 131072))[tid] = ((const u32x4*)rope)[tid]; ((LAS u32x4*)(C.lds + 131072))[tid + 512] = ((const u32x4*)rope)[tid + 512]; ((LAS u32x4*)(C.lds + 131072))[tid + 1024] = ((const u32x4*)rope)[tid + 1024];
        __syncthreads();
    }
    Epi1 E{(bf16_t*)(ws + WS_P0B), (float*)(ws + WS_SSQ), (bf16_t*)(ws + WS_KR), (bf16_t*)(ws + WS_QD), (bf16_t*)(ws + WS_KD), (bf16_t*)(ws + WS_VD), (bf16_t*)A->out, rope, (unsigned*)(ws + WS_KMAX), (const LAS float*)(C.lds + 131072),
           ctxmode == 3 ? (unsigned*)(ws + WS_CTL) + XB_P0B : nullptr};
    pg8::gemm_phase(C.wave, C.lds, pg8::Gemm{1024, 1024, 1024}, S, E);
}
__device__ __forceinline__ void ph_upproj(const Ctx& C, KA A, int bx, bool split) {
    unsigned char* ws = A->ws; const float* rope = (const float*)(ws + WS_ROPE);
    if (split) {
        if (C.wave == 0) { unsigned* bar = (unsigned*)(ws + WS_CTL);
            if (lane_id() == 0) XB_SPIN(xb_ld(&bar[XB_P0B]) < 260u, bar);
            __builtin_amdgcn_fence(__ATOMIC_ACQUIRE, "agent"); }
    }
    {
        const int tid = C.wave * 64 + lane_id();
        ((LAS u32x4*)(C.lds + 131072))[tid] = ((const u32x4*)(rope + 4096))[tid];
        __syncthreads();
    }
    SchedUQ Sq{C.G, bx, (const char*)(ws + WS_P0B), (const char*)(ws + WS_WUQ)}; SchedUKV Sk{C.G, bx, (const char*)(ws + WS_P0B), (const char*)(ws + WS_WUKV)};
    SchedU S{Sq, Sk, split ? C.G - 20 : C.G, split ? bx - 20 : bx};
    EpiU E{EpiUQ{(const float*)(ws + WS_SSQ), (bf16_t*)(ws + WS_QM), (const LAS float*)(C.lds + 131072)}, EpiUKV{(const float*)(ws + WS_SSQ), (const bf16_t*)(ws + WS_KR), (bf16_t*)(ws + WS_KM), (bf16_t*)(ws + WS_VM), (unsigned*)(ws + WS_KMAX)}};
    pg8::gemm_phase(C.wave, C.lds, pg8::Gemm{256, 512, 256}, S, E);
}
__device__ __forceinline__ void ph_y(const Ctx& C, KA A, int bx) {
    unsigned char* ws = A->ws;
    SchedY S{C.G, bx, (const char*)(ws + WS_OA), (const char*)(ws + WS_WOC)}; EpiY E{(const bf16_t*)A->out, (bf16_t*)(ws + WS_Y)};
    pg8::gemm_phase(C.wave, C.lds, pg8::Gemm{512, 1024, 1024}, S, E);
}
__device__ __forceinline__ void ph_z(const Ctx& C, KA A, int bx) {
    unsigned char* ws = A->ws;
    SchedZ S{C.G, bx, (const char*)(ws + WS_Y), (const char*)(ws + WS_WOUT)}; EpiZ E{(const float*)(ws + WS_MOD), (bf16_t*)(ws + WS_OL)};
    pg8::gemm_phase(C.wave, C.lds, pg8::Gemm{1024, 1024, 1024}, S, E);
}
__device__ __forceinline__ void ph_moe1(const Ctx& C, KA A, int abl = 0) {
    unsigned char* ws = A->ws;
    SchedM1 S{C.xcd, C.slot, (const char*)(ws + WS_H2), (const char*)(ws + WS_W13)}; EpiM1 E{(bf16_t*)(ws + WS_HID), abl};
    LAS int* rowsL = (LAS int*)(C.lds + 131072); const int* idx = (const int*)(ws + WS_IDX);
    { int t_ = C.wave * 64 + lane_id(); asm volatile("" : "+v"(t_));
#pragma unroll
      for (int i = 0; i < 4; ++i) { const int q = t_ + 512 * i; Unit u; S.next(q >> 8, u); rowsL[q] = idx[u.pm * 256 + (q & 255)]; } }
    __syncthreads();
    pg8::gemm_phase<EpiM1, SchedM1, true>(C.wave, C.lds, pg8::Gemm{1024, 1024, 1024}, S, E, rowsL);
}
__device__ __forceinline__ void ph_moe2(const Ctx& C, KA A) {
    unsigned char* ws = A->ws;
    SchedM2 S{C.xcd, C.slot, (const char*)(ws + WS_HID), (const char*)(ws + WS_W2T)}; EpiM2 E{(const float*)(ws + WS_GSEL), (bf16_t*)(ws + WS_YE)};
    pg8::gemm_phase(C.wave, C.lds, pg8::Gemm{1024, 1024, 1024}, S, E);
}

constexpr int NPHASE = 13;
#ifdef DBG_UBENCH
#ifndef DBG_UBN
#define DBG_UBN 4096
#endif
__device__ __forceinline__ void dbg_ubench(unsigned char* wsb) {
    float x[8]; const int l = lane_id();
#pragma unroll
    for (int i = 0; i < 8; ++i) x[i] = -1.0f - 0.001f * (float)(l + i);
    f32x16 acc = {}; bf16x8 a, b;
#pragma unroll
    for (int i = 0; i < 8; ++i) { a[i] = (short)(0x3c00 + l); b[i] = (short)(0x3c00 + i); }
#pragma unroll 1
    for (int it = 0; it < DBG_UBN; ++it) {
        if (DBG_UBENCH == 1) {
#pragma unroll
            for (int i = 0; i < 8; ++i) x[i] = __builtin_amdgcn_exp2f(x[i]) - 1.5f;
        } else if (DBG_UBENCH == 2) {
#pragma unroll
            for (int i = 0; i < 8; ++i) { x[i] = x[i] + 1.25f; x[i] = x[i] - 1.5f; }
        } else if (DBG_UBENCH == 3) {
            acc = __builtin_amdgcn_mfma_f32_32x32x16_bf16(a, b, acc, 0, 0, 0); acc = __builtin_amdgcn_mfma_f32_32x32x16_bf16(b, a, acc, 0, 0, 0);
        } else if (DBG_UBENCH == 4) {
            acc = __builtin_amdgcn_mfma_f32_32x32x16_bf16(a, b, acc, 0, 0, 0);
#pragma unroll
            for (int i = 0; i < 4; ++i) x[i] = __builtin_amdgcn_exp2f(x[i]) - 1.5f;
            acc = __builtin_amdgcn_mfma_f32_32x32x16_bf16(b, a, acc, 0, 0, 0);
#pragma unroll
            for (int i = 4; i < 8; ++i) x[i] = __builtin_amdgcn_exp2f(x[i]) - 1.5f;
        } else {
            acc = __builtin_amdgcn_mfma_f32_32x32x16_bf16(a, b, acc, 0, 0, 0);
#pragma unroll
            for (int i = 0; i < 4; ++i) { x[i] = x[i] + 1.25f; x[i] = x[i] - 1.5f; }
            acc = __builtin_amdgcn_mfma_f32_32x32x16_bf16(b, a, acc, 0, 0, 0);
#pragma unroll
            for (int i = 4; i < 8; ++i) { x[i] = x[i] + 1.25f; x[i] = x[i] - 1.5f; }
        }
    }
    float s = 0.f;
#pragma unroll
    for (int i = 0; i < 8; ++i) s += x[i];
#pragma unroll
    for (int i = 0; i < 16; ++i) s += acc[i];
    if (s == 123.456f) *(float*)(wsb + WS_CTL + 65536) = s;
}
#endif

__global__ void __launch_bounds__(NTHR, 2) mk(Args A_) {
    extern __shared__ __attribute__((aligned(16))) unsigned char lds_raw[];
    Ctx C; C.lds = (LAS unsigned char*)lds_raw; C.lds_g = lds_raw;
    C.tid = threadIdx.x; C.lane = 0; C.wave = __builtin_amdgcn_readfirstlane(C.tid >> 6);
    C.G = gridDim.x; { const int bx = blockIdx.x; C.xcd = bx & 7; C.slot = bx >> 3; C.vcu = (bx & 7) * (C.G >> 3) + (bx >> 3); }
    const int lo = A_.ph_lo, hi = A_.ph_hi;
#define A kargs()
#define ws (kargs()->ws)
#if MK_ONE_LAUNCH
    volatile LAS unsigned* bst = (volatile LAS unsigned*)(C.lds + LDS_BYTES - 64);
    if (threadIdx.x < 2) bst[threadIdx.x] = 0u;
    __syncthreads();
    const XcdBarrier xbar = xcd_barrier_post((unsigned*)(ws + WS_CTL), bst, C.wave);
#ifndef MK_CG_SEAM0
#define MK_CG_SEAM0 0
#endif

#define SEAM(k) do { if (lo <= (k) && (k) + 1 < hi) { if (MK_CG_SEAM0 && (k) == 0) cg::this_grid().sync(); else xcd_barrier(xbar); } } while (0)
#else
#define SEAM(k) do { } while (0)
#endif
#ifndef DBG_ONLY
#define DBG_ONLY -1
#endif
#ifndef DBG_SKIP_MASK
#define DBG_SKIP_MASK 0
#endif
#define IN(k) ((DBG_ONLY < 0 || DBG_ONLY == (k)) && !((DBG_SKIP_MASK >> (k)) & 1) && lo <= (k) && (k) < hi)
#ifndef DBG_REPEAT
#define DBG_REPEAT -1
#endif
#if MK_ONE_LAUNCH
#ifndef DBG_REPN
#define DBG_REPN 1
#endif
#define RUN(k, call) do { if (IN(k)) { if (DBG_REPEAT == (k)) { _Pragma("unroll 1") for (int r_ = 0; r_ <= DBG_REPN; ++r_) { if (r_) xcd_barrier(xbar); call; } } else { call; } } } while (0)
#else
#define RUN(k, call) do { if (IN(k)) { call; } } while (0)
#endif
    const int bx = blockIdx.x;
#ifdef DBG_UBENCH
    if (IN(0)) dbg_ubench(ws);
#endif
    RUN(0, p0_prologue(C, A)); SEAM(0);
#if MK_CTX_IN_MOD
    RUN(1, (p0b_modulate(C, A, bx, true), ph_gemm1(C, A, bx, 1))); SEAM(1);
    RUN(2, ph_gemm1(C, A, bx, 0)); SEAM(2);
#else
    RUN(1, p0b_modulate(C, A, bx, false)); SEAM(1);
#if defined(DBG_PHCLK) && MK_ONE_LAUNCH
    if (IN(2)) { const unsigned long long t0 = __builtin_amdgcn_s_memtime(), r0 = __builtin_amdgcn_s_memrealtime();
        ph_gemm1(C, A, bx, 2);
        const unsigned long long t1 = __builtin_amdgcn_s_memtime(), r1 = __builtin_amdgcn_s_memrealtime();
        if (blockIdx.x == 0) { const unsigned long long mhz = (t1 - t0) * 100ull / (r1 - r0 + 1ull); const unsigned long long until = r1 + mhz * 100ull;
            while (__builtin_amdgcn_s_memrealtime() < until) __builtin_amdgcn_s_sleep(8); } }
    SEAM(2);
#else
#if MK_SPLIT23
    RUN(2, ph_gemm1(C, A, bx, 3));
#else
    RUN(2, ph_gemm1(C, A, bx, 2)); SEAM(2);
#endif
#endif
#endif
    RUN(3, ph_upproj(C, A, bx, MK_SPLIT23 != 0)); SEAM(3);
#if !MK_NAIVE_ATTN
#if defined(DBG_CLOCK) && MK_ONE_LAUNCH
    if (IN(4)) {
        const unsigned long long t0 = __builtin_amdgcn_s_memtime(), r0 = __builtin_amdgcn_s_memrealtime();
        attn_phase<0>(C, ws, A->in[13]);
        const unsigned long long t1 = __builtin_amdgcn_s_memtime(), r1 = __builtin_amdgcn_s_memrealtime();
        if (blockIdx.x == 0) { const unsigned long long mhz = (t1 - t0) * 100ull / (r1 - r0 + 1ull); const unsigned long long until = r1 + mhz * 100ull;
            while (__builtin_amdgcn_s_memrealtime() < until) __builtin_amdgcn_s_sleep(8); }
    }
#elif defined(DBG_ABL) && MK_ONE_LAUNCH
    if (IN(4)) { attn_phase<DBG_ABL>(C, ws, A->in[13]); xcd_barrier(xbar); attn_phase<0>(C, ws, A->in[13]); }
#else
    RUN(4, attn_phase<0>(C, ws, A->in[13]));
#endif
#endif
    SEAM(4);
    RUN(5, ph_y(C, A, bx)); SEAM(5);
    RUN(6, ph_z(C, A, bx)); SEAM(6);
    RUN(7, p4_ln_router(C, A)); SEAM(7);
    RUN(8, p5_topk(C, A)); SEAM(8);
#if defined(DBG_M1ABL) && MK_ONE_LAUNCH
    if (IN(10)) { ph_moe1(C, A, DBG_M1ABL); xcd_barrier(xbar); ph_moe1(C, A, 0); } SEAM(10);
#else
    RUN(10, ph_moe1(C, A)); SEAM(10);
#endif
    RUN(11, ph_moe2(C, A)); SEAM(11);
    RUN(12, p8_final(C, A));
#undef RUN
#undef A
#undef ws
#undef IN
#undef SEAM
}

#ifdef DBG_COPY_OFF
__global__ void dbg_copy(u32x4* dst, const u32x4* src, size_t n16) { for (size_t i = blockIdx.x * 256ull + threadIdx.x; i < n16; i += gridDim.x * 256ull) dst[i] = src[i]; }
#endif
extern "C" void kernel_launch(void* const* d_in, const int* in_sizes, int n_in, void* d_out, int out_size, void* d_ws, size_t ws_size, hipStream_t stream) {
    static int ready = 0;
    if (ready == 0) {
        if (n_in != 25 || in_sizes[0] != NLAT * DM || out_size != NLAT * DM || ws_size < WS_NEED) {
            fprintf(stderr, "kernel_launch: unexpected shapes (n_in %d, x %d, out %d, ws %zu; need ws >= %zu)\n", n_in, n_in > 0 ? in_sizes[0] : -1, out_size, ws_size, (size_t)WS_NEED); ready = -1; return; }
        if (hipFuncSetAttribute((const void*)mk, hipFuncAttributeMaxDynamicSharedMemorySize, LDS_BYTES) != hipSuccess) { fprintf(stderr, "kernel_launch: hipFuncSetAttribute failed\n"); ready = -1; return; }
        int dev = 0, cus = 0, per_cu = 0;
        (void)hipGetDevice(&dev); (void)hipDeviceGetAttribute(&cus, hipDeviceAttributeMultiprocessorCount, dev);
        (void)hipOccupancyMaxActiveBlocksPerMultiprocessor(&per_cu, (const void*)mk, NTHR, LDS_BYTES);
        if (cus != 256 || per_cu < 1) { fprintf(stderr, "kernel_launch: needs 256 CUs with one resident workgroup each (cus %d, per_cu %d)\n", cus, per_cu); ready = -1; return; }
        ready = 1;
    }
    if (ready < 0) return;
    Args a{};
    for (int i = 0; i < 25; ++i) a.in[i] = (const float*)d_in[i];
    a.out = (float*)d_out; a.ws = (unsigned char*)d_ws;
#if MK_ONE_LAUNCH
    a.ph_lo = 0; a.ph_hi = NPHASE;
    if (hipMemsetAsync((char*)d_ws + WS_CTL, 0, XCD_BAR_WORDS * 4, stream) != hipSuccess) { fprintf(stderr, "kernel_launch: memset of the barrier words failed\n"); return; }
    void* kargs[] = {&a};
    hipError_t e = hipLaunchCooperativeKernel((const void*)mk, dim3(256), dim3(NTHR), kargs, LDS_BYTES, stream);
    if (e != hipSuccess) fprintf(stderr, "kernel_launch: cooperative launch failed: %s\n", hipGetErrorString(e));
#else
#ifndef DBG_LAST_PHASE
#define DBG_LAST_PHASE 99
#endif
    for (int ph = 0; ph < NPHASE && ph <= DBG_LAST_PHASE; ++ph) {
#if MK_NAIVE_ATTN
        if (ph == 4) {
            unsigned char* ws = (unsigned char*)d_ws;
            naive_attn<0><<<NB * 8 * SEQ / 4, 256, 0, stream>>>((const bf16_t*)(ws + WS_QM), (const bf16_t*)(ws + WS_KM), (const bf16_t*)(ws + WS_VM), (bf16_t*)(ws + WS_OA), (const float*)(ws + WS_LAM), (const float*)d_in[13]);
            naive_attn<1><<<NB * 4 * SEQ / 4, 256, 0, stream>>>((const bf16_t*)(ws + WS_QD), (const bf16_t*)(ws + WS_KD), (const bf16_t*)(ws + WS_VD), (bf16_t*)(ws + WS_OA), (const float*)(ws + WS_LAM), (const float*)d_in[13]);
            continue;
        }
#endif
        a.ph_lo = ph; a.ph_hi = ph + 1;
        hipLaunchKernelGGL(mk, dim3(256), dim3(NTHR), LDS_BYTES, stream, a);
    }
#ifdef DBG_COPY_OFF
    dbg_copy<<<2048, 256, 0, stream>>>((u32x4*)d_out, (const u32x4*)((unsigned char*)d_ws + (size_t)DBG_COPY_OFF), (size_t)DBG_COPY_BYTES / 16);
#endif
    hipError_t e = hipPeekAtLastError();
    if (e != hipSuccess) fprintf(stderr, "kernel_launch: launch failed: %s\n", hipGetErrorString(e));
#endif
}
```

```cpp
#include <hip/hip_runtime.h>
#include <hip/hip_cooperative_groups.h>
#include <cstdio>
#include <cstdint>
namespace cg = cooperative_groups;

#ifndef MK_ONE_LAUNCH
#define MK_ONE_LAUNCH 1
#endif
#ifndef MK_SLOWK
#define MK_SLOWK 0
#endif
#ifndef MK_NAIVE_ATTN
#define MK_NAIVE_ATTN 0
#endif

#define LAS __attribute__((address_space(3)))
#define GAS __attribute__((address_space(1)))
typedef unsigned short bf16_t;
typedef short bf16x8 __attribute__((ext_vector_type(8)));
typedef short s16x4 __attribute__((ext_vector_type(4)));
typedef float f32x2 __attribute__((ext_vector_type(2)));
typedef float f32x4 __attribute__((ext_vector_type(4)));
typedef float f32x16 __attribute__((ext_vector_type(16)));
typedef unsigned u32x2 __attribute__((ext_vector_type(2)));
typedef unsigned u32x4 __attribute__((ext_vector_type(4)));

constexpr int DM = 1024, NB = 4, SEQ = 8192, CTXL = 256, SK = SEQ + CTXL;
constexpr int NLAT = NB * SEQ, NCTX = NB * CTXL, MTOT = NCTX + NLAT;
constexpr int NE = 16, CAP = 1024, FFD = 1024, NIN = 4000;
constexpr float EPS = 1e-6f, LOG2E = 1.4426950408889634f;
constexpr float MLA_QS = 0.10206207261596577f * LOG2E;
constexpr float DIFF_QS = 0.125f * LOG2E;
constexpr float ALPHA = 1.189207115002721f;
constexpr float LAMBDA_INIT = 0.2f;
constexpr int NWAVES = 8, NTHR = 512;

constexpr size_t MiB = 1u << 20;
constexpr size_t WS_CTL = 0;
constexpr size_t WS_MOD = 1 * MiB;
constexpr size_t WS_ROPE = 1 * MiB + 256 * 1024;
constexpr size_t WS_LAM = 1 * MiB + 512 * 1024;
constexpr size_t WS_KMAX = 1 * MiB + 640 * 1024;
template <int K> __device__ __forceinline__ float swz_xor(float v) { return __int_as_float(__builtin_amdgcn_ds_swizzle(__float_as_int(v), 0x1f | (K << 10))); }
__device__ __forceinline__ float half_sum(float v) { auto rr = __builtin_amdgcn_permlane32_swap(__float_as_uint(v), __float_as_uint(v), false, false); return __uint_as_float(rr[0]) + __uint_as_float(rr[1]); }
__device__ __forceinline__ float sum_fq(float v) { v += swz_xor<16>(v); return half_sum(v); }
__device__ __forceinline__ float wmax16(float v) { v = fmaxf(v, swz_xor<1>(v)); v = fmaxf(v, swz_xor<2>(v)); v = fmaxf(v, swz_xor<4>(v)); v = fmaxf(v, swz_xor<8>(v)); return v; }
constexpr size_t WS_SSQ = 2 * MiB;
constexpr size_t WS_KR = 4 * MiB;
constexpr size_t WS_AFF = 7 * MiB;
constexpr size_t WS_IDX = 9 * MiB;
constexpr size_t WS_GSEL = 9 * MiB + 512 * 1024;
constexpr size_t WS_SLOT = 10 * MiB;
constexpr size_t WS_WIN = 16 * MiB;
constexpr size_t WS_WUQ = 24 * MiB;
constexpr size_t WS_WUKV = 25 * MiB;
constexpr size_t WS_WOC = 26 * MiB;
constexpr size_t WS_WOUT = 28 * MiB;
constexpr size_t WS_W13 = 32 * MiB;
constexpr size_t WS_W2T = 96 * MiB;
constexpr size_t WS_A1 = 128 * MiB;
constexpr size_t WS_P0B = 194 * MiB;
constexpr size_t WS_QD = 228 * MiB;
constexpr size_t WS_KD = 260 * MiB;
constexpr size_t WS_VD = 293 * MiB;
constexpr size_t WS_QM = 326 * MiB;
constexpr size_t WS_KM = 374 * MiB;
constexpr size_t WS_VM = 424 * MiB;
constexpr size_t WS_OA = 128 * MiB;
constexpr size_t WS_Y = 192 * MiB;
constexpr size_t WS_H2 = 128 * MiB;
constexpr size_t WS_X1B = 192 * MiB;
constexpr size_t WS_OL = 256 * MiB;
constexpr size_t WS_XE = 256 * MiB;
constexpr size_t WS_HID = 384 * MiB;
constexpr size_t WS_YE = 256 * MiB;
constexpr size_t WS_NEED = 512 * MiB;

constexpr int LDS_BYTES = 156672;

typedef __bf16 bf16x2_t __attribute__((ext_vector_type(2)));
__device__ __forceinline__ unsigned cvt_pk_bf16(float lo, float hi) { const f32x2 v = {lo, hi}; const bf16x2_t b = __builtin_convertvector(v, bf16x2_t); return __builtin_bit_cast(unsigned, b); }
__device__ __forceinline__ float bf_lo(unsigned w) { return __uint_as_float(w << 16); }
__device__ __forceinline__ float bf_hi(unsigned w) { return __uint_as_float(w & 0xffff0000u); }
__device__ __forceinline__ float bf2f(bf16_t h) { return __uint_as_float(((unsigned)h) << 16); }
__device__ __forceinline__ float fast_exp2(float x) { return __builtin_amdgcn_exp2f(x); }
__device__ __forceinline__ float fast_rcp(float x) { return __builtin_amdgcn_rcpf(x); }
__device__ __forceinline__ float fast_rsq(float x) { return __builtin_amdgcn_rsqf(x); }
__device__ __forceinline__ float sigmoidf_(float x) { return fast_rcp(1.0f + fast_exp2(-x * LOG2E)); }
__device__ __forceinline__ float wave_sum(float v) {
#pragma unroll
    for (int o = 1; o < 64; o <<= 1) v += __shfl_xor(v, o);
    return v;
}
__device__ __forceinline__ float wave_max(float v) {
#pragma unroll
    for (int o = 1; o < 64; o <<= 1) v = fmaxf(v, __shfl_xor(v, o));
    return v;
}

__device__ __forceinline__ int lane_id() { return (int)__builtin_amdgcn_mbcnt_hi(~0u, __builtin_amdgcn_mbcnt_lo(~0u, 0u)); }
struct Args { const float* in[25]; float* out; unsigned char* ws; int ph_lo, ph_hi; };
typedef const __attribute__((address_space(4))) Args* KA;
__device__ __forceinline__ KA kargs() { KA p = (KA)__builtin_amdgcn_kernarg_segment_ptr(); asm volatile("" : "+s"(p)); return p; }

__device__ __forceinline__ void dep_arrive(unsigned* cnt) { __builtin_amdgcn_fence(__ATOMIC_RELEASE, "agent"); (void)__hip_atomic_fetch_add(cnt, 1u, __ATOMIC_RELAXED, __HIP_MEMORY_SCOPE_AGENT); }
__device__ __forceinline__ void dep_wait(unsigned* cnt, unsigned target) {
    unsigned sp = 0u; while (__hip_atomic_load(cnt, __ATOMIC_RELAXED, __HIP_MEMORY_SCOPE_AGENT) < target) { __builtin_amdgcn_s_sleep(1); if (++sp > (1u << 22)) break; }
    __builtin_amdgcn_fence(__ATOMIC_ACQUIRE, "agent"); }
struct Ctx {
    LAS unsigned char* lds; unsigned char* lds_g;
    int tid, lane, wave, G, vcu, xcd, slot;
};

namespace pg8 {
constexpr int BM = 256, BK = 64, HALF = 128, HTB = HALF * BK * 2, STAGE_BYTES = 8 * HTB;
__host__ __device__ __forceinline__ int lds_byte(int r, int c) { const int st = (r >> 4) * 2 + (c >> 5), rr = r & 15, cc = c & 31, ob = rr * 64 + cc * 2; return st * 1024 + (ob ^ (((ob >> 9) & 1) << 5)); }
__host__ __device__ __forceinline__ void stage_rc(int b, int& R, int& C) { const int st = b / 1024, sb = b % 1024, swz = sb ^ (((sb >> 9) & 1) << 5); R = (st >> 1) * 16 + swz / 64; C = (st & 1) * 32 + (swz % 64) / 2; }
__host__ __device__ __forceinline__ int perm32(int rho) { const int n = rho >> 4, i = rho & 15; return 8 * (i >> 2) + 4 * n + (i & 3); }
struct Unit { int pm, pn, aux; };
struct Gemm { int K, lda, ldb; };

#define ACC_ZERO() do { _Pragma("unroll") for (int a_ = 0; a_ < 2; ++a_) _Pragma("unroll") for (int b_ = 0; b_ < 2; ++b_) _Pragma("unroll") for (int m_ = 0; m_ < 4; ++m_) _Pragma("unroll") for (int n_ = 0; n_ < 2; ++n_) acc[a_][b_][m_][n_] = (f32x4){0.f, 0.f, 0.f, 0.f}; } while (0)

#if MK_SLOWK
template <class Epi, class Sched, bool GATHER = false>
__device__ __forceinline__ void gemm_phase(int wave, LAS unsigned char* lds, const Gemm g, const Sched& S, const Epi& E, const LAS int* rowsL = nullptr) {
    const int tid = wave * 64 + lane_id(), wid = __builtin_amdgcn_readfirstlane(tid >> 6), lane = tid & 63, wr = wid >> 2, wc = wid & 3, fr = lane & 15, fq = lane >> 4;
    f32x4 acc[2][2][4][2];
    ACC_ZERO();
    Unit cur;
    for (int ui = 0; S.next(ui, cur); ++ui) {
        const char* cA = S.a_ptr(cur); const char* cB = S.b_ptr(cur);
        for (int k0 = 0; k0 < g.K; k0 += 32) {
            bf16x8 At[2][4], Bt[2][2];
#pragma unroll
            for (int ai = 0; ai < 2; ++ai)
#pragma unroll
                for (int m = 0; m < 4; ++m) At[ai][m] = *(const bf16x8*)(cA + ((size_t)(128 * ai + 64 * wr + 16 * m + fr) * g.lda + k0 + 8 * fq) * 2);
#pragma unroll
            for (int bj = 0; bj < 2; ++bj)
#pragma unroll
                for (int n = 0; n < 2; ++n) { const int sl = 16 * n + fr; const int row = 128 * bj + 32 * wc + (Epi::PERM ? perm32(sl) : sl);
                    Bt[bj][n] = *(const bf16x8*)(cB + ((size_t)row * g.ldb + k0 + 8 * fq) * 2); }
#pragma unroll
            for (int ai = 0; ai < 2; ++ai)
#pragma unroll
                for (int bj = 0; bj < 2; ++bj)
#pragma unroll
                    for (int m = 0; m < 4; ++m)
#pragma unroll
                        for (int n = 0; n < 2; ++n) acc[ai][bj][m][n] = __builtin_amdgcn_mfma_f32_16x16x32_bf16(Bt[bj][n], At[ai][m], acc[ai][bj][m][n], 0, 0, 0);
        }
        E(acc, cur, wr, wc, fr, fq);
        if (!E.keep(cur)) ACC_ZERO();
    }
}
#else
template <class Epi, class Sched, bool GATHER = false>
__device__ __forceinline__ void gemm_phase(int wave, LAS unsigned char* lds, const Gemm g, const Sched& S, const Epi& E, const LAS int* rowsL = nullptr) {
#ifndef PG8_ALIGN_EPI
#define PG8_ALIGN_EPI true
#endif
    constexpr bool ALIGN_EPI = PG8_ALIGN_EPI;
    int tid_ = wave * 64 + lane_id(); asm volatile("" : "+v"(tid_));
    const int tid = tid_, wid = __builtin_amdgcn_readfirstlane(tid >> 6), lane = tid & 63, wr = wid >> 2, wc = wid & 3, fr = lane & 15, fq = lane >> 4;
    const int K = g.K, nt = K / BK;
    unsigned voffA[2], voffB[2];
#pragma unroll
    for (int i = 0; i < 2; ++i) { int R, C; stage_rc(tid * 16 + i * 8192, R, C); const int Rb = Epi::PERM ? ((R & ~31) + perm32(R & 31)) : R;
        voffA[i] = (unsigned)(R * g.lda + C) * 2u; voffB[i] = (unsigned)(Rb * g.ldb + C) * 2u; }
    unsigned vc[2][2] = {{0u, 0u}, {0u, 0u}}, vn[2][2] = {{0u, 0u}, {0u, 0u}}; int gR[2] = {0, 0}, gC[2] = {0, 0};
    if constexpr (GATHER) {
#pragma unroll
        for (int i = 0; i < 2; ++i) stage_rc(tid * 16 + i * 8192, gR[i], gC[i]);
    }
#define PG8_GOFFS(dst, ord) do { _Pragma("unroll") for (int h_ = 0; h_ < 2; ++h_) _Pragma("unroll") for (int i_ = 0; i_ < 2; ++i_) \
        dst[h_][i_] = (unsigned)(rowsL[(ord) * 256 + h_ * 128 + gR[i_]] * g.lda + gC[i_]) * 2u; } while (0)
#define PG8_STAGE_A(bufoff, gbase0, h, nextflag) do { if constexpr (GATHER) { const unsigned vv_[2] = {(nextflag) ? vn[h][0] : vc[h][0], (nextflag) ? vn[h][1] : vc[h][1]}; PG8_STAGE(bufoff, gbase0, vv_); } \
        else { PG8_STAGE(bufoff, (gbase0) + (h) * hstepA, voffA); } } while (0)
    const size_t kstep = (size_t)(BK * 2);
    const size_t hstepA = (size_t)HALF * g.lda * 2, hstepB = (size_t)HALF * g.ldb * 2;
    const unsigned ldsw = (unsigned)wid * 1024u;
    const int aoff = lds_byte(wr * 64 + fr, fq * 8), boff = lds_byte(wc * 32 + fr, fq * 8);
#define PG8_SA(b, h) (((b) * 2 + (h)) * HTB)
#define PG8_SB(b, h) ((4 + (b) * 2 + (h)) * HTB)
#define PG8_STAGE(bufoff, gbase, voff) do { _Pragma("unroll") for (int _i = 0; _i < 2; ++_i) \
        __builtin_amdgcn_global_load_lds((const unsigned*)((const char*)(gbase) + (voff)[_i]), (LAS unsigned*)(lds + (bufoff) + ldsw + _i * 8192), 16, 0, 0); } while (0)
#define PG8_LDA(dst, b, h) do { _Pragma("unroll") for (int m = 0; m < 4; ++m) _Pragma("unroll") for (int k = 0; k < 2; ++k) dst[m][k] = *(const LAS bf16x8*)(lds + PG8_SA(b, h) + aoff + m * 2048 + k * 1024); } while (0)
#define PG8_LDB(dst, b, h) do { _Pragma("unroll") for (int n = 0; n < 2; ++n) _Pragma("unroll") for (int k = 0; k < 2; ++k) dst[n][k] = *(const LAS bf16x8*)(lds + PG8_SB(b, h) + boff + n * 2048 + k * 1024); } while (0)
#define PG8_MMA(ai, bj, At, Bt) do { __builtin_amdgcn_s_setprio(1); _Pragma("unroll") for (int m = 0; m < 4; ++m) _Pragma("unroll") for (int n = 0; n < 2; ++n) _Pragma("unroll") for (int k = 0; k < 2; ++k) \
        acc[ai][bj][m][n] = __builtin_amdgcn_mfma_f32_16x16x32_bf16(Bt[n][k], At[m][k], acc[ai][bj][m][n], 0, 0, 0); __builtin_amdgcn_s_setprio(0); } while (0)
#define PG8_WAIT_V(n) asm volatile("s_waitcnt vmcnt(" #n ")" ::: "memory")
#define PG8_WAIT_L(n) asm volatile("s_waitcnt lgkmcnt(" #n ")" ::: "memory")
#define PG8_BAR __builtin_amdgcn_s_barrier()
#define PG8_SCHED __builtin_amdgcn_sched_barrier(0)
    Unit cur, nxt; int ui = 0;
    if (!S.next(0, cur)) return;
#ifdef PG8_STAGGER_US
    if (Epi::STAGGER) {
      const unsigned long long until = __builtin_amdgcn_s_memrealtime() + (unsigned long long)((blockIdx.x >> 3) & 7) * (PG8_STAGGER_US * 10ull);
      while (__builtin_amdgcn_s_memrealtime() < until) __builtin_amdgcn_s_sleep(4); }
#endif
    f32x4 acc[2][2][4][2];
    ACC_ZERO();
    bf16x8 At[4][2], B0[2][2], B1[2][2];
    const char* cA = S.a_ptr(cur); const char* cB = S.b_ptr(cur);
    if constexpr (GATHER) PG8_GOFFS(vc, 0);
    PG8_STAGE(PG8_SB(0, 0), cB, voffB); PG8_STAGE(PG8_SB(0, 1), cB + hstepB, voffB); PG8_STAGE_A(PG8_SA(0, 0), cA, 0, false); PG8_STAGE_A(PG8_SA(0, 1), cA, 1, false);
    if (wr == 1) PG8_BAR;
    PG8_WAIT_V(2); PG8_BAR;
    PG8_STAGE(PG8_SB(1, 0), cB + kstep, voffB); PG8_STAGE_A(PG8_SA(1, 0), cA + kstep, 0, false); PG8_STAGE(PG8_SB(1, 1), cB + hstepB + kstep, voffB);
    PG8_WAIT_V(6); PG8_BAR;
    for (;;) {
        const bool has_next = S.next(ui + 1, nxt);
        const char* nA = has_next ? S.a_ptr(nxt) : cA; const char* nB = has_next ? S.b_ptr(nxt) : cB;
        if constexpr (GATHER) { if (has_next) PG8_GOFFS(vn, ui + 1); else { vn[0][0] = vc[0][0]; vn[0][1] = vc[0][1]; vn[1][0] = vc[1][0]; vn[1][1] = vc[1][1]; } }
        for (int t = 0; t < nt; t += 2) {
            const bool last = (t == nt - 2);
            const char* a1 = cA + (size_t)(t + 1) * kstep;
            const char* a2 = last ? nA : cA + (size_t)(t + 2) * kstep; const char* b2 = last ? nB : cB + (size_t)(t + 2) * kstep;
            const char* a3 = a2 + kstep; const char* b3 = b2 + kstep;
            PG8_LDB(B0, 0, 0); PG8_LDB(B1, 0, 1); PG8_SCHED; PG8_LDA(At, 0, 0); PG8_STAGE_A(PG8_SA(1, 1), a1, 1, false);
            PG8_WAIT_V(8); PG8_WAIT_L(0); PG8_BAR; PG8_MMA(0, 0, At, B0); PG8_MMA(0, 1, At, B1); PG8_BAR; PG8_SCHED;
            PG8_LDA(At, 0, 1); PG8_STAGE(PG8_SB(0, 0), b2, voffB); PG8_STAGE(PG8_SB(0, 1), b2 + hstepB, voffB); PG8_STAGE_A(PG8_SA(0, 0), a2, 0, last);
            PG8_WAIT_V(8); PG8_WAIT_L(0); PG8_BAR; PG8_MMA(1, 0, At, B0); PG8_MMA(1, 1, At, B1); PG8_BAR; PG8_SCHED;
            PG8_LDB(B0, 1, 0); PG8_LDB(B1, 1, 1); PG8_SCHED; PG8_LDA(At, 1, 0); PG8_STAGE_A(PG8_SA(0, 1), a2, 1, last);
            PG8_WAIT_V(8); PG8_WAIT_L(0); PG8_BAR; PG8_MMA(0, 0, At, B0); PG8_MMA(0, 1, At, B1); PG8_BAR; PG8_SCHED;
            PG8_LDA(At, 1, 1); PG8_STAGE(PG8_SB(1, 0), b3, voffB); PG8_STAGE(PG8_SB(1, 1), b3 + hstepB, voffB); PG8_STAGE_A(PG8_SA(1, 0), a3, 0, last);
            PG8_WAIT_V(8); PG8_WAIT_L(0); PG8_BAR; PG8_MMA(1, 0, At, B0); PG8_MMA(1, 1, At, B1); PG8_BAR; PG8_SCHED;
        }
        if constexpr (ALIGN_EPI) { if (wr == 0) PG8_BAR; }
        E(acc, cur, wr, wc, fr, fq);
#ifdef MK_EPI_DRAIN
        PG8_WAIT_V(0);
#endif
        if (!has_next) break;
        if (!E.keep(cur)) ACC_ZERO();
        cur = nxt; cA = nA; cB = nB; ++ui;
        if constexpr (GATHER) { vc[0][0] = vn[0][0]; vc[0][1] = vn[0][1]; vc[1][0] = vn[1][0]; vc[1][1] = vn[1][1]; }
        if constexpr (ALIGN_EPI) { if (wr == 1) PG8_BAR; }
    }
    PG8_WAIT_V(0);
    if constexpr (!ALIGN_EPI) { if (wr == 0) PG8_BAR; }
    PG8_BAR;
#undef PG8_GOFFS
#undef PG8_STAGE_A
#undef PG8_SA
#undef PG8_SB
#undef PG8_STAGE
#undef PG8_LDA
#undef PG8_LDB
#undef PG8_MMA
#undef PG8_WAIT_V
#undef PG8_WAIT_L
#undef PG8_BAR
#undef PG8_SCHED
}
#endif
}
using pg8::Unit;

__device__ __forceinline__ void static_order(int L, int nM, int nN, int& pm, int& pn) {
    const int nwg = nM * nN; int wgid = L;
    { const int q = nwg / 8, r = nwg % 8, xcd = wgid % 8, off = wgid / 8; wgid = (xcd < r ? xcd * (q + 1) : r * (q + 1) + (xcd - r) * q) + off; }
    const int nig = 8 * nN, gid = wgid / nig, fm = gid * 8, gsz = (nM - fm) < 8 ? (nM - fm) : 8;
    pm = fm + ((wgid % nig) % gsz); pn = (wgid % nig) / gsz;
}
#ifndef EPI_NT
#define EPI_NT 0
#endif
__device__ __forceinline__ void st16(void* p, u32x4 v) { if (EPI_NT) __builtin_nontemporal_store(v, (u32x4*)p); else *(u32x4*)p = v; }
__device__ __forceinline__ u32x4 pack8(f32x4 a, f32x4 b) { u32x4 w; w.x = cvt_pk_bf16(a[0], a[1]); w.y = cvt_pk_bf16(a[2], a[3]); w.z = cvt_pk_bf16(b[0], b[1]); w.w = cvt_pk_bf16(b[2], b[3]); return w; }
__device__ __forceinline__ void rope4(f32x4& x1, f32x4& x2, f32x4 c, f32x4 s) { const f32x4 o1 = x1 * c - x2 * s, o2 = x2 * c + x1 * s; x1 = o1; x2 = o2; }
__device__ __forceinline__ float sq4(f32x4 v) { return (v[0] * v[0] + v[1] * v[1]) + (v[2] * v[2] + v[3] * v[3]); }

struct Sched1 {
    int G, c; const char* A1; const char* WIN; int ctxmode;
    __device__ __forceinline__ bool next(int i, Unit& u) const {
        u.aux = 0;
        if (ctxmode == 1) { if (i > 0 || c >= 20) return false; u.pm = c / 5; const int j = c % 5; u.pn = (j == 0) ? 1 : (3 + j); return true; }
        if (ctxmode == 3) {
            if (c < 20) { if (i == 0) { u.pm = c / 5; const int j = c % 5; u.pn = (j == 0) ? 1 : (3 + j); return true; } --i; }
            const int L3 = i * G + c; if (L3 >= 2048) return false;
            int pm, pn; static_order(L3, 128, 16, pm, pn); u.pm = pm + 4; u.pn = pn; return true; }
        int L = i * G + c;
        if (L < 2048) { int pm, pn; static_order(L, 128, 16, pm, pn); u.pm = pm + 4; u.pn = pn; return true; }
        if (ctxmode == 0) return false;
        L -= 2048; if (L >= 20) return false;
        u.pm = L / 5; const int j = L % 5; u.pn = (j == 0) ? 1 : (3 + j); return true;
    }
    __device__ __forceinline__ const char* a_ptr(const Unit& u) const { return A1 + (size_t)u.pm * 256 * 1024 * 2; }
    __device__ __forceinline__ const char* b_ptr(const Unit& u) const { return WIN + (size_t)u.pn * 256 * 1024 * 2; }
};
#ifndef E1_ROPE_LDS
#define E1_ROPE_LDS 1
#endif
struct Epi1 {
    static constexpr bool PERM = true, STAGGER = true;
    bf16_t* P0B; float* SSQ; bf16_t* KR; bf16_t* QD; bf16_t* KD; bf16_t* VD; bf16_t* GT; const float* rope; unsigned* KMAX; const LAS float* ropeL;
    unsigned* ready;
    __device__ __forceinline__ bool keep(const Unit&) const { return false; }
    __device__ __forceinline__ void operator()(f32x4 (&acc)[2][2][4][2], const Unit& u, int wr, int wc, int fr, int fq) const {
        asm volatile("" : "+v"(fr), "+v"(fq));
        const bool isctx = u.pm < 4; int b, tbase;
        if (isctx) { b = u.pm; tbase = 0; } else { const int lt = u.pm - 4; b = lt >> 5; tbase = (lt & 31) * 256; }
        const int pn = u.pn;
        const int lr0 = 64 * wr + fr, cw = 32 * wc + 8 * fq;
#define E1_ROWS(...) _Pragma("unroll") for (int ai = 0; ai < 2; ++ai) _Pragma("unroll") for (int m = 0; m < 4; ++m) { const int lr = 128 * ai + 16 * m + lr0; const int t = tbase + lr; __VA_ARGS__ asm volatile("" ::: "memory"); }
        if (pn == 0) {
            bf16_t* P = P0B + (size_t)u.pm * 256 * 512 + cw; float* SQ = SSQ + (size_t)u.pm * 256 * 8 + wc;
            E1_ROWS({ (void)t; float ss = 0.f;
                _Pragma("unroll") for (int bj = 0; bj < 2; ++bj) { const f32x4 v0 = acc[ai][bj][m][0], v1 = acc[ai][bj][m][1]; ss += sq4(v0) + sq4(v1); *(u32x4*)(P + lr * 512 + 128 * bj) = pack8(v0, v1); }
                ss = sum_fq(ss); if (fq == 0) SQ[lr * 8] = ss; })
        } else if (pn == 1) {
            bf16_t* P = P0B + (size_t)u.pm * 256 * 512 + 256 + cw; float* SQ = SSQ + (size_t)u.pm * 256 * 8 + 4 + wc; bf16_t* KRb = KR + (size_t)b * SK * 32 + 8 * fq;
            const int axis = fq >> 1, sub = fq & 1; float kmx = 0.f;
            E1_ROWS({ const f32x4 v0 = acc[ai][0][m][0], v1 = acc[ai][0][m][1]; float ss = sq4(v0) + sq4(v1);
                *(u32x4*)(P + lr * 512) = pack8(v0, v1);
                ss = sum_fq(ss); if (fq == 0) SQ[lr * 8] = ss;
                f32x4 w0 = acc[ai][1][m][0], w1 = acc[ai][1][m][1];
                *(u32x4*)(P + lr * 512 + 128) = pack8(w0, w1);
                if (wc == 0) { const int kidx = isctx ? lr : 256 + t;
                    if (!isctx) { const int pos = axis ? (t & 63) : (t >> 6); const f32x4 c = *(const LAS f32x4*)(ropeL + 4096 + pos * 8 + 4 * sub), s = *(const LAS f32x4*)(ropeL + 5120 + pos * 8 + 4 * sub); rope4(w0, w1, c, s); }
                    float s2 = sq4(w0) + sq4(w1); s2 = sum_fq(s2); kmx = fmaxf(kmx, s2);
                    *(u32x4*)(KRb + kidx * 32) = pack8(w0, w1); } })
            if (wc == 0) { const float mx = wmax16(kmx); if ((fr | fq) == 0) atomicMax(KMAX + 64 + b, __float_as_uint(mx)); }
        }
        if (pn < 2 && ready) {
            asm volatile("s_waitcnt vmcnt(0)" ::: "memory"); __syncthreads();
            if ((wr | wc) == 0 && (fr | fq) == 0) { __builtin_amdgcn_fence(__ATOMIC_RELEASE, "agent"); (void)__hip_atomic_fetch_add(ready, 1u, __ATOMIC_RELAXED, __HIP_MEMORY_SCOPE_AGENT); }
        }
        if (pn < 2) {
        } else if (pn < 6) {
            const bool isq = pn < 4; const int h0 = 2 * (isq ? pn - 2 : pn - 4); const int axis = wc & 1;
            bf16_t* Qb = QD + (size_t)(b * 4 + h0) * SEQ * 128 + cw; bf16_t* Kb = KD + (size_t)(b * 4 + h0) * SK * 128 + cw; float kmx[2] = {0.f, 0.f};
            E1_ROWS({ const int kidx = isctx ? lr : 256 + t; const int pos = axis ? (t & 63) : (t >> 6);
                f32x4 c = {1.f, 1.f, 1.f, 1.f}, s = {0.f, 0.f, 0.f, 0.f};
#if E1_ROPE_LDS
                if (!isctx) { c = *(const LAS f32x4*)(ropeL + pos * 16 + 4 * fq); s = *(const LAS f32x4*)(ropeL + 2048 + pos * 16 + 4 * fq); }
#else
                if (!isctx) { c = *(const f32x4*)(rope + pos * 16 + 4 * fq); s = *(const f32x4*)(rope + 2048 + pos * 16 + 4 * fq); }
#endif
                _Pragma("unroll") for (int bj = 0; bj < 2; ++bj) { f32x4 v0 = acc[ai][bj][m][0], v1 = acc[ai][bj][m][1]; rope4(v0, v1, c, s);
                    if (isq) { v0 = v0 * DIFF_QS; v1 = v1 * DIFF_QS; float s2 = sq4(v0) + sq4(v1); s2 = sum_fq(s2); kmx[bj] = fmaxf(kmx[bj], s2);
                        *(u32x4*)(Qb + (bj * SEQ + t) * 128) = pack8(v0, v1); }
                    else { float s2 = sq4(v0) + sq4(v1); s2 = sum_fq(s2); kmx[bj] = fmaxf(kmx[bj], s2);
                        *(u32x4*)(Kb + (bj * SK + kidx) * 128) = pack8(v0, v1); } } })
            {
                _Pragma("unroll") for (int bj = 0; bj < 2; ++bj) { const float mx = wmax16(kmx[bj]); if ((fr | fq) == 0) atomicMax(KMAX + (isq ? 132 : 68) + (b * 4 + h0 + bj) * 4 + wc, __float_as_uint(mx)); } }
        } else if (pn < 8) {
            bf16_t* Vb = VD + (size_t)(b * 4 + 2 * (pn - 6)) * SK * 128 + cw;
            E1_ROWS({ const int kidx = isctx ? lr : 256 + t;
                _Pragma("unroll") for (int bj = 0; bj < 2; ++bj) *(u32x4*)(Vb + (bj * SK + kidx) * 128) = pack8(acc[ai][bj][m][0], acc[ai][bj][m][1]); })
        } else {
            bf16_t* Gb = GT + (size_t)(u.pm - 4) * 256 * 2048 + (pn - 8) * 256 + cw;
            E1_ROWS({ (void)t;
                _Pragma("unroll") for (int bj = 0; bj < 2; ++bj) { f32x4 v0 = acc[ai][bj][m][0], v1 = acc[ai][bj][m][1];
                    #ifndef DBG_RAW_GATES
                    _Pragma("unroll") for (int j = 0; j < 4; ++j) { v0[j] = sigmoidf_(v0[j]); v1[j] = sigmoidf_(v1[j]); }
#endif

                    st16(Gb + lr * 2048 + 128 * bj, pack8(v0, v1)); } })
        }
#undef E1_ROWS
    }
};

struct SchedUQ {
    int G, c; const char* P0B; const char* WUQ;
    __device__ __forceinline__ bool next(int i, Unit& u) const { const int L = i * G + c; if (L >= 384) return false; u.pn = L % 3; u.pm = L / 3; u.aux = 0; return true; }
    __device__ __forceinline__ const char* a_ptr(const Unit& u) const { return P0B + ((size_t)(NCTX + 256 * u.pm) * 512) * 2; }
    __device__ __forceinline__ const char* b_ptr(const Unit& u) const { return WUQ + (size_t)u.pn * 256 * 256 * 2; }
};
struct EpiUQ {
    static constexpr bool PERM = true, STAGGER = false;
    const float* SSQ; bf16_t* QM; const LAS float* ropeL;
    __device__ __forceinline__ bool keep(const Unit&) const { return false; }
    __device__ __forceinline__ void operator()(f32x4 (&acc)[2][2][4][2], const Unit& u, int wr, int wc, int fr, int fq) const {
        asm volatile("" : "+v"(fr), "+v"(fq));
        const int b = u.pm >> 5, tbase = (u.pm & 31) * 256;
        const float* SQ = SSQ + (size_t)(NCTX + u.pm * 256) * 8; bf16_t* Qb = QM + (size_t)b * 8 * SEQ * 96;
        int hh[2], dd[2];
#pragma unroll
        for (int bj = 0; bj < 2; ++bj) { const int c = 256 * u.pn + 128 * bj + 32 * wc + 8 * fq; hh[bj] = c / 96; dd[bj] = c - 96 * hh[bj]; }
        float rsv[8];
#pragma unroll
        for (int i = 0; i < 8; ++i) { const int lr = 128 * (i >> 2) + 64 * wr + 16 * (i & 3) + fr; const f32x4 sq = *(const f32x4*)(SQ + lr * 8);
            rsv[i] = fast_rsq(((sq[0] + sq[1]) + (sq[2] + sq[3])) * (1.0f / 256.0f) + EPS); }
#pragma unroll
        for (int ai = 0; ai < 2; ++ai)
#pragma unroll
            for (int m = 0; m < 4; ++m) {
                const int lr = 128 * ai + 64 * wr + 16 * m + fr; const int t = tbase + lr;
                const float rs = rsv[ai * 4 + m];
#pragma unroll
                for (int bj = 0; bj < 2; ++bj) { const int h = hh[bj], d = dd[bj];
                    f32x4 v0 = acc[ai][bj][m][0] * rs, v1 = acc[ai][bj][m][1] * rs;
                    if (d >= 64) { const int g = (d - 64) >> 3, axis = g >> 1, sub = g & 1; const int pos = axis ? (t & 63) : (t >> 6);
                        const f32x4 cc = *(const LAS f32x4*)(ropeL + pos * 8 + 4 * sub), ss = *(const LAS f32x4*)(ropeL + 1024 + pos * 8 + 4 * sub); rope4(v0, v1, cc, ss); }
                    v0 = v0 * MLA_QS; v1 = v1 * MLA_QS;
                    *(u32x4*)(Qb + (h * SEQ + t) * 96 + d) = pack8(v0, v1); }
                asm volatile("" ::: "memory");
            }
    }
};
struct SchedUKV {
    int G, c; const char* P0B; const char* WUKV;
    __device__ __forceinline__ bool next(int i, Unit& u) const { const int L = i * G + c; if (L >= 528) return false; u.pn = L & 3; u.pm = L >> 2; u.aux = 0; return true; }
    __device__ __forceinline__ const char* a_ptr(const Unit& u) const { return P0B + ((size_t)(256 * u.pm) * 512 + 256) * 2; }
    __device__ __forceinline__ const char* b_ptr(const Unit& u) const { return WUKV + (size_t)u.pn * 256 * 256 * 2; }
};
struct EpiUKV {
    static constexpr bool PERM = true, STAGGER = false;
    const float* SSQ; const bf16_t* KR; bf16_t* KM; bf16_t* VM; unsigned* KMAX;
    __device__ __forceinline__ bool keep(const Unit&) const { return false; }
    __device__ __forceinline__ void operator()(f32x4 (&acc)[2][2][4][2], const Unit& u, int wr, int wc, int fr, int fq) const {
        asm volatile("" : "+v"(fr), "+v"(fq));
        const bool isctx = u.pm < 4; int b, tbase;
        if (isctx) { b = u.pm; tbase = 0; } else { const int lt = u.pm - 4; b = lt >> 5; tbase = 256 + (lt & 31) * 256; }
        const float* SQ = SSQ + (size_t)(u.pm * 256) * 8 + 4; const bf16_t* KRb = KR + (size_t)b * SK * 32 + 8 * fq;
        bf16_t* Kb = KM + (size_t)(b * 8 + 2 * u.pn) * SK * 96; bf16_t* Vb = VM + (size_t)(b * 8 + 2 * u.pn) * SK * 64;
        float kmx[2] = {0.f, 0.f};
        float rsv[8];
#pragma unroll
        for (int i = 0; i < 8; ++i) { const int lr = 128 * (i >> 2) + 64 * wr + 16 * (i & 3) + fr; const f32x4 sq = *(const f32x4*)(SQ + lr * 8);
            rsv[i] = fast_rsq(((sq[0] + sq[1]) + (sq[2] + sq[3])) * (1.0f / 128.0f) + EPS); }
#pragma unroll
        for (int ai = 0; ai < 2; ++ai)
#pragma unroll
            for (int m = 0; m < 4; ++m) {
                const int lr = 128 * ai + 64 * wr + 16 * m + fr; const int kidx = tbase + lr;
                const float rs = rsv[ai * 4 + m];
#pragma unroll
                for (int bj = 0; bj < 2; ++bj) { const int row = bj * SK + kidx;
                    const f32x4 k0 = acc[ai][bj][m][0] * rs, k1 = acc[ai][bj][m][1] * rs;
                    if (wc < 2) { float s2 = sq4(k0) + sq4(k1); s2 = sum_fq(s2); kmx[bj] = fmaxf(kmx[bj], s2); }
                    const u32x4 w = pack8(k0, k1);
                    if (wc < 2) *(u32x4*)(Kb + row * 96 + 32 * wc + 8 * fq) = w; else *(u32x4*)(Vb + row * 64 + 32 * (wc - 2) + 8 * fq) = w; }
                asm volatile("" ::: "memory");
            }
        if (wc == 0) {
            u32x4 kr[8];
#pragma unroll
            for (int i = 0; i < 8; ++i) { const int lr = 128 * (i >> 2) + 64 * wr + 16 * (i & 3) + fr; kr[i] = *(const u32x4*)(KRb + (tbase + lr) * 32); }
#pragma unroll
            for (int i = 0; i < 8; ++i) { const int lr = 128 * (i >> 2) + 64 * wr + 16 * (i & 3) + fr; const int kidx = tbase + lr;
#pragma unroll
                for (int bj = 0; bj < 2; ++bj) *(u32x4*)(Kb + (bj * SK + kidx) * 96 + 64 + 8 * fq) = kr[i]; }
        }
        if (wc < 2) {
#pragma unroll
            for (int bj = 0; bj < 2; ++bj) { const float mx = wmax16(kmx[bj]); if ((fr | fq) == 0) atomicMax(KMAX + (b * 8 + 2 * u.pn + bj) * 2 + wc, __float_as_uint(mx)); }
        }
    }
};

struct SchedY {
    int G, c; const char* OA; const char* WOC;
    __device__ __forceinline__ bool next(int i, Unit& u) const { if (i >= 4) return false; const int T = (i >> 1) * G + c; if (T >= 512) return false;
        int pm, pn; static_order(T, 128, 4, pm, pn); u.pm = pm; u.pn = pn; u.aux = i & 1; return true; }
    __device__ __forceinline__ const char* a_ptr(const Unit& u) const { return OA + ((size_t)u.pm * 256 * 1024 + u.aux * 512) * 2; }
    __device__ __forceinline__ const char* b_ptr(const Unit& u) const { return WOC + ((size_t)u.pn * 256 * 1024 + u.aux * 512) * 2; }
};
#ifdef EPIY_OLD
struct EpiY {
    static constexpr bool PERM = true, STAGGER = false;
    const bf16_t* GT; bf16_t* Y;
    __device__ __forceinline__ bool keep(const Unit& u) const { return u.aux == 0; }
    __device__ __forceinline__ void operator()(f32x4 (&acc)[2][2][4][2], const Unit& u, int wr, int wc, int fr, int fq) const {
        asm volatile("" : "+v"(fr), "+v"(fq));
#pragma unroll
        for (int ai = 0; ai < 2; ++ai)
#pragma unroll
            for (int m = 0; m < 4; ++m) {
                const size_t rr = (size_t)u.pm * 256 + 128 * ai + 64 * wr + 16 * m + fr;
#pragma unroll
                for (int bj = 0; bj < 2; ++bj) { const int c = 256 * u.pn + 128 * bj + 32 * wc + 8 * fq;
                    const u32x4 gb = *(const u32x4*)(GT + rr * 2048 + 1024 + c);
                    f32x4 b0 = {bf_lo(gb.x), bf_hi(gb.x), bf_lo(gb.y), bf_hi(gb.y)}, b1 = {bf_lo(gb.z), bf_hi(gb.z), bf_lo(gb.w), bf_hi(gb.w)};
                    if (u.aux == 0) {
                        const u32x4 ga = *(const u32x4*)(GT + rr * 2048 + c);
                        const f32x4 a0 = {bf_lo(ga.x), bf_hi(ga.x), bf_lo(ga.y), bf_hi(ga.y)}, a1 = {bf_lo(ga.z), bf_hi(ga.z), bf_lo(ga.w), bf_hi(ga.w)};
#pragma unroll
                        for (int j = 0; j < 4; ++j) { acc[ai][bj][m][0][j] *= (b0[j] > 0.f ? a0[j] * fast_rcp(b0[j]) : 0.f); acc[ai][bj][m][1][j] *= (b1[j] > 0.f ? a1[j] * fast_rcp(b1[j]) : 0.f); }
                    } else {
                        *(u32x4*)(Y + rr * 1024 + c) = pack8(acc[ai][bj][m][0] * b0, acc[ai][bj][m][1] * b1);
                    } }
            }
    }
};

#else
struct EpiY {
    static constexpr bool PERM = true, STAGGER = false;
    const bf16_t* GT; bf16_t* Y;
    __device__ __forceinline__ bool keep(const Unit& u) const { return u.aux == 0; }
    __device__ __forceinline__ void operator()(f32x4 (&acc)[2][2][4][2], const Unit& u, int wr, int wc, int fr, int fq) const {
        asm volatile("" : "+v"(fr), "+v"(fq));
        const bf16_t* Gp = GT + ((size_t)u.pm * 256 + 64 * wr + fr) * 2048 + 256 * u.pn + 32 * wc + 8 * fq;
        if (u.aux == 0) {
#pragma unroll
            for (int ai = 0; ai < 2; ++ai)
#pragma unroll
                for (int m = 0; m < 4; ++m)
#pragma unroll
                    for (int bj = 0; bj < 2; ++bj) { const bf16_t* g = Gp + (128 * ai + 16 * m) * 2048 + 128 * bj;
                        const u32x4 gb = *(const u32x4*)(g + 1024), ga = *(const u32x4*)g;
                        const f32x4 b0 = {bf_lo(gb.x), bf_hi(gb.x), bf_lo(gb.y), bf_hi(gb.y)}, b1 = {bf_lo(gb.z), bf_hi(gb.z), bf_lo(gb.w), bf_hi(gb.w)};
                        const f32x4 a0 = {bf_lo(ga.x), bf_hi(ga.x), bf_lo(ga.y), bf_hi(ga.y)}, a1 = {bf_lo(ga.z), bf_hi(ga.z), bf_lo(ga.w), bf_hi(ga.w)};
#pragma unroll
                        for (int j = 0; j < 4; ++j) { acc[ai][bj][m][0][j] *= (b0[j] > 0.f ? a0[j] * fast_rcp(b0[j]) : 0.f); acc[ai][bj][m][1][j] *= (b1[j] > 0.f ? a1[j] * fast_rcp(b1[j]) : 0.f); } }
        } else {
            bf16_t* Yp = Y + ((size_t)u.pm * 256 + 64 * wr + fr) * 1024 + 256 * u.pn + 32 * wc + 8 * fq;
#pragma unroll
            for (int ai = 0; ai < 2; ++ai) {
                u32x4 gbv[4][2];
#pragma unroll
                for (int m = 0; m < 4; ++m)
#pragma unroll
                    for (int bj = 0; bj < 2; ++bj) gbv[m][bj] = *(const u32x4*)(Gp + (128 * ai + 16 * m) * 2048 + 128 * bj + 1024);
#pragma unroll
                for (int m = 0; m < 4; ++m)
#pragma unroll
                    for (int bj = 0; bj < 2; ++bj) { const u32x4 gb = gbv[m][bj];
                        const f32x4 b0 = {bf_lo(gb.x), bf_hi(gb.x), bf_lo(gb.y), bf_hi(gb.y)}, b1 = {bf_lo(gb.z), bf_hi(gb.z), bf_lo(gb.w), bf_hi(gb.w)};
                        *(u32x4*)(Yp + (128 * ai + 16 * m) * 1024 + 128 * bj) = pack8(acc[ai][bj][m][0] * b0, acc[ai][bj][m][1] * b1); }
                asm volatile("" ::: "memory");
            }
        }
    }
};

#endif
struct SchedZ {
    int G, c; const char* Y; const char* WOUT;
    __device__ __forceinline__ bool next(int i, Unit& u) const { const int L = i * G + c; if (L >= 512) return false; int pm, pn; static_order(L, 128, 4, pm, pn); u.pm = pm; u.pn = pn; u.aux = 0; return true; }
    __device__ __forceinline__ const char* a_ptr(const Unit& u) const { return Y + (size_t)u.pm * 256 * 1024 * 2; }
    __device__ __forceinline__ const char* b_ptr(const Unit& u) const { return WOUT + (size_t)u.pn * 256 * 1024 * 2; }
};
struct EpiZ {
    static constexpr bool PERM = true, STAGGER = false;
    const float* mod; bf16_t* OL;
    __device__ __forceinline__ bool keep(const Unit&) const { return false; }
    __device__ __forceinline__ void operator()(f32x4 (&acc)[2][2][4][2], const Unit& u, int wr, int wc, int fr, int fq) const {
        asm volatile("" : "+v"(fr), "+v"(fq));
        const int b = u.pm >> 5; const float* g1 = mod + b * 6144 + 2048 + 256 * u.pn + 32 * wc + 8 * fq;
        bf16_t* O = OL + (size_t)u.pm * 256 * 1024 + 256 * u.pn + 32 * wc + 8 * fq;
        f32x4 gq[2][2];
#pragma unroll
        for (int bj = 0; bj < 2; ++bj) { gq[bj][0] = *(const f32x4*)(g1 + 128 * bj); gq[bj][1] = *(const f32x4*)(g1 + 128 * bj + 4); }
#pragma unroll
        for (int bj = 0; bj < 2; ++bj) { const f32x4 g0 = gq[bj][0], g4 = gq[bj][1];
#pragma unroll
            for (int ai = 0; ai < 2; ++ai)
#pragma unroll
                for (int m = 0; m < 4; ++m) { const int lr = 128 * ai + 64 * wr + 16 * m + fr;
                    *(u32x4*)(O + lr * 1024 + 128 * bj) = pack8(acc[ai][bj][m][0] * g0, acc[ai][bj][m][1] * g4); } }
    }
};

struct SchedM1 {
    int xcd, slot; const char* XE; const char* W13;
    __device__ __forceinline__ bool next(int i, Unit& u) const { if (i >= 8) return false; const int e = 2 * xcd + (i >> 2), ap = (i & 3) * 4 + (slot >> 3);
        u.pn = slot & 7; u.pm = ((ap >> 2) * 16 + e) * 4 + (ap & 3); u.aux = e; return true; }
    __device__ __forceinline__ const char* a_ptr(const Unit& u) const { return XE + (size_t)(u.pm >> 6) * SEQ * 1024 * 2; }
    __device__ __forceinline__ const char* b_ptr(const Unit& u) const { return W13 + ((size_t)u.aux * 2048 + u.pn * 256) * 1024 * 2; }
};
struct EpiM1 {
    static constexpr bool PERM = true, STAGGER = true;
    bf16_t* HID; int abl;
    __device__ __forceinline__ bool keep(const Unit&) const { return false; }
    __device__ __forceinline__ void operator()(f32x4 (&acc)[2][2][4][2], const Unit& u, int wr, int wc, int fr, int fq) const {
        asm volatile("" : "+v"(fr), "+v"(fq));
        if (abl == 2) return;
#pragma unroll
        for (int ai = 0; ai < 2; ++ai)
#pragma unroll
            for (int m = 0; m < 4; ++m) { const size_t row = (size_t)u.pm * 256 + 128 * ai + 64 * wr + 16 * m + fr;
                f32x4 h0, h1;
#pragma unroll
                for (int j = 0; j < 4; ++j) { const float a0 = acc[ai][0][m][0][j], a1 = acc[ai][0][m][1][j];
                    h0[j] = a0 * sigmoidf_(a0) * acc[ai][1][m][0][j]; h1[j] = a1 * sigmoidf_(a1) * acc[ai][1][m][1][j]; }
                const u32x4 pk = pack8(h0, h1);
                if (abl == 0) st16(HID + row * 1024 + 128 * u.pn + 32 * wc + 8 * fq, pk);
                else if (abl == 3) { u32x2 p2; p2[0] = pk[0] ^ pk[2]; p2[1] = pk[1] ^ pk[3]; *(u32x2*)(HID + row * 1024 + 128 * u.pn + 32 * wc + 8 * fq) = p2; }
                else if (abl == 4) st16(HID + ((size_t)(blockIdx.x * 16) + (row & 15)) * 1024 + 128 * u.pn + 32 * wc + 8 * fq, pk);
                else if (abl == 5) { if (ai == 0 && m == 0) st16(HID + row * 1024 + 128 * u.pn + 32 * wc + 8 * fq, pk); else asm volatile("" :: "v"(pk)); }
                else asm volatile("" :: "v"(pk)); }
    }
};
struct SchedM2 {
    int xcd, slot; const char* HID; const char* W2T;
    __device__ __forceinline__ bool next(int i, Unit& u) const { if (i >= 4) return false; const int e = 2 * xcd + (i >> 1), ap = (i & 1) * 8 + (slot >> 2);
        u.pn = slot & 3; u.pm = ((ap >> 2) * 16 + e) * 4 + (ap & 3); u.aux = e; return true; }
    __device__ __forceinline__ const char* a_ptr(const Unit& u) const { return HID + (size_t)u.pm * 256 * 1024 * 2; }
    __device__ __forceinline__ const char* b_ptr(const Unit& u) const { return W2T + ((size_t)u.aux * 1024 + u.pn * 256) * 1024 * 2; }
};
struct EpiM2 {
    static constexpr bool PERM = true, STAGGER = true;
    const float* GSEL; bf16_t* YE;
    __device__ __forceinline__ bool keep(const Unit&) const { return false; }
    __device__ __forceinline__ void operator()(f32x4 (&acc)[2][2][4][2], const Unit& u, int wr, int wc, int fr, int fq) const {
        asm volatile("" : "+v"(fr), "+v"(fq));
#ifndef EPIM2_OLD
        float gv[8];
#pragma unroll
        for (int i = 0; i < 8; ++i) gv[i] = GSEL[(size_t)u.pm * 256 + 128 * (i >> 2) + 64 * wr + 16 * (i & 3) + fr];
#endif
#ifdef DBG_M2_FENCE
        asm volatile("s_waitcnt vmcnt(0)" ::: "memory");
#endif
#pragma unroll
        for (int ai = 0; ai < 2; ++ai)
#pragma unroll
            for (int m = 0; m < 4; ++m) { const size_t row = (size_t)u.pm * 256 + 128 * ai + 64 * wr + 16 * m + fr;
#ifdef EPIM2_OLD
                const float g = GSEL[row];
#else
                const float g = gv[ai * 4 + m];
#endif
#pragma unroll
                for (int bj = 0; bj < 2; ++bj)
                    st16(YE + row * 1024 + 256 * u.pn + 128 * bj + 32 * wc + 8 * fq, pack8(acc[ai][bj][m][0] * g, acc[ai][bj][m][1] * g)); }
    }
};

struct SchedU {
    SchedUQ q; SchedUKV kv; int G, c;
    __device__ __forceinline__ bool next(int i, Unit& u) const {
#ifdef DBG_UREP
        if (i >= 4 * (DBG_UREP + 1)) return false; int L = (i & 3) * G + c; if (L >= 912) L -= 512;
#else
        if (c < 0) return false;
        const int L = i * G + c; if (L >= 912) return false;
#endif
        if (L < 384) { u.pn = L % 3; u.pm = L / 3; u.aux = 0; } else { const int L2 = L - 384; u.pn = L2 & 3; u.pm = L2 >> 2; u.aux = 1; } return true; }
    __device__ __forceinline__ const char* a_ptr(const Unit& u) const { return u.aux == 0 ? q.a_ptr(u) : kv.a_ptr(u); }
    __device__ __forceinline__ const char* b_ptr(const Unit& u) const { return u.aux == 0 ? q.b_ptr(u) : kv.b_ptr(u); }
};
struct EpiU {
    static constexpr bool PERM = true, STAGGER = false;
    EpiUQ q; EpiUKV kv;
    __device__ __forceinline__ bool keep(const Unit&) const { return false; }
    __device__ __forceinline__ void operator()(f32x4 (&acc)[2][2][4][2], const Unit& u, int wr, int wc, int fr, int fq) const {
        if (u.aux == 0) q(acc, u, wr, wc, fr, fq); else kv(acc, u, wr, wc, fr, fq);
    }
};
namespace fa {
#define KSWZ(row, colB) ((row) * 256 + ((colB) ^ (((row) & 15) << 4)))
#define SBAR() __builtin_amdgcn_sched_barrier(0)
__device__ __forceinline__ int crow(int r, int hi) { return (r & 3) + 8 * (r >> 2) + 4 * hi; }
constexpr float THRL = 11.0f;
constexpr int VOFF = 0, KOFF = 32768, BUFB = 16384, WSOFF = 131072;

__device__ __forceinline__ void partialSM(f32x16& p0, f32x16& p1, float& m_reg, float& alpha) {
    float pmax = p0[0];
#pragma unroll
    for (int r = 1; r < 16; ++r) pmax = fmaxf(pmax, p0[r]);
#pragma unroll
    for (int r = 0; r < 16; ++r) pmax = fmaxf(pmax, p1[r]);
    { auto rr = __builtin_amdgcn_permlane32_swap(__float_as_uint(pmax), __float_as_uint(pmax), false, false);
      pmax = fmaxf(__uint_as_float(rr[0]), __uint_as_float(rr[1])); }
    float mn;
    if (__builtin_expect(__all(pmax - m_reg <= THRL), 1)) { mn = m_reg; alpha = 1.f; }
    else { mn = fmaxf(m_reg, pmax); alpha = fast_exp2(m_reg - mn); m_reg = mn; }
#pragma unroll
    for (int r = 0; r < 16; ++r) { p0[r] -= mn; p1[r] -= mn; }
#pragma unroll
    for (int r = 0; r < 16; ++r) p0[r] = fast_exp2(p0[r]);
}
__device__ __forceinline__ void finishSM(f32x16& p0, f32x16& p1, float alpha, float& l_reg, bf16x8& pa0, bf16x8& pa1, bf16x8& pa2, bf16x8& pa3) {
#pragma unroll
    for (int r = 0; r < 16; ++r) p1[r] = fast_exp2(p1[r]);
    float ps = 0.f;
#pragma unroll
    for (int r = 0; r < 16; ++r) ps += p0[r];
#pragma unroll
    for (int r = 0; r < 16; ++r) ps += p1[r];
    { auto rr = __builtin_amdgcn_permlane32_swap(__float_as_uint(ps), __float_as_uint(ps), false, false);
      ps = __uint_as_float(rr[0]) + __uint_as_float(rr[1]); }
    l_reg = l_reg * alpha + ps;
#define PK4(P, BASE, OUT) do { unsigned a0 = cvt_pk_bf16(P[BASE + 0], P[BASE + 1]), a1 = cvt_pk_bf16(P[BASE + 2], P[BASE + 3]);   \
    unsigned b0 = cvt_pk_bf16(P[BASE + 4], P[BASE + 5]), b1 = cvt_pk_bf16(P[BASE + 6], P[BASE + 7]);                              \
    auto r0 = __builtin_amdgcn_permlane32_swap(a0, b0, false, false); auto r1 = __builtin_amdgcn_permlane32_swap(a1, b1, false, false); \
    u32x4 w = {r0[0], r1[0], r0[1], r1[1]}; OUT = __builtin_bit_cast(bf16x8, w); } while (0)
    PK4(p0, 0, pa0); PK4(p0, 8, pa1); PK4(p1, 0, pa2); PK4(p1, 8, pa3);
#undef PK4
}
template <int NQ>
__device__ __forceinline__ void qkt(f32x16& p0, f32x16& p1, const LAS unsigned char* Ks, const bf16x8* qr, int r32, int hi, int kcolB) {
    p0 = f32x16{}; p1 = f32x16{};
#pragma unroll
    for (int d0 = 0; d0 < NQ; ++d0) { const int cb = kcolB + (d0 * 16 + hi * 8) * 2;
        const bf16x8 b0 = *(const LAS bf16x8*)(Ks + KSWZ(r32, cb));
        const bf16x8 b1 = *(const LAS bf16x8*)(Ks + KSWZ(32 + r32, cb));
        p0 = __builtin_amdgcn_mfma_f32_32x32x16_bf16(b0, qr[d0], p0, 0, 0, 0);
        p1 = __builtin_amdgcn_mfma_f32_32x32x16_bf16(b1, qr[d0], p1, 0, 0, 0); }
}
template <int NCB> __device__ __forceinline__ int v_st(int k, int c) { const int kk = k; return ((kk >> 3) * NCB + (c >> 5)) * 512 + ((kk & 7) * 32 + (c & 31)) * 2; }
__device__ __forceinline__ int v_rd_base(int lane) { return ((lane & 3) << 3) | (((lane >> 2) & 3) << 6) | (((lane >> 4) & 1) << 5) | (((lane >> 5) & 1) << 8); }
template <int OFF> __device__ __forceinline__ s16x4 tr_read(int vb) {
    s16x4 r; asm volatile("ds_read_b64_tr_b16 %0, %1 offset:%2" : "=&v"(r) : "v"(vb), "i"(OFF) : "memory"); return r;
}
template <int NCB, int D0> __device__ __forceinline__ void pv_one(f32x16& od, int vb, bf16x8 pa0, bf16x8 pa1, bf16x8 pa2, bf16x8 pa3) {
#define VO(ks, half) (D0 * 512 + (ks) * (1024 * NCB) + (half) * (512 * NCB))
    const s16x4 l0 = tr_read<VO(0, 0)>(vb), h0 = tr_read<VO(0, 1)>(vb), l1 = tr_read<VO(1, 0)>(vb), h1 = tr_read<VO(1, 1)>(vb);
    const s16x4 l2 = tr_read<VO(2, 0)>(vb), h2 = tr_read<VO(2, 1)>(vb), l3 = tr_read<VO(3, 0)>(vb), h3 = tr_read<VO(3, 1)>(vb);
#undef VO
    asm volatile("s_waitcnt lgkmcnt(0)" ::: "memory"); SBAR();
#define PK(L, H) (bf16x8){L[0], L[1], L[2], L[3], H[0], H[1], H[2], H[3]}
    od = __builtin_amdgcn_mfma_f32_32x32x16_bf16(pa0, PK(l0, h0), od, 0, 0, 0);
    od = __builtin_amdgcn_mfma_f32_32x32x16_bf16(pa1, PK(l1, h1), od, 0, 0, 0);
    od = __builtin_amdgcn_mfma_f32_32x32x16_bf16(pa2, PK(l2, h2), od, 0, 0, 0);
    od = __builtin_amdgcn_mfma_f32_32x32x16_bf16(pa3, PK(l3, h3), od, 0, 0, 0);
#undef PK
}
template <int NCB> __device__ __forceinline__ void pv_all(f32x16* o, int vb, bf16x8 pa0, bf16x8 pa1, bf16x8 pa2, bf16x8 pa3) {
    pv_one<NCB, 0>(o[0], vb, pa0, pa1, pa2, pa3); pv_one<NCB, 1>(o[1], vb, pa0, pa1, pa2, pa3);
    if constexpr (NCB == 4) { pv_one<NCB, 2>(o[2], vb, pa0, pa1, pa2, pa3); pv_one<NCB, 3>(o[3], vb, pa0, pa1, pa2, pa3); }
}

typedef short v4i16_t __attribute__((ext_vector_type(4)));
__device__ __forceinline__ s16x4 vtr(const LAS unsigned char* p) { return __builtin_bit_cast(s16x4, __builtin_amdgcn_ds_read_tr16_b64_v4i16((LAS v4i16_t*)p)); }
template <int LO, int N, int ABL = 0, bool SUM = true> __device__ __forceinline__ void expsum(f32x16& p0, f32x16& p1, float (&ls)[4], int lo_rt, float msub) {
#pragma unroll
    for (int q = 0; q < N; ++q) { const int r = lo_rt + q;
        if (r < 16) { const float e = (ABL & 1) ? (p0[r] - msub) : fast_exp2(p0[r] - msub); p0[r] = e; if (SUM) ls[0] += e; } else if (r < 32) { const float e = (ABL & 1) ? (p1[r - 16] - msub) : fast_exp2(p1[r - 16] - msub); p1[r - 16] = e; if (SUM) ls[0] += e; } }
}
#define PK4(P, BASE, OUT) do { const u32x4 w_ = {cvt_pk_bf16(P[BASE + 0], P[BASE + 1]), cvt_pk_bf16(P[BASE + 2], P[BASE + 3]), cvt_pk_bf16(P[BASE + 4], P[BASE + 5]), cvt_pk_bf16(P[BASE + 6], P[BASE + 7])}; \
    OUT = __builtin_bit_cast(bf16x8, w_); } while (0)

#ifndef ROWSUM_MFMA
#define ROWSUM_MFMA 0
#endif
#ifdef ATT_NOSGB
#define SGB(mask, n) do { } while (0)
#else
#define SGB(mask, n) __builtin_amdgcn_sched_group_barrier(mask, n, 0)
#endif
template <int ABL> __device__ __forceinline__ f32x16 mfma_a(bf16x8 a, bf16x8 b, f32x16 c) { if constexpr (ABL & 2) { asm volatile("" :: "v"(a), "v"(b)); return c; } else return __builtin_amdgcn_mfma_f32_32x32x16_bf16(a, b, c, 0, 0, 0); }
template <int ABL> __device__ __forceinline__ bf16x8 ldsrd_a(const LAS unsigned char* p, bf16x8 alt) { if constexpr (ABL & 16) { asm volatile("" : "+v"(alt)); return alt; } else return *(const LAS bf16x8*)p; }
template <int NQ, int NCB, bool DOQK, bool DOPV, int SHIFT, int ABL, int NEXB>
__device__ __forceinline__ void tile_step(f32x16& c0, f32x16& c1, f32x16& p0, f32x16& p1, f32x16 (&o)[NCB], f32x16& lacc, const LAS unsigned char* Kb, const int (&ka)[NQ],
                                          const bf16x8 (&qr)[NQ], const f32x16& negm, float msub, const LAS unsigned char* Vb) {
    const f32x16 zero16 = {};
    constexpr int NG = 2 * NQ, NM = 4 * NCB;
    SBAR();
    if constexpr (DOQK) {
#pragma unroll
        for (int d0 = 0; d0 < NQ; ++d0) {
            const bf16x8 kf0 = ldsrd_a<ABL>(Kb + ka[d0], qr[d0]), kf1 = ldsrd_a<ABL>(Kb + ka[d0] + 8192, qr[d0]);
            if (d0 == 0) { c0 = mfma_a<ABL>(kf0, qr[d0], (SHIFT == 1) ? negm : zero16); c1 = mfma_a<ABL>(kf1, qr[d0], (SHIFT == 1) ? negm : zero16); }
            else { c0 = mfma_a<ABL>(kf0, qr[d0], c0); c1 = mfma_a<ABL>(kf1, qr[d0], c1); }
        }
    }
    if constexpr (DOPV) {
#define VO(d0, ks, half) ((d0) * 512 + (ks) * (1024 * NCB) + (half) * (512 * NCB))
        bf16x8 pa[4];
        { float ls_[4] = {0.f, 0.f, 0.f, 0.f}; ls_[0] = lacc[0]; expsum<0, 32 - NEXB, ABL, !ROWSUM_MFMA>(p0, p1, ls_, 0, msub);
          PK4(p0, 0, pa[0]); PK4(p0, 8, pa[1]);
          if constexpr (NEXB > 0) expsum<0, NEXB, ABL, !ROWSUM_MFMA>(p0, p1, ls_, 32 - NEXB, msub);
          PK4(p1, 0, pa[2]); PK4(p1, 8, pa[3]);
          if (!ROWSUM_MFMA) lacc[0] = ls_[0]; }
        const u32x4 one4 = {0x3f803f80u, 0x3f803f80u, 0x3f803f80u, 0x3f803f80u}; const bf16x8 ones = __builtin_bit_cast(bf16x8, one4);
#pragma unroll
        for (int idx = 0; idx < NM; ++idx) { const int ks = idx / NCB, d0 = idx % NCB;
#if ROWSUM_MFMA
            if (d0 == 0) lacc = mfma_a<ABL>(pa[ks], ones, lacc);
#endif
            bf16x8 vf;
            if constexpr (ABL & 16) { vf = pa[ks]; asm volatile("" : "+v"(vf)); } else { const s16x4 vl = vtr(Vb + VO(d0, ks, 0)), vh = vtr(Vb + VO(d0, ks, 1)); vf = (bf16x8){vl[0], vl[1], vl[2], vl[3], vh[0], vh[1], vh[2], vh[3]}; }
            o[d0] = mfma_a<ABL>(pa[ks], vf, o[d0]);
        }
#undef VO
    }
#ifndef ATT_PACKFRONT
#define ATT_PACKFRONT 0
#endif
#ifndef ATT_MFMA2
#define ATT_MFMA2 0
#endif
#ifndef ATT_VAH_MLA
#define ATT_VAH_MLA 8
#endif
#ifndef ATT_VAH_DIFF
#define ATT_VAH_DIFF 4
#endif
#ifndef ATT_FRONT
#define ATT_FRONT 8
#endif
#ifndef ATT_KAHEAD
#define ATT_KAHEAD 2
#endif
    constexpr int VAH = (NCB == 4) ? ATT_VAH_DIFF : ATT_VAH_MLA;
    constexpr int VPER = (SHIFT == 2) ? 1 : 0;
    constexpr int NEXA = 32 - NEXB, FRONT = DOQK ? ATT_FRONT : NEXA, HALFM = NM / 2;
#ifndef ATT_KAHEAD_DIFF
#define ATT_KAHEAD_DIFF ATT_KAHEAD
#endif
#ifndef ATT_VSTART
#define ATT_VSTART 4
#endif
    constexpr int KAH_ = (NCB == 4) ? ATT_KAHEAD_DIFF : ATT_KAHEAD;
    constexpr int KFIRST = (KAH_ >= NG) ? NG : KAH_;
    if constexpr (DOQK) SGB(0x100, KFIRST);
    if constexpr (DOPV && FRONT > 0) { SGB(0x400, FRONT); if constexpr (VPER > 0) SGB(0x002, FRONT * VPER); }
    if constexpr (DOQK) {
        constexpr int PER = (NEXA - FRONT + NG - 1) / NG;
#pragma unroll
        for (int g = 0; g < NG; ++g) {
            if (ATT_MFMA2) { if (g & 1) continue;
                if (KFIRST + g < NG) SGB(0x100, 2);
                SGB(0x008, 2);
                if constexpr (DOPV) { if constexpr (PER > 0) { SGB(0x400, 2 * PER); if constexpr (VPER > 0) SGB(0x002, 2 * PER * VPER); } if (g >= NG - ATT_VSTART) SGB(0x100, (4 * VAH) / ATT_VSTART); }
                continue; }
            if (KFIRST + g < NG) SGB(0x100, 1);
            SGB(0x008, 1);
            if constexpr (DOPV) { if constexpr (PER > 0) { SGB(0x400, PER); if constexpr (VPER > 0) SGB(0x002, PER * VPER); } if (g >= NG - ATT_VSTART) SGB(0x100, (2 * VAH) / ATT_VSTART); }
        }
    }
    if constexpr (DOPV) {
        if constexpr (!DOQK) SGB(0x100, 2 * VAH);
        SGB(0x002, ATT_PACKFRONT ? 16 : 8);
        constexpr int PERB = NEXB > 0 ? (NEXB + HALFM - 1) / HALFM : 0;
#pragma unroll
        for (int idx = 0; idx < NM + (ROWSUM_MFMA ? 4 : 0); ++idx) {
            if (idx + VAH < NM) SGB(0x100, 2);
            if constexpr (NEXB > 0) { if (idx == HALFM) SGB(0x002, 8); }
            SGB(0x008, 1);
            if constexpr (NEXB > 0) { if (idx < HALFM) { SGB(0x400, PERB); if constexpr (VPER > 0) SGB(0x002, PERB * VPER); } }
            else { if (!ATT_PACKFRONT && idx < 4) SGB(0x002, 2); }
        }
    }
    if constexpr (DOQK) asm volatile("" : "+v"(c0), "+v"(c1));
    if constexpr (DOPV) {
#pragma unroll
        for (int d = 0; d < NCB; ++d) asm volatile("" : "+v"(o[d]));
        asm volatile("" : "+v"(lacc));
    }
    SBAR();
}

template <int MODE> struct AU { static constexpr int DQK = MODE ? 64 : 96, DV = MODE ? 128 : 64, LDK = MODE ? 128 : 96, NQ = DQK / 16, NLD = (64 * (LDK / 8) + 64 * (DV / 8) + 511) / 512; };
template <int MODE, int ABL, int SHIFT>
__device__ __forceinline__ void attn_unit(LAS unsigned char* lds, const bf16_t* __restrict__ Qu, const bf16_t* __restrict__ Kh, const bf16_t* __restrict__ Vh, bf16_t* Ou,
                                          float kmax0, float kmax1, float lam, const float* __restrict__ gsub, int wave,
                                          const bf16_t* __restrict__ Qn, const bf16_t* __restrict__ Kn, const bf16_t* __restrict__ Vn, bf16x8 (&qr)[AU<MODE>::NQ], bf16x8 (&sr_)[AU<MODE>::NLD]) {
    constexpr int DQK = MODE ? 64 : 96, DV = MODE ? 128 : 64, LDQ = MODE ? 128 : 96, LDK = MODE ? 128 : 96, LDV = DV;
    constexpr int KCPR = LDK / 8, VCPR = LDV / 8, NKCH = 64 * KCPR, NCH = NKCH + 64 * VCPR, NLD = (NCH + 511) / 512, NCB = DV / 32, NQ = DQK / 16, NT = SK / 64;
    static_assert(NQ == AU<MODE>::NQ && NLD == AU<MODE>::NLD, "AU mismatch");
    constexpr int NEXB = 0;
    int tid_ = wave * 64 + lane_id(); asm volatile("" : "+v"(tid_));
    const int tid = tid_, wid = wave, lane = tid & 63, r32 = lane & 31, hi = lane >> 5;
    const int mp = MODE ? (wid >> 2) : 0, qw = MODE ? (wid & 3) : wid;
    f32x16 o[NCB];
#pragma unroll
    for (int d = 0; d < NCB; ++d) o[d] = f32x16{};
    float qss = 0.f;
    const int qoff = (qw * 32 + r32) * LDQ + mp * 64 + hi * 8;
#pragma unroll
    for (int d0 = 0; d0 < NQ; ++d0) {
#pragma unroll
        for (int j = 0; j < 8; ++j) { const float v = bf2f((bf16_t)qr[d0][j]); qss += v * v; } }
    { auto rr = __builtin_amdgcn_permlane32_swap(__float_as_uint(qss), __float_as_uint(qss), false, false); qss = __uint_as_float(rr[0]) + __uint_as_float(rr[1]); }
    const float Mrow = 1.02f * sqrtf(qss) * (mp ? kmax1 : kmax0) + 0.5f;
    f32x16 negm = {}; const float msub = (SHIFT == 2) ? Mrow : 0.f;
    if constexpr (SHIFT == 1) {
#pragma unroll
        for (int r = 0; r < 16; ++r) negm[r] = -Mrow;
        asm volatile("" : "+v"(negm)); }
    unsigned voff[NLD]; int dst[NLD]; bool isk[NLD];
#pragma unroll
    for (int i = 0; i < NLD; ++i) { int c = tid + 512 * i; if (c >= NCH) c -= NCH;
        if (MODE) isk[i] = (i < 2); else isk[i] = (i == 0) || ((i == 1) == (wid < 4));
        if (c < NKCH) { const int row = c / KCPR, ch = c % KCPR; voff[i] = (row * LDK + ch * 8) * 2; dst[i] = KOFF + BUFB + KSWZ(row, ch * 16); }
        else { const int c2 = c - NKCH; const int row = c2 / VCPR, ch = c2 % VCPR; voff[i] = (row * LDV + ch * 8) * 2; dst[i] = VOFF + v_st<NCB>(row, ch * 8); } }
    int ka[NQ];
#pragma unroll
    for (int d0 = 0; d0 < NQ; ++d0) ka[d0] = KSWZ(r32, mp * 128 + (d0 * 16 + hi * 8) * 2);
    const LAS unsigned char* Kb0 = lds + KOFF; const LAS unsigned char* Vb0 = lds + VOFF + v_rd_base(lane);
#define STAGE_LOAD_AT(KB, VB, j) do { const char* kb_ = (const char*)((KB) + (long)((j) + 1) * (64 * LDK)); const char* vb_ = (const char*)((VB) + (long)(j) * (64 * LDV)); \
        _Pragma("unroll") for (int i_ = 0; i_ < NLD; ++i_) sr_[i_] = *(const bf16x8*)((isk[i_] ? kb_ : vb_) + voff[i_]); } while (0)
#define STAGE_LOAD(j) STAGE_LOAD_AT(Kh, Vh, j)
#define STAGE_WRITE(jodd) do { _Pragma("unroll") for (int i_ = 0; i_ < NLD; ++i_) *(LAS bf16x8*)(lds + (dst[i_] ^ ((jodd) ? BUFB : 0))) = sr_[i_]; } while (0)
    f32x16 sA0, sA1, sB0, sB1, lacc = {};
    __syncthreads();
    STAGE_WRITE(1); STAGE_LOAD(0);
    __syncthreads();
    tile_step<NQ, NCB, true, false, SHIFT, ABL, NEXB>(sA0, sA1, sA0, sA1, o, lacc, Kb0, ka, qr, negm, msub, Vb0);
    STAGE_WRITE(0); STAGE_LOAD(1);
    __syncthreads();
#define ITER(C0, C1, P0, P1, todd, t) do { \
        tile_step<NQ, NCB, true, true, SHIFT, ABL, NEXB>(C0, C1, P0, P1, o, lacc, Kb0 + ((todd) ? BUFB : 0), ka, qr, negm, msub, Vb0 + ((todd) ? 0 : BUFB)); \
        STAGE_WRITE(todd); if (!(ABL & 4)) STAGE_LOAD((t) + 1); \
        if (!(ABL & 8)) __syncthreads(); } while (0)
    if (!(ABL & 32))
    for (int t = 1; t + 1 < NT; t += 2) {
        ITER(sB0, sB1, sA0, sA1, 1, t);
        ITER(sA0, sA1, sB0, sB1, 0, t + 1);
    }
    {
        tile_step<NQ, NCB, true, true, SHIFT, ABL, NEXB>(sB0, sB1, sA0, sA1, o, lacc, Kb0 + BUFB, ka, qr, negm, msub, Vb0);
        STAGE_WRITE(1);
        { long dq = Qn - Qu; asm volatile("" : "+s"(dq));
            if constexpr (MODE == 0) { long dk = Kn - Kh, dv = Vn - Vh; asm volatile("" : "+s"(dk), "+s"(dv)); STAGE_LOAD_AT(Kh + dk, Vh + dv, -1); }
#pragma unroll
            for (int d0 = 0; d0 < NQ; ++d0) qr[d0] = *(const bf16x8*)(Qu + dq + qoff + d0 * 16); }
        if (!(ABL & 8)) __syncthreads(); }
    tile_step<NQ, NCB, false, true, SHIFT, ABL, NEXB>(sB0, sB1, sB0, sB1, o, lacc, Kb0, ka, qr, negm, msub, Vb0 + BUFB);
#undef ITER
    float rli[16];
#if ROWSUM_MFMA
#pragma unroll
    for (int r = 0; r < 16; ++r) rli[r] = fast_rcp(lacc[r]);
#else
    { float l_reg = lacc[0]; LAS float* li_l = (LAS float*)(lds + WSOFF) + wid * 64;
      auto rr = __builtin_amdgcn_permlane32_swap(__float_as_uint(l_reg), __float_as_uint(l_reg), false, false); l_reg = __uint_as_float(rr[0]) + __uint_as_float(rr[1]);
      if (hi == 0) li_l[r32] = l_reg; asm volatile("s_waitcnt lgkmcnt(0)" ::: "memory");
#pragma unroll
      for (int r = 0; r < 16; ++r) rli[r] = fast_rcp(li_l[crow(r, hi)]); }
#endif
    if constexpr (MODE == 0) {
        bf16_t* Ow = Ou + (size_t)(wid * 32) * 1024;
#pragma unroll
        for (int r = 0; r < 16; ++r) { const int orow = crow(r, hi);
#pragma unroll
            for (int d0 = 0; d0 < NCB; ++d0) Ow[(size_t)orow * 1024 + d0 * 32 + r32] = (bf16_t)(cvt_pk_bf16(o[d0][r] * rli[r], 0.f) & 0xffffu); }
    } else {
        __syncthreads();
        LAS float* Ost = (LAS float*)lds;
#pragma unroll
        for (int r = 0; r < 16; ++r) { const int row = mp * 128 + qw * 32 + crow(r, hi);
#pragma unroll
            for (int d0 = 0; d0 < NCB; ++d0) Ost[row * 128 + d0 * 32 + r32] = o[d0][r] * rli[r]; }
        __syncthreads();
        const float g0 = gsub[2 * lane], g1 = gsub[2 * lane + 1];
        { long dk = Kn - Kh, dv = Vn - Vh; asm volatile("" : "+s"(dk), "+s"(dv)); STAGE_LOAD_AT(Kh + dk, Vh + dv, -1); }
#pragma unroll 4
        for (int k = 0; k < 16; ++k) { const int row = wid * 16 + k;
            const f32x2 a = *(const LAS f32x2*)(Ost + row * 128 + 2 * lane), b2 = *(const LAS f32x2*)(Ost + (128 + row) * 128 + 2 * lane);
            const float d0 = a.x - lam * b2.x, d1 = a.y - lam * b2.y;
            const float ss = wave_sum(d0 * d0 + d1 * d1);
            const float rs = (fast_rsq(ss * (1.0f / 128.0f) + EPS)) * (1.0f - LAMBDA_INIT);
            *(unsigned*)(Ou + (size_t)row * 1024 + 2 * lane) = cvt_pk_bf16(d0 * rs * g0, d1 * rs * g1); }
    }
#undef STAGE_LOAD
#undef STAGE_LOAD_AT
#undef STAGE_WRITE
}
template <int MODE>
__device__ __forceinline__ void attn_prefetch(const bf16_t* __restrict__ Qu, const bf16_t* __restrict__ Kh, const bf16_t* __restrict__ Vh, int wave, bf16x8 (&qr)[AU<MODE>::NQ], bf16x8 (&sr_)[AU<MODE>::NLD]) {
    constexpr int DV = MODE ? 128 : 64, LDQ = MODE ? 128 : 96, LDK = MODE ? 128 : 96, LDV = DV;
    constexpr int KCPR = LDK / 8, VCPR = LDV / 8, NKCH = 64 * KCPR, NCH = NKCH + 64 * VCPR, NLD = AU<MODE>::NLD, NQ = AU<MODE>::NQ;
    int tid_ = wave * 64 + lane_id(); asm volatile("" : "+v"(tid_));
    const int tid = tid_, wid = wave, lane = tid & 63, r32 = lane & 31, hi = lane >> 5;
    const int mp = MODE ? (wid >> 2) : 0, qw = MODE ? (wid & 3) : wid;
    const int qoff = (qw * 32 + r32) * LDQ + mp * 64 + hi * 8;
#pragma unroll
    for (int d0 = 0; d0 < NQ; ++d0) qr[d0] = *(const bf16x8*)(Qu + qoff + d0 * 16);
#pragma unroll
    for (int i = 0; i < NLD; ++i) { int c = tid + 512 * i; if (c >= NCH) c -= NCH;
        const bool isk = MODE ? (i < 2) : ((i == 0) || ((i == 1) == (wid < 4)));
        unsigned vo; if (c < NKCH) { const int row = c / KCPR, ch = c % KCPR; vo = (row * LDK + ch * 8) * 2; } else { const int c2 = c - NKCH; const int row = c2 / VCPR, ch = c2 % VCPR; vo = (row * LDV + ch * 8) * 2; }
        sr_[i] = *(const bf16x8*)((isk ? (const char*)Kh : (const char*)(Vh - 64 * LDV)) + vo); }
}
#undef PK4
#undef KSWZ
#undef SBAR
}

template <int ABL>
__device__ __forceinline__ void attn_phase(const Ctx& C, unsigned char* ws, const float* gsub) {
    const bf16_t* QM = (const bf16_t*)(ws + WS_QM); const bf16_t* KM = (const bf16_t*)(ws + WS_KM); const bf16_t* VM = (const bf16_t*)(ws + WS_VM);
    const bf16_t* QD = (const bf16_t*)(ws + WS_QD); const bf16_t* KD = (const bf16_t*)(ws + WS_KD); const bf16_t* VD = (const bf16_t*)(ws + WS_VD);
    bf16_t* OA = (bf16_t*)(ws + WS_OA); const float* KMX = (const float*)(ws + WS_KMAX);
    const float lam = *(const float*)(ws + WS_LAM);
    if (!(ABL & 64)) {
        bf16x8 qrM[fa::AU<0>::NQ], srM[fa::AU<0>::NLD];
        { const int bh = C.xcd * 4; fa::attn_prefetch<0>(QM + ((size_t)bh * SEQ + C.slot * 256) * 96, KM + (size_t)bh * SK * 96, VM + (size_t)bh * SK * 64, C.wave, qrM, srM); }
#pragma unroll 1
        for (int r = 0; r < 4; ++r) {
            const int bh = C.xcd * 4 + r, b = bh >> 3, h = bh & 7, qb = C.slot;
            const float kmax = sqrtf(KMX[bh * 2] + KMX[bh * 2 + 1] + KMX[64 + b]);
            const int bn = r < 3 ? bh + 1 : bh;
            fa::attn_unit<0, ABL, 1>(C.lds, QM + ((size_t)bh * SEQ + qb * 256) * 96, KM + (size_t)bh * SK * 96, VM + (size_t)bh * SK * 64,
                             OA + ((size_t)b * SEQ + qb * 256) * 1024 + h * 64, kmax, kmax, lam, gsub, C.wave,
                             QM + ((size_t)bn * SEQ + qb * 256) * 96, KM + (size_t)bn * SK * 96, VM + (size_t)bn * SK * 64, qrM, srM);
        }
    }
    if (!(ABL & 128)) {
        bf16x8 qrD[fa::AU<1>::NQ], srD[fa::AU<1>::NLD];
        { const int bh = C.xcd * 2; fa::attn_prefetch<1>(QD + ((size_t)bh * SEQ + C.slot * 128) * 128, KD + (size_t)bh * SK * 128, VD + (size_t)bh * SK * 128, C.wave, qrD, srD); }
#pragma unroll 1
        for (int r = 0; r < 4; ++r) {
            const int bh = C.xcd * 2 + (r >> 1), b = bh >> 2, h = bh & 3, qb = (r & 1) * 32 + C.slot;
            const float km0 = sqrtf(KMX[68 + bh * 4] + KMX[68 + bh * 4 + 1]), km1 = sqrtf(KMX[68 + bh * 4 + 2] + KMX[68 + bh * 4 + 3]);
            const float qm0 = sqrtf(KMX[132 + bh * 4] + KMX[132 + bh * 4 + 1]), qm1 = sqrtf(KMX[132 + bh * 4 + 2] + KMX[132 + bh * 4 + 3]);
            const bf16_t* Qp = QD + ((size_t)bh * SEQ + qb * 128) * 128; bf16_t* Op = OA + ((size_t)b * SEQ + qb * 128) * 1024 + 512 + h * 128;
            const int rn = r < 3 ? r + 1 : r, bhn = C.xcd * 2 + (rn >> 1), qbn = (rn & 1) * 32 + C.slot;
            const bf16_t* Qn = QD + ((size_t)bhn * SEQ + qbn * 128) * 128; const bf16_t* Kn = KD + (size_t)bhn * SK * 128; const bf16_t* Vn = VD + (size_t)bhn * SK * 128;
            if (fmaxf(qm0 * km0, qm1 * km1) * 1.02f < 100.0f) fa::attn_unit<1, ABL, 0>(C.lds, Qp, KD + (size_t)bh * SK * 128, VD + (size_t)bh * SK * 128, Op, km0, km1, lam, gsub, C.wave, Qn, Kn, Vn, qrD, srD);
            else fa::attn_unit<1, ABL, 2>(C.lds, Qp, KD + (size_t)bh * SK * 128, VD + (size_t)bh * SK * 128, Op, km0, km1, lam, gsub, C.wave, Qn, Kn, Vn, qrD, srD);
        }
    }
    __syncthreads();
}

#if MK_NAIVE_ATTN
template <int MODE>
__global__ __launch_bounds__(256) void naive_attn(const bf16_t* __restrict__ Q, const bf16_t* __restrict__ K, const bf16_t* __restrict__ V, bf16_t* __restrict__ OA,
                                                  const float* __restrict__ lamp, const float* __restrict__ gsub) {
    constexpr int NH = MODE ? 4 : 8, DQK = MODE ? 64 : 96, LDQ = MODE ? 128 : 96, LDK = LDQ, DV = MODE ? 128 : 64, NMAP = MODE ? 2 : 1;
    const int lane = threadIdx.x & 63; const long gw = (long)blockIdx.x * 4 + (threadIdx.x >> 6);
    const int q = (int)(gw % SEQ); const int bh = (int)(gw / SEQ); const int b = bh / NH, h = bh % NH;
    const bf16_t* Qrow = Q + ((size_t)bh * SEQ + q) * LDQ; const bf16_t* Kh = K + (size_t)bh * SK * LDK; const bf16_t* Vh = V + (size_t)bh * SK * DV;
    float res0 = 0.f, res1 = 0.f; const float lam = *lamp;
    for (int mp = 0; mp < NMAP; ++mp) {
        u32x4 qp[DQK / 8];
#pragma unroll
        for (int i = 0; i < DQK / 8; ++i) qp[i] = *(const u32x4*)(Qrow + mp * 64 + 8 * i);
        float m = -1e30f, l = 0.f, acc0 = 0.f, acc1 = 0.f;
        for (int t = 0; t < SK / 64; ++t) {
            const bf16_t* kr = Kh + (size_t)(t * 64 + lane) * LDK + mp * 64; float s = 0.f;
#pragma unroll
            for (int i = 0; i < DQK / 8; ++i) { const u32x4 kv = *(const u32x4*)(kr + 8 * i);
                s += bf_lo(qp[i].x) * bf_lo(kv.x) + bf_hi(qp[i].x) * bf_hi(kv.x) + bf_lo(qp[i].y) * bf_lo(kv.y) + bf_hi(qp[i].y) * bf_hi(kv.y)
                   + bf_lo(qp[i].z) * bf_lo(kv.z) + bf_hi(qp[i].z) * bf_hi(kv.z) + bf_lo(qp[i].w) * bf_lo(kv.w) + bf_hi(qp[i].w) * bf_hi(kv.w); }
            const float mn = fmaxf(m, wave_max(s)); const float alpha = exp2f(m - mn); const float p = exp2f(s - mn);
            l = l * alpha + wave_sum(p); acc0 *= alpha; acc1 *= alpha; m = mn;
            for (int kk = 0; kk < 64; ++kk) { const float pk = __shfl(p, kk); const bf16_t* vr = Vh + (size_t)(t * 64 + kk) * DV;
                acc0 += pk * bf2f(vr[lane]); if (DV == 128) acc1 += pk * bf2f(vr[64 + lane]); }
        }
        const float il = 1.0f / l;
        if (mp == 0) { res0 = acc0 * il; res1 = acc1 * il; } else { res0 -= lam * acc0 * il; res1 -= lam * acc1 * il; }
    }
    if (MODE == 0) { OA[((size_t)b * SEQ + q) * 1024 + h * 64 + lane] = (bf16_t)(cvt_pk_bf16(res0, 0.f) & 0xffffu); }
    else { const float ss = wave_sum(res0 * res0 + res1 * res1); const float rs = (fast_rsq(ss * (1.0f / 128.0f) + EPS)) * (1.0f - LAMBDA_INIT);
        bf16_t* o = OA + ((size_t)b * SEQ + q) * 1024 + 512 + h * 128;
        o[lane] = (bf16_t)(cvt_pk_bf16(res0 * rs * gsub[lane], 0.f) & 0xffffu); o[64 + lane] = (bf16_t)(cvt_pk_bf16(res1 * rs * gsub[64 + lane], 0.f) & 0xffffu); }
}
#endif
__device__ __forceinline__ int invperm64(int d) { const int a = d >> 5, half = (d >> 4) & 1, i = d & 15; return (a * 4 + (i >> 2)) * 8 + half * 4 + (i & 3); }
__device__ __forceinline__ int invperm32(int d) { const int a = d >> 4, half = (d >> 3) & 1, i = d & 7; return (a * 2 + (i >> 2)) * 8 + half * 4 + (i & 3); }
struct MapWin { __device__ __forceinline__ int operator()(int n) const {
    if (n < 384) return n;
    if (n < 416) return 384 + invperm32(n - 384);
    if (n < 1440) { const int isk = n >= 928; const int rel = n - (isk ? 928 : 416); return (isk ? 1024 : 512) + (rel & ~63) + invperm64(rel & 63); }
    if (n < 1952) return 1536 + (n - 1440);
    return 2048 + (n - 1952); } };
struct MapUq { __device__ __forceinline__ int operator()(int n) const { const int h = n / 96, d = n - 96 * h; return d < 64 ? n : h * 96 + 64 + invperm32(d - 64); } };
struct MapId { int off; __device__ __forceinline__ int operator()(int n) const { return off + n; } };
struct MapW13 { int off; __device__ __forceinline__ int operator()(int f) const { return off + (f >> 7) * 256 + (f & 127); } };

struct TrSrc { const float* W; int ldw, k0, n0; };
__device__ __forceinline__ void tr_load(const TrSrc& t, f32x4 (&v)[8], int lane) {
#pragma unroll
    for (int i = 0; i < 8; ++i) v[i] = *(const f32x4*)(t.W + (size_t)(t.k0 + 8 * i + (lane >> 3)) * t.ldw + t.n0 + (lane & 7) * 4);
}
template <class RM>
__device__ __forceinline__ void tr_store(f32x4 (&v)[8], int k0, int n0, bf16_t* WT, int ldt, int kdst0, const float* kscale, RM rm, LAS float* scr, int lane) {
#pragma unroll
    for (int i = 0; i < 8; ++i) { const int kk = 8 * i + (lane >> 3); f32x4 w = v[i]; if (kscale) w = w * kscale[k0 + kk]; LAS float* d = scr + kk * 33 + (lane & 7) * 4;
        d[0] = w[0]; d[1] = w[1]; d[2] = w[2]; d[3] = w[3]; }
    asm volatile("s_waitcnt lgkmcnt(0)" ::: "memory");
    const int c = lane & 7;
#pragma unroll
    for (int j = 0; j < 4; ++j) { const int n = (lane >> 3) + 8 * j; const LAS float* s = scr + (8 * c) * 33 + n;
        u32x4 o; o.x = cvt_pk_bf16(s[0 * 33], s[1 * 33]); o.y = cvt_pk_bf16(s[2 * 33], s[3 * 33]); o.z = cvt_pk_bf16(s[4 * 33], s[5 * 33]); o.w = cvt_pk_bf16(s[6 * 33], s[7 * 33]);
        *(u32x4*)(WT + (size_t)rm(n0 + n) * ldt + kdst0 + k0 + 8 * c) = o; }
    asm volatile("s_waitcnt lgkmcnt(0)" ::: "memory");
}
template <class RM>
__device__ __forceinline__ void tr_item(const float* __restrict__ W, int ldw, int k0, int n0, bf16_t* WT, int ldt, int kdst0, const float* kscale, RM rm, LAS float* scr, int lane) {
    f32x4 v[8]; tr_load(TrSrc{W, ldw, k0, n0}, v, lane); tr_store(v, k0, n0, WT, ldt, kdst0, kscale, rm, scr, lane);
}
namespace p0i { constexpr int I_IN = 16 * 125, I_UQ = 4 * 24, I_UKV = 2 * 32, I_OM = 8 * 32, I_OD = 8 * 32, I_OUT = 16 * 32, I_E = 16 * 16 * 32;
    constexpr int NITEMS = I_IN + I_UQ + I_UKV + I_OM + I_OD + I_OUT + 2 * I_E; }
__device__ __forceinline__ TrSrc p0_item_src(KA A, int it) {
    using namespace p0i; int r = it;
    if (r < I_IN) return TrSrc{A->in[6], NIN, 64 * (r / 125), 32 * (r % 125)}; r -= I_IN;
    if (r < I_UQ) return TrSrc{A->in[8], 768, 64 * (r / 24), 32 * (r % 24)}; r -= I_UQ;
    if (r < I_UKV) return TrSrc{A->in[10], 1024, 64 * (r / 32), 32 * (r % 32)}; r -= I_UKV;
    if (r < I_OM) return TrSrc{A->in[11], 1024, 64 * (r / 32), 32 * (r % 32)}; r -= I_OM;
    if (r < I_OD) return TrSrc{A->in[14], 1024, 64 * (r / 32), 32 * (r % 32)}; r -= I_OD;
    if (r < I_OUT) return TrSrc{A->in[15], 1024, 64 * (r / 32), 32 * (r % 32)}; r -= I_OUT;
    const int which = r / I_E; r -= which * I_E; const int e = r / 512, q = r % 512;
    return TrSrc{(which == 0 ? A->in[20] : A->in[21]) + (size_t)e * 1024 * 1024, 1024, 64 * (q / 32), 32 * (q % 32)};
}
__device__ __forceinline__ void p0_item_store(KA A, unsigned char* ws, int it, f32x4 (&v)[8], LAS float* scr, int lane) {
    using namespace p0i; int r = it;
    if (r < I_IN) { tr_store(v, 64 * (r / 125), 32 * (r % 125), (bf16_t*)(ws + WS_WIN), 1024, 0, nullptr, MapWin{}, scr, lane); return; } r -= I_IN;
    if (r < I_UQ) { tr_store(v, 64 * (r / 24), 32 * (r % 24), (bf16_t*)(ws + WS_WUQ), 256, 0, A->in[7], MapUq{}, scr, lane); return; } r -= I_UQ;
    if (r < I_UKV) { tr_store(v, 64 * (r / 32), 32 * (r % 32), (bf16_t*)(ws + WS_WUKV), 256, 0, A->in[9], MapId{0}, scr, lane); return; } r -= I_UKV;
    if (r < I_OM) { tr_store(v, 64 * (r / 32), 32 * (r % 32), (bf16_t*)(ws + WS_WOC), 1024, 0, nullptr, MapId{0}, scr, lane); return; } r -= I_OM;
    if (r < I_OD) { tr_store(v, 64 * (r / 32), 32 * (r % 32), (bf16_t*)(ws + WS_WOC), 1024, 512, nullptr, MapId{0}, scr, lane); return; } r -= I_OD;
    if (r < I_OUT) { tr_store(v, 64 * (r / 32), 32 * (r % 32), (bf16_t*)(ws + WS_WOUT), 1024, 0, nullptr, MapId{0}, scr, lane); return; } r -= I_OUT;
    const int which = r / I_E; r -= which * I_E; const int e = r / 512, q = r % 512;
    tr_store(v, 64 * (q / 32), 32 * (q % 32), (bf16_t*)(ws + WS_W13), 1024, 0, nullptr, MapW13{e * 2048 + (which ? 128 : 0)}, scr, lane);
}

#ifndef P0_SHARE_BUSY
#define P0_SHARE_BUSY 5
#endif
__device__ __forceinline__ void p0_prologue(const Ctx& C0, KA A, unsigned* modcnt) {
    Ctx C = C0; C.tid = C.wave * 64 + lane_id(); asm volatile("" : "+v"(C.tid)); C.lane = C.tid & 63;
    unsigned char* ws = A->ws;
    const float* cvec = A->in[1]; const float* cctx = A->in[3]; const float* w_ada = A->in[4]; const float* b_ada = A->in[5];
    if (C.vcu < 96) {
        LAS float* sl = (LAS float*)(C.lds + 86016);
        for (int i = C.tid; i < 5 * 1024; i += NTHR) { const float cv = (i < 4096) ? cvec[i] : cctx[i - 4096]; sl[i] = cv * sigmoidf_(cv); }
        __syncthreads();
        const int col = C.vcu * 64 + C.lane; float acc[5] = {0.f, 0.f, 0.f, 0.f, 0.f};
#pragma unroll 32
        for (int k = C.wave * 128; k < C.wave * 128 + 128; ++k) { const float wv = w_ada[(size_t)k * 6144 + col];
#pragma unroll
            for (int r = 0; r < 5; ++r) acc[r] += sl[r * 1024 + k] * wv; }
        LAS float* red = (LAS float*)(C.lds + 73728);
#pragma unroll
        for (int r = 0; r < 5; ++r) red[(C.wave * 5 + r) * 64 + C.lane] = acc[r];
        __syncthreads();
        if (C.tid < 320) { const int r = C.tid >> 6, l = C.tid & 63; float s = 0.f;
#pragma unroll
            for (int w = 0; w < 8; ++w) s += red[(w * 5 + r) * 64 + l];
            ((float*)(ws + WS_MOD))[r * 6144 + C.vcu * 64 + l] = s + b_ada[C.vcu * 64 + l]; }
        asm volatile("s_waitcnt vmcnt(0)" ::: "memory");
        __syncthreads();
        if (modcnt && C.tid == 0) dep_arrive(modcnt);
    }
    if (C.vcu == C.G - 1) {
        if (C.tid < 196) ((unsigned*)(ws + WS_KMAX))[C.tid] = 0u;
        float* rope = (float*)(ws + WS_ROPE);
        for (int i = C.tid; i < 2048; i += NTHR) { const int pos = i >> 4, f = i & 15; const float inv = exp2f(-(float)f * (13.287712379549449f / 16.0f)); const float ang = (float)pos * inv;
            rope[i] = cosf(ang); rope[2048 + i] = sinf(ang); }
        for (int i = C.tid; i < 1024; i += NTHR) { const int pos = i >> 3, f = i & 7; const float inv = exp2f(-(float)f * (13.287712379549449f / 8.0f)); const float ang = (float)pos * inv;
            rope[4096 + i] = cosf(ang); rope[5120 + i] = sinf(ang); }
        if (C.wave == 0) { const float* dl = A->in[12]; const float s1 = wave_sum(dl[C.lane] * dl[64 + C.lane]), s2 = wave_sum(dl[128 + C.lane] * dl[192 + C.lane]);
            if (C.lane == 0) *(float*)(ws + WS_LAM) = expf(s1) - expf(s2) + LAMBDA_INIT; }
    }
    LAS float* scr = (LAS float*)(C.lds + C.wave * 8448);
    {
        constexpr int NBUSY = 97, SHARE_BUSY = P0_SHARE_BUSY;
        constexpr int N_B = NBUSY * NWAVES * SHARE_BUSY;
        const bool busy = C.vcu < 96 || C.vcu == C.G - 1;
        const int widx = busy ? ((C.vcu < 96 ? C.vcu : 96) * NWAVES + C.wave) : ((C.vcu - 96) * NWAVES + C.wave);
        const int stride = busy ? NBUSY * NWAVES : (C.G - NBUSY) * NWAVES;
        const int first = busy ? widx : N_B + widx, end = busy ? N_B : p0i::NITEMS;
        f32x4 v[8];
        if (first < end) tr_load(p0_item_src(A, first), v, C.lane);
        for (int it = first; it < end; it += stride) {
            const int nx = (it + stride < end) ? it + stride : it;
            f32x4 vn[8]; tr_load(p0_item_src(A, nx), vn, C.lane);
            p0_item_store(A, ws, it, v, scr, C.lane);
#pragma unroll
            for (int i = 0; i < 8; ++i) v[i] = vn[i];
        }
    }
    const int gt = C.vcu * NTHR + C.tid, NGT = C.G * NTHR; const u32x4 z4 = {0u, 0u, 0u, 0u};
    for (int i = gt; i < 96 * 128; i += NGT) *(u32x4*)(ws + WS_WIN + (size_t)416 * 2048 + (size_t)i * 16) = z4;
    for (int i = gt; i < 1024 * 16; i += NGT) *(u32x4*)(ws + WS_WUKV + (size_t)(i >> 4) * 512 + 256 + (size_t)(i & 15) * 16) = z4;
}

__device__ __forceinline__ void mod_row(KA A, const float* mod, bf16_t* A1, int r, int lane) {
    const float* src = r < NCTX ? A->in[2] + (size_t)r * 1024 : A->in[0] + (size_t)(r - NCTX) * 1024;
    const float* sh = mod + (r < NCTX ? 4 : ((r - NCTX) >> 13)) * 6144; const float* sc = sh + 1024;
#pragma unroll
    for (int j = 0; j < 4; ++j) { const int d = 4 * lane + 256 * j; const f32x4 v = *(const f32x4*)(src + d), s = *(const f32x4*)(sc + d), h = *(const f32x4*)(sh + d);
        const f32x4 o = v * (s + 1.0f) + h; u32x2 w; w.x = cvt_pk_bf16(o[0], o[1]); w.y = cvt_pk_bf16(o[2], o[3]);
        *(u32x2*)(A1 + (size_t)r * 1024 + d) = w; }
}
__device__ __forceinline__ void p0b_modulate(const Ctx& C0, KA A, int bx, bool ctxsplit, unsigned* modcnt) {
    Ctx C = C0; C.tid = C.wave * 64 + lane_id(); asm volatile("" : "+v"(C.tid)); C.lane = C.tid & 63;
    if (modcnt) { if (C.wave == 0) dep_wait(modcnt, 96u); __syncthreads(); }
    const float* mod = (const float*)(A->ws + WS_MOD); bf16_t* A1 = (bf16_t*)(A->ws + WS_A1);
    if (!ctxsplit) {
        const int gw = C.vcu * NWAVES + C.wave, NGW = C.G * NWAVES;
        f32x4 xin[4];
        { const float* src = gw < NCTX ? A->in[2] + (size_t)gw * 1024 : A->in[0] + (size_t)(gw - NCTX) * 1024;
#pragma unroll
          for (int j = 0; j < 4; ++j) xin[j] = *(const f32x4*)(src + 4 * C.lane + 256 * j); }
        int cm = -1; f32x4 sv1[4], hv[4];
        for (int r = gw; r < MTOT; r += NGW) {
            const int mi = r < NCTX ? 4 : ((r - NCTX) >> 13);
            if (mi != cm) { cm = mi; const float* sh = mod + mi * 6144; const float* sc = sh + 1024;
#pragma unroll
                for (int j = 0; j < 4; ++j) { const int d = 4 * C.lane + 256 * j; sv1[j] = *(const f32x4*)(sc + d) + 1.0f; hv[j] = *(const f32x4*)(sh + d); } }
            f32x4 cur[4];
#pragma unroll
            for (int j = 0; j < 4; ++j) cur[j] = xin[j];
            { const int nr = (r + NGW < MTOT) ? r + NGW : r; const float* src = nr < NCTX ? A->in[2] + (size_t)nr * 1024 : A->in[0] + (size_t)(nr - NCTX) * 1024;
#pragma unroll
              for (int j = 0; j < 4; ++j) xin[j] = *(const f32x4*)(src + 4 * C.lane + 256 * j); }
#pragma unroll
            for (int j = 0; j < 4; ++j) { const int d = 4 * C.lane + 256 * j;
                const f32x4 o = cur[j] * sv1[j] + hv[j]; u32x2 w; w.x = cvt_pk_bf16(o[0], o[1]); w.y = cvt_pk_bf16(o[2], o[3]);
                *(u32x2*)(A1 + (size_t)r * 1024 + d) = w; }
        }
    } else if (bx < 20) {
        const int r0 = (bx / 5) * 256 + C.wave * 32;
        for (int r = r0; r < r0 + 32; ++r) mod_row(A, mod, A1, r, C.lane);
        __threadfence(); __syncthreads();
    } else {
        const int gw = (bx - 20) * NWAVES + C.wave, NGW = (C.G - 20) * NWAVES;
        for (int r = NCTX + gw; r < MTOT; r += NGW) mod_row(A, mod, A1, r, C.lane);
    }
}

__device__ __forceinline__ void p4_ln_router(const Ctx& C0, KA A) {
    Ctx C = C0; C.tid = C.wave * 64 + lane_id(); asm volatile("" : "+v"(C.tid)); C.lane = C.tid & 63;
    bf16_t* X1B = (bf16_t*)(A->ws + WS_X1B); const bf16_t* OL = (const bf16_t*)(A->ws + WS_OL); const float* X = A->in[0]; bf16_t* H2 = (bf16_t*)(A->ws + WS_H2); float* aff = (float*)(A->ws + WS_AFF); const float* mod = (const float*)(A->ws + WS_MOD);
    LAS float* wrt = (LAS float*)C.lds;
    for (int i = C.tid; i < 16384; i += NTHR) wrt[(i & 15) * 1024 + (i >> 4)] = A->in[18][i];
    __syncthreads();
    f32x4 lg[4], lb[4];
#pragma unroll
    for (int j = 0; j < 4; ++j) { lg[j] = *(const f32x4*)(A->in[16] + 4 * C.lane + 256 * j); lb[j] = *(const f32x4*)(A->in[17] + 4 * C.lane + 256 * j); }
    const int gw = C.vcu * NWAVES + C.wave, NGW = C.G * NWAVES;
    f32x4 xin[4]; u32x2 oin[4];
#pragma unroll
    for (int j = 0; j < 4; ++j) { const int d = 4 * C.lane + 256 * j; xin[j] = *(const f32x4*)(X + (size_t)gw * 1024 + d); oin[j] = *(const u32x2*)(OL + (size_t)gw * 1024 + d); }
    int cb = -1; f32x4 sc2p[4], sh2v[4];
    const float rbias = A->in[19][(C.lane >> 2) & 15];
    for (int row = gw; row < NLAT; row += NGW) {
        const int b = row >> 13, n = row & 8191; bf16_t* zr = X1B + (size_t)row * 1024;
        if (b != cb) { cb = b; const float* sh2 = mod + b * 6144 + 3 * 1024; const float* sc2 = mod + b * 6144 + 4 * 1024;
#pragma unroll
            for (int j = 0; j < 4; ++j) { const int d = 4 * C.lane + 256 * j; sc2p[j] = *(const f32x4*)(sc2 + d) + 1.0f; sh2v[j] = *(const f32x4*)(sh2 + d); } }
        f32x4 v[4]; float s = 0.f;
#pragma unroll
        for (int j = 0; j < 4; ++j) { v[j] = xin[j] * ALPHA + (f32x4){bf_lo(oin[j].x), bf_hi(oin[j].x), bf_lo(oin[j].y), bf_hi(oin[j].y)}; s += (v[j][0] + v[j][1]) + (v[j][2] + v[j][3]); }
        { const int nrow = (row + NGW < NLAT) ? row + NGW : row;
#pragma unroll
          for (int j = 0; j < 4; ++j) { const int d = 4 * C.lane + 256 * j; xin[j] = *(const f32x4*)(X + (size_t)nrow * 1024 + d); oin[j] = *(const u32x2*)(OL + (size_t)nrow * 1024 + d); } }
        const float mean = wave_sum(s) * (1.0f / 1024.0f); float s2 = 0.f;
#pragma unroll
        for (int j = 0; j < 4; ++j) { v[j] = v[j] - mean; s2 += sq4(v[j]); }
        const float rstd = fast_rsq(wave_sum(s2) * (1.0f / 1024.0f) + EPS);
        float p[16];
#pragma unroll
        for (int e = 0; e < 16; ++e) p[e] = 0.f;
#pragma unroll
        for (int j = 0; j < 4; ++j) { const int d = 4 * C.lane + 256 * j; const f32x4 x1 = v[j] * rstd * lg[j] + lb[j];
            { u32x2 w1; w1.x = cvt_pk_bf16(x1[0], x1[1]); w1.y = cvt_pk_bf16(x1[2], x1[3]); *(u32x2*)(zr + d) = w1; }
            const f32x4 h = x1 * sc2p[j] + sh2v[j];
            u32x2 w; w.x = cvt_pk_bf16(h[0], h[1]); w.y = cvt_pk_bf16(h[2], h[3]); *(u32x2*)(H2 + (size_t)row * 1024 + d) = w;
#pragma unroll
            for (int e = 0; e < 16; ++e) { const f32x4 wv = *(const LAS f32x4*)(wrt + e * 1024 + d); p[e] += (h[0] * wv[0] + h[1] * wv[1]) + (h[2] * wv[2] + h[3] * wv[3]); if ((e & 3) == 3) asm volatile("" ::: "memory"); } }
        const bool h5 = (C.lane & 32) != 0, h4 = (C.lane & 16) != 0, h3 = (C.lane & 8) != 0, h2b = (C.lane & 4) != 0;
#pragma unroll
        for (int e = 0; e < 8; ++e) { const float keep = h5 ? p[e + 8] : p[e], send = h5 ? p[e] : p[e + 8];
            auto rr = __builtin_amdgcn_permlane32_swap(__float_as_uint(send), __float_as_uint(send), false, false); p[e] = keep + __uint_as_float(h5 ? rr[0] : rr[1]); }
#pragma unroll
        for (int e = 0; e < 4; ++e) { const float keep = h4 ? p[e + 4] : p[e], send = h4 ? p[e] : p[e + 4]; p[e] = keep + swz_xor<16>(send); }
#pragma unroll
        for (int e = 0; e < 2; ++e) { const float keep = h3 ? p[e + 2] : p[e], send = h3 ? p[e] : p[e + 2]; p[e] = keep + swz_xor<8>(send); }
        { const float keep = h2b ? p[1] : p[0], send = h2b ? p[0] : p[1]; p[0] = keep + swz_xor<4>(send); }
        p[0] += swz_xor<2>(p[0]); p[0] += swz_xor<1>(p[0]);
        const int myexp = (C.lane >> 2) & 15;
        const float logit = p[0] + rbias;
        float mx = logit; mx = fmaxf(mx, swz_xor<4>(mx)); mx = fmaxf(mx, swz_xor<8>(mx)); mx = fmaxf(mx, swz_xor<16>(mx));
        { auto rr = __builtin_amdgcn_permlane32_swap(__float_as_uint(mx), __float_as_uint(mx), false, false); mx = fmaxf(__uint_as_float(rr[0]), __uint_as_float(rr[1])); }
        const float ex = expf(logit - mx); float den = ex; den += swz_xor<4>(den); den += swz_xor<8>(den); den += swz_xor<16>(den); den = half_sum(den);
        if ((C.lane & 3) == 0) aff[((size_t)b * 16 + myexp) * SEQ + n] = ex / den;
    }
    __syncthreads();
}

__device__ __forceinline__ unsigned block_incl_scan(unsigned v, LAS unsigned* wtot, int lane, int wave, unsigned& total) {
    unsigned x = v;
#pragma unroll
    for (int o = 1; o < 64; o <<= 1) { const unsigned y = __shfl_up(x, o); if (lane >= o) x += y; }
    if (lane == 63) wtot[wave] = x;
    __syncthreads();
    unsigned off = 0, tot = 0;
#pragma unroll
    for (int w = 0; w < 8; ++w) { const unsigned t = wtot[w]; off += (w < wave) ? t : 0u; tot += t; }
    __syncthreads();
    total = tot; return x + off;
}
__device__ __forceinline__ void p5_topk(const Ctx& C0, KA A) {
    Ctx C = C0; C.tid = C.wave * 64 + lane_id(); asm volatile("" : "+v"(C.tid)); C.lane = C.tid & 63;
    const float* aff = (const float*)(A->ws + WS_AFF); int* idx = (int*)(A->ws + WS_IDX); float* gsel = (float*)(A->ws + WS_GSEL); short* slotmap = (short*)(A->ws + WS_SLOT);
    LAS unsigned* hist = (LAS unsigned*)C.lds; LAS unsigned* wtot = hist + 4096; LAS unsigned* res = wtot + 16;
    if (C.vcu >= NB * NE) {
        LAS float* scr = (LAS float*)(C.lds + C.wave * 8448); unsigned char* ws = A->ws;
        const int gw2 = (C.vcu - NB * NE) * NWAVES + C.wave, NGW2 = (C.G - NB * NE) * NWAVES;
        f32x4 v[8]; const float* w2 = A->in[22];
        if (gw2 < 16 * 512) tr_load(TrSrc{w2 + (size_t)(gw2 / 512) * 1024 * 1024, 1024, 64 * ((gw2 % 512) / 32), 32 * (gw2 % 32)}, v, C.lane);
        for (int r = gw2; r < 16 * 512; r += NGW2) { const int e = r / 512, q = r % 512;
            const int rn = (r + NGW2 < 16 * 512) ? r + NGW2 : r; f32x4 vn[8];
            tr_load(TrSrc{w2 + (size_t)(rn / 512) * 1024 * 1024, 1024, 64 * ((rn % 512) / 32), 32 * (rn % 32)}, vn, C.lane);
            tr_store(v, 64 * (q / 32), 32 * (q % 32), (bf16_t*)(ws + WS_W2T), 1024, 0, nullptr, MapId{e * 1024}, scr, C.lane);
#pragma unroll
            for (int i = 0; i < 8; ++i) v[i] = vn[i]; }
    }
    for (int be = C.vcu; be < NB * NE; be += C.G) {
        const int b = be >> 4, e = be & 15; unsigned key[16];
#pragma unroll
        for (int j = 0; j < 4; ++j) { const u32x4 k4 = *(const u32x4*)(aff + (size_t)be * SEQ + C.tid * 16 + 4 * j); key[4 * j] = k4.x; key[4 * j + 1] = k4.y; key[4 * j + 2] = k4.z; key[4 * j + 3] = k4.w; }
        unsigned prefix = 0u, mask = 0u, need = CAP;
#pragma unroll
        for (int pass = 0; pass < 3; ++pass) {
            const int shift = pass == 0 ? 20 : (pass == 1 ? 8 : 0), nb = pass == 2 ? 256 : 4096;
            for (int i = C.tid; i < nb; i += NTHR) hist[i] = 0u;
            __syncthreads();
#pragma unroll
            for (int k = 0; k < 16; ++k) if ((key[k] & mask) == prefix) atomicAdd((unsigned*)(hist + ((key[k] >> shift) & (unsigned)(nb - 1))), 1u);
            __syncthreads();
            const int per = nb / NTHR > 0 ? nb / NTHR : 1; const int lo = C.tid * per; unsigned s = 0u;
            if (lo < nb) for (int d = 0; d < per; ++d) s += hist[lo + d];
            unsigned total; const unsigned incl = block_incl_scan(s, wtot, C.lane, C.wave, total);
            unsigned running = total - incl;
            if (lo < nb) for (int d = per - 1; d >= 0; --d) { const unsigned hv = hist[lo + d]; if (running < need && need <= running + hv) { res[0] = (unsigned)(lo + d); res[1] = running; } running += hv; }
            __syncthreads();
            prefix |= res[0] << shift; mask |= (unsigned)(nb - 1) << shift; need -= res[1];
            __syncthreads();
        }
        const unsigned T = prefix; unsigned cg = 0u, ce = 0u;
#pragma unroll
        for (int k = 0; k < 16; ++k) { cg += key[k] > T ? 1u : 0u; ce += key[k] == T ? 1u : 0u; }
        unsigned total; const unsigned packed = cg | (ce << 16); const unsigned excl = block_incl_scan(packed, wtot, C.lane, C.wave, total) - packed;
        unsigned eqr = excl >> 16; unsigned slot = (excl & 0xffffu) + (eqr < need ? eqr : need);
#pragma unroll
        for (int k = 0; k < 16; ++k) { const int n = C.tid * 16 + k; const bool iseq = key[k] == T; const bool sel = key[k] > T || (iseq && eqr < need); eqr += iseq ? 1u : 0u;
            slotmap[(size_t)be * SEQ + n] = sel ? (short)slot : (short)-1;
            if (sel) { idx[be * CAP + slot] = n; gsel[be * CAP + slot] = __uint_as_float(key[k]); ++slot; } }
        __syncthreads();
    }
}
__device__ __forceinline__ void p5b_gather(const Ctx& C0, KA A) {
    Ctx C = C0; C.tid = C.wave * 64 + lane_id(); asm volatile("" : "+v"(C.tid)); C.lane = C.tid & 63;
    const int* idx = (const int*)(A->ws + WS_IDX); const bf16_t* H2 = (const bf16_t*)(A->ws + WS_H2); bf16_t* XE = (bf16_t*)(A->ws + WS_XE);
    const int gw = C.vcu * NWAVES + C.wave, NGW = C.G * NWAVES;
    for (int r = gw; r < NB * NE * CAP; r += NGW) { const int b = r >> 14; const int n = idx[r];
        const bf16_t* s = H2 + ((size_t)b * SEQ + n) * 1024; bf16_t* d = XE + (size_t)r * 1024;
        const u32x4 v0 = *(const u32x4*)(s + 8 * C.lane), v1 = *(const u32x4*)(s + 512 + 8 * C.lane);
        *(u32x4*)(d + 8 * C.lane) = v0; *(u32x4*)(d + 512 + 8 * C.lane) = v1; }
}
__device__ __forceinline__ void p8_final(const Ctx& C0, KA A) {
    Ctx C = C0; C.tid = C.wave * 64 + lane_id(); asm volatile("" : "+v"(C.tid)); C.lane = C.tid & 63;
    float* OUT = A->out; const bf16_t* X1B = (const bf16_t*)(A->ws + WS_X1B); const bf16_t* YE = (const bf16_t*)(A->ws + WS_YE); const short* slotmap = (const short*)(A->ws + WS_SLOT); const float* mod = (const float*)(A->ws + WS_MOD);
    f32x4 lg[4], lb[4];
#pragma unroll
    for (int j = 0; j < 4; ++j) { lg[j] = *(const f32x4*)(A->in[23] + 4 * C.lane + 256 * j); lb[j] = *(const f32x4*)(A->in[24] + 4 * C.lane + 256 * j); }
    const int gw = C.vcu * NWAVES + C.wave, NGW = C.G * NWAVES;
    u32x2 xv[4]; int myslot;
    { const int row = gw; const int b = row >> 13;
#pragma unroll
      for (int j = 0; j < 4; ++j) xv[j] = *(const u32x2*)(X1B + (size_t)row * 1024 + 4 * C.lane + 256 * j);
      myslot = (int)slotmap[((size_t)b * 16 + (C.lane & 15)) * SEQ + (row & (SEQ - 1))]; }
    f32x4 ov[4]; float* op = nullptr; int cb = -1; f32x4 gg[4];
#define P8_FLUSH() do { if (op) { _Pragma("unroll") for (int j = 0; j < 4; ++j) *(f32x4*)(op + 4 * C.lane + 256 * j) = ov[j]; op = nullptr; } } while (0)
    for (int row = gw; row < NLAT; row += NGW) {
        const int b = row >> 13; float* xr = OUT + (size_t)row * 1024;
        const int nrow = (row + NGW < NLAT) ? row + NGW : row; const int nb = nrow >> 13;
        u32x2 nxv[4];
#pragma unroll
        for (int j = 0; j < 4; ++j) nxv[j] = *(const u32x2*)(X1B + (size_t)nrow * 1024 + 4 * C.lane + 256 * j);
        const int nslot = (int)slotmap[((size_t)nb * 16 + (C.lane & 15)) * SEQ + (nrow & (SEQ - 1))];
        if (b != cb) { cb = b; const float* g2 = mod + b * 6144 + 5 * 1024;
#pragma unroll
            for (int j = 0; j < 4; ++j) gg[j] = *(const f32x4*)(g2 + 4 * C.lane + 256 * j); }
        f32x4 mo[4];
#pragma unroll
        for (int j = 0; j < 4; ++j) mo[j] = (f32x4){0.f, 0.f, 0.f, 0.f};
        unsigned m = (unsigned)(__ballot(myslot >= 0) & 0xffffull);
        while (m) {
            const int e0 = __builtin_ctz(m); m &= m - 1u; const bool two = m != 0u; const int e1 = two ? __builtin_ctz(m) : e0; if (two) m &= m - 1u;
            const bf16_t* y0 = YE + ((size_t)(b * 16 + e0) * CAP + __shfl(myslot, e0)) * 1024; const bf16_t* y1 = YE + ((size_t)(b * 16 + e1) * CAP + __shfl(myslot, e1)) * 1024;
            u32x2 w0[4], w1[4];
#pragma unroll
            for (int j = 0; j < 4; ++j) { w0[j] = *(const u32x2*)(y0 + 4 * C.lane + 256 * j); w1[j] = *(const u32x2*)(y1 + 4 * C.lane + 256 * j); }
            P8_FLUSH();
            const float k1 = two ? 1.0f : 0.0f;
#pragma unroll
            for (int j = 0; j < 4; ++j) mo[j] += (f32x4){bf_lo(w0[j].x), bf_hi(w0[j].x), bf_lo(w0[j].y), bf_hi(w0[j].y)} + (f32x4){bf_lo(w1[j].x), bf_hi(w1[j].x), bf_lo(w1[j].y), bf_hi(w1[j].y)} * k1;
        }
        P8_FLUSH();
        f32x4 v[4]; float s = 0.f;
#pragma unroll
        for (int j = 0; j < 4; ++j) { v[j] = (f32x4){bf_lo(xv[j].x), bf_hi(xv[j].x), bf_lo(xv[j].y), bf_hi(xv[j].y)} * ALPHA + gg[j] * mo[j]; s += (v[j][0] + v[j][1]) + (v[j][2] + v[j][3]); }
        const float mean = wave_sum(s) * (1.0f / 1024.0f); float s2 = 0.f;
#pragma unroll
        for (int j = 0; j < 4; ++j) { v[j] = v[j] - mean; s2 += sq4(v[j]); }
        const float rstd = fast_rsq(wave_sum(s2) * (1.0f / 1024.0f) + EPS);
#pragma unroll
        for (int j = 0; j < 4; ++j) ov[j] = v[j] * rstd * lg[j] + lb[j];
        op = xr;
#pragma unroll
        for (int j = 0; j < 4; ++j) xv[j] = nxv[j];
        myslot = nslot;
    }
    P8_FLUSH();
#undef P8_FLUSH
}
#define XB_TMO      128
#define XB_XCNT(j)  (256  + 64 * (j))
#define XB_XSUB(j)  (1280 + 64 * (j))
#define XB_XGEN(j)  (2304 + 64 * (j))
#define XB_TOP      3328
#define XB_TOPGEN   3392
#define XB_P0B      3520
#define XB_MOD      3552
#define XCD_BAR_WORDS 3584
#define XB_SPIN_CAP (1u << 18)
#ifndef MK_SPLIT01
#define MK_SPLIT01 MK_ONE_LAUNCH
#endif
#ifndef MK_SPLIT23
#define MK_SPLIT23 MK_ONE_LAUNCH
#endif
__device__ __forceinline__ unsigned xb_ld(unsigned* p)              { return __hip_atomic_load(p, __ATOMIC_RELAXED, __HIP_MEMORY_SCOPE_AGENT); }
__device__ __forceinline__ unsigned xb_add(unsigned* p, unsigned v) { return __hip_atomic_fetch_add(p, v, __ATOMIC_RELAXED, __HIP_MEMORY_SCOPE_AGENT); }
__device__ __forceinline__ unsigned xb_xcc_id() { return (unsigned)__builtin_amdgcn_s_getreg((3 << 11) | 20) & 0xFu; }
#define XB_SPIN(cond, bar) do { unsigned _sp = 0; while (cond) { __builtin_amdgcn_s_sleep(1); \
    if ((++_sp & 255u) == 0u) { if (xb_ld(&(bar)[XB_TMO])) break; if (_sp > XB_SPIN_CAP) { atomicAdd(&(bar)[XB_TMO], 1u); break; } } } } while (0)
struct XcdBarrier { unsigned* bar; unsigned x; volatile LAS unsigned* st; int wave; };
__device__ __forceinline__ XcdBarrier xcd_barrier_post(unsigned* bar, volatile LAS unsigned* st, int wave) {
    XcdBarrier b; b.bar = bar; b.x = xb_xcc_id(); b.st = st; b.wave = wave;
    if (wave == 0 && lane_id() == 0) (void)xb_add(&bar[XB_XCNT(b.x)], 1u);
    return b;
}
__device__ __forceinline__ void xcd_barrier_complete(unsigned* bar, unsigned x, unsigned& nloc, unsigned& nx) {
    const unsigned G = gridDim.x;
    unsigned sum, cnt, mine, sp = 0u;
    for (;;) {
        sum = 0u; cnt = 0u; mine = 0u;
#pragma unroll
        for (unsigned j = 0; j < 16; ++j) { const unsigned c = xb_ld(&bar[XB_XCNT(j)]); sum += c; cnt += (c > 0u) ? 1u : 0u; mine = (j == x) ? c : mine; }
        if (sum == G) break;
        __builtin_amdgcn_s_sleep(1);
        if ((++sp & 255u) == 0u) { if (xb_ld(&bar[XB_TMO])) break; if (sp > XB_SPIN_CAP) { atomicAdd(&bar[XB_TMO], 1u); break; } }
    }
    nloc = mine > 0u ? mine : 1u; nx = cnt > 0u ? cnt : 1u;
}
__device__ __forceinline__ void xcd_barrier(const XcdBarrier& b) {
    asm volatile("s_waitcnt vmcnt(0)" ::: "memory");
    __syncthreads();
    if (b.wave == 0 && lane_id() == 0) {
        unsigned* bar = b.bar;
        __builtin_amdgcn_s_waitcnt(0);
        unsigned nloc = b.st[0], nx = b.st[1];
        if (nloc == 0u) { xcd_barrier_complete(bar, b.x, nloc, nx); b.st[0] = nloc; b.st[1] = nx; }
        const unsigned old = xb_add(&bar[XB_XSUB(b.x)], 1u);
        const unsigned gen = old / nloc;
        if (old + 1u == (gen + 1u) * nloc) {
            __builtin_amdgcn_fence(__ATOMIC_RELEASE, "agent");
            asm volatile("s_waitcnt vmcnt(0)" ::: "memory");
            const unsigned og = xb_add(&bar[XB_TOP], 1u);
            const unsigned tg = og / nx;
            if (og + 1u == (tg + 1u) * nx) xb_add(&bar[XB_TOPGEN], 1u);
            else XB_SPIN(xb_ld(&bar[XB_TOPGEN]) == tg, bar);
            __builtin_amdgcn_fence(__ATOMIC_ACQUIRE, "agent");
            xb_add(&bar[XB_XGEN(b.x)], 1u);
            asm volatile("s_waitcnt vmcnt(0)" ::: "memory");
        } else {
            XB_SPIN(xb_ld(&bar[XB_XGEN(b.x)]) == gen, bar);
            __builtin_amdgcn_fence(__ATOMIC_ACQUIRE, "agent");
            asm volatile("s_waitcnt vmcnt(0)" ::: "memory");
        }
    }
    __syncthreads();
}

#ifndef MK_CTX_IN_MOD
#define MK_CTX_IN_MOD 0
#endif
__device__ __forceinline__ void ph_gemm1(const Ctx& C, KA A, int bx, int ctxmode) {
    unsigned char* ws = A->ws; const float* rope = (const float*)(ws + WS_ROPE);
    Sched1 S{C.G, bx, (const char*)(ws + WS_A1), (const char*)(ws + WS_WIN), ctxmode};
    {
        const int tid = C.wave * 64 + lane_id();
        ((LAS u32x4*)(C.lds + 131072))[tid] = ((const u32x4*)rope)[tid]; ((LAS u32x4*)(C.lds + 131072))[tid + 512] = ((const u32x4*)rope)[tid + 512]; ((LAS u32x4*)(C.lds + 131072))[tid + 1024] = ((const u32x4*)rope)[tid + 1024];
        __syncthreads();
    }
    Epi1 E{(bf16_t*)(ws + WS_P0B), (float*)(ws + WS_SSQ), (bf16_t*)(ws + WS_KR), (bf16_t*)(ws + WS_QD), (bf16_t*)(ws + WS_KD), (bf16_t*)(ws + WS_VD), (bf16_t*)A->out, rope, (unsigned*)(ws + WS_KMAX), (const LAS float*)(C.lds + 131072),
           ctxmode == 3 ? (unsigned*)(ws + WS_CTL) + XB_P0B : nullptr};
    pg8::gemm_phase(C.wave, C.lds, pg8::Gemm{1024, 1024, 1024}, S, E);
}
__device__ __forceinline__ void ph_upproj(const Ctx& C, KA A, int bx, bool split) {
    unsigned char* ws = A->ws; const float* rope = (const float*)(ws + WS_ROPE);
    if (split) {
        if (C.wave == 0) { unsigned* bar = (unsigned*)(ws + WS_CTL);
            if (lane_id() == 0) XB_SPIN(xb_ld(&bar[XB_P0B]) < 260u, bar);
            __builtin_amdgcn_fence(__ATOMIC_ACQUIRE, "agent"); }
    }
    {
        const int tid = C.wave * 64 + lane_id();
        ((LAS u32x4*)(C.lds + 131072))[tid] = ((const u32x4*)(rope + 4096))[tid];
        __syncthreads();
    }
    SchedUQ Sq{C.G, bx, (const char*)(ws + WS_P0B), (const char*)(ws + WS_WUQ)}; SchedUKV Sk{C.G, bx, (const char*)(ws + WS_P0B), (const char*)(ws + WS_WUKV)};
    SchedU S{Sq, Sk, split ? C.G - 20 : C.G, split ? bx - 20 : bx};
    EpiU E{EpiUQ{(const float*)(ws + WS_SSQ), (bf16_t*)(ws + WS_QM), (const LAS float*)(C.lds + 131072)}, EpiUKV{(const float*)(ws + WS_SSQ), (const bf16_t*)(ws + WS_KR), (bf16_t*)(ws + WS_KM), (bf16_t*)(ws + WS_VM), (unsigned*)(ws + WS_KMAX)}};
    pg8::gemm_phase(C.wave, C.lds, pg8::Gemm{256, 512, 256}, S, E);
}
__device__ __forceinline__ void ph_y(const Ctx& C, KA A, int bx) {
    unsigned char* ws = A->ws;
    SchedY S{C.G, bx, (const char*)(ws + WS_OA), (const char*)(ws + WS_WOC)}; EpiY E{(const bf16_t*)A->out, (bf16_t*)(ws + WS_Y)};
    pg8::gemm_phase(C.wave, C.lds, pg8::Gemm{512, 1024, 1024}, S, E);
}
__device__ __forceinline__ void ph_z(const Ctx& C, KA A, int bx) {
    unsigned char* ws = A->ws;
    SchedZ S{C.G, bx, (const char*)(ws + WS_Y), (const char*)(ws + WS_WOUT)}; EpiZ E{(const float*)(ws + WS_MOD), (bf16_t*)(ws + WS_OL)};
    pg8::gemm_phase(C.wave, C.lds, pg8::Gemm{1024, 1024, 1024}, S, E);
}
__device__ __forceinline__ void ph_moe1(const Ctx& C, KA A, int abl = 0) {
    unsigned char* ws = A->ws;
    SchedM1 S{C.xcd, C.slot, (const char*)(ws + WS_H2), (const char*)(ws + WS_W13)}; EpiM1 E{(bf16_t*)(ws + WS_HID), abl};
    LAS int* rowsL = (LAS int*)(C.lds + 131072); const int* idx = (const int*)(ws + WS_IDX);
    { int t_ = C.wave * 64 + lane_id(); asm volatile("" : "+v"(t_));
#pragma unroll
      for (int i = 0; i < 4; ++i) { const int q = t_ + 512 * i; Unit u; S.next(q >> 8, u); rowsL[q] = idx[u.pm * 256 + (q & 255)]; } }
    __syncthreads();
    pg8::gemm_phase<EpiM1, SchedM1, true>(C.wave, C.lds, pg8::Gemm{1024, 1024, 1024}, S, E, rowsL);
}
__device__ __forceinline__ void ph_moe2(const Ctx& C, KA A) {
    unsigned char* ws = A->ws;
    SchedM2 S{C.xcd, C.slot, (const char*)(ws + WS_HID), (const char*)(ws + WS_W2T)}; EpiM2 E{(const float*)(ws + WS_GSEL), (bf16_t*)(ws + WS_YE)};
    pg8::gemm_phase(C.wave, C.lds, pg8::Gemm{1024, 1024, 1024}, S, E);
}

constexpr int NPHASE = 13;
#ifdef DBG_UBENCH
#ifndef DBG_UBN
#define DBG_UBN 4096
#endif
__device__ __forceinline__ void dbg_ubench(unsigned char* wsb) {
    float x[8]; const int l = lane_id();
#pragma unroll
    for (int i = 0; i < 8; ++i) x[i] = -1.0f - 0.001f * (float)(l + i);
    f32x16 acc = {}; bf16x8 a, b;
#pragma unroll
    for (int i = 0; i < 8; ++i) { a[i] = (short)(0x3c00 + l); b[i] = (short)(0x3c00 + i); }
#pragma unroll 1
    for (int it = 0; it < DBG_UBN; ++it) {
        if (DBG_UBENCH == 1) {
#pragma unroll
            for (int i = 0; i < 8; ++i) x[i] = __builtin_amdgcn_exp2f(x[i]) - 1.5f;
        } else if (DBG_UBENCH == 2) {
#pragma unroll
            for (int i = 0; i < 8; ++i) { x[i] = x[i] + 1.25f; x[i] = x[i] - 1.5f; }
        } else if (DBG_UBENCH == 6) {
#pragma unroll
            for (int i = 0; i < 8; ++i) { unsigned xi = __float_as_uint(x[i]); asm volatile("v_exp_f16_e32 %0, %0" : "+v"(xi)); x[i] = __uint_as_float(xi); }
#pragma unroll
            for (int i = 0; i < 8; ++i) x[i] = x[i] - 1.5f;
        } else if (DBG_UBENCH == 7) {
#pragma unroll
            for (int i = 0; i < 8; ++i) { asm volatile("v_dot2_f32_f16 %0, %1, %1, %0" : "+v"(x[i]) : "v"(__float_as_uint(x[(i + 1) & 7]))); }
        } else if (DBG_UBENCH == 3) {
            acc = __builtin_amdgcn_mfma_f32_32x32x16_bf16(a, b, acc, 0, 0, 0); acc = __builtin_amdgcn_mfma_f32_32x32x16_bf16(b, a, acc, 0, 0, 0);
        } else if (DBG_UBENCH == 4) {
            acc = __builtin_amdgcn_mfma_f32_32x32x16_bf16(a, b, acc, 0, 0, 0);
#pragma unroll
            for (int i = 0; i < 4; ++i) x[i] = __builtin_amdgcn_exp2f(x[i]) - 1.5f;
            acc = __builtin_amdgcn_mfma_f32_32x32x16_bf16(b, a, acc, 0, 0, 0);
#pragma unroll
            for (int i = 4; i < 8; ++i) x[i] = __builtin_amdgcn_exp2f(x[i]) - 1.5f;
        } else {
            acc = __builtin_amdgcn_mfma_f32_32x32x16_bf16(a, b, acc, 0, 0, 0);
#pragma unroll
            for (int i = 0; i < 4; ++i) { x[i] = x[i] + 1.25f; x[i] = x[i] - 1.5f; }
            acc = __builtin_amdgcn_mfma_f32_32x32x16_bf16(b, a, acc, 0, 0, 0);
#pragma unroll
            for (int i = 4; i < 8; ++i) { x[i] = x[i] + 1.25f; x[i] = x[i] - 1.5f; }
        }
    }
    float s = 0.f;
#pragma unroll
    for (int i = 0; i < 8; ++i) s += x[i];
#pragma unroll
    for (int i = 0; i < 16; ++i) s += acc[i];
    if (s == 123.456f) *(float*)(wsb + WS_CTL + 65536) = s;
}
#endif

__global__ void __launch_bounds__(NTHR, 2) mk(Args A_) {
    extern __shared__ __attribute__((aligned(16))) unsigned char lds_raw[];
    Ctx C; C.lds = (LAS unsigned char*)lds_raw; C.lds_g = lds_raw;
    C.tid = threadIdx.x; C.lane = 0; C.wave = __builtin_amdgcn_readfirstlane(C.tid >> 6);
    C.G = gridDim.x; { const int bx = blockIdx.x; C.xcd = bx & 7; C.slot = bx >> 3; C.vcu = (bx & 7) * (C.G >> 3) + (bx >> 3); }
    const int lo = A_.ph_lo, hi = A_.ph_hi;
#define A kargs()
#define ws (kargs()->ws)
#if MK_ONE_LAUNCH
    volatile LAS unsigned* bst = (volatile LAS unsigned*)(C.lds + LDS_BYTES - 64);
    if (threadIdx.x < 2) bst[threadIdx.x] = 0u;
    __syncthreads();
    const XcdBarrier xbar = xcd_barrier_post((unsigned*)(ws + WS_CTL), bst, C.wave);
#ifndef MK_CG_SEAM0
#define MK_CG_SEAM0 0
#endif

#define SEAM(k) do { if (lo <= (k) && (k) + 1 < hi) { if (MK_CG_SEAM0 && (k) == 0) cg::this_grid().sync(); else xcd_barrier(xbar); } } while (0)
#else
#define SEAM(k) do { } while (0)
#endif
#ifndef DBG_ONLY
#define DBG_ONLY -1
#endif
#ifndef DBG_SKIP_MASK
#define DBG_SKIP_MASK 0
#endif
#define IN(k) ((DBG_ONLY < 0 || DBG_ONLY == (k)) && !((DBG_SKIP_MASK >> (k)) & 1) && lo <= (k) && (k) < hi)
#ifndef DBG_REPEAT
#define DBG_REPEAT -1
#endif
#if MK_ONE_LAUNCH
#ifndef DBG_REPN
#define DBG_REPN 1
#endif
#define RUN(k, call) do { if (IN(k)) { if (DBG_REPEAT == (k)) { _Pragma("unroll 1") for (int r_ = 0; r_ <= DBG_REPN; ++r_) { if (r_) xcd_barrier(xbar); call; } } else { call; } } } while (0)
#else
#define RUN(k, call) do { if (IN(k)) { call; } } while (0)
#endif
    const int bx = blockIdx.x;
#ifdef DBG_UBENCH
    if (IN(0)) dbg_ubench(ws);
#endif
#if MK_SPLIT01
    RUN(0, p0_prologue(C, A, (unsigned*)(ws + WS_CTL) + XB_MOD));
#define MODCNT ((unsigned*)(ws + WS_CTL) + XB_MOD)
#else
    RUN(0, p0_prologue(C, A, nullptr)); SEAM(0);
#define MODCNT ((unsigned*)nullptr)
#endif
#if MK_CTX_IN_MOD
    RUN(1, (p0b_modulate(C, A, bx, true, MODCNT), ph_gemm1(C, A, bx, 1))); SEAM(1);
    RUN(2, ph_gemm1(C, A, bx, 0)); SEAM(2);
#else
    RUN(1, p0b_modulate(C, A, bx, false, MODCNT)); SEAM(1);
#if defined(DBG_PHCLK) && MK_ONE_LAUNCH
    if (IN(2)) { const unsigned long long t0 = __builtin_amdgcn_s_memtime(), r0 = __builtin_amdgcn_s_memrealtime();
        ph_gemm1(C, A, bx, 2);
        const unsigned long long t1 = __builtin_amdgcn_s_memtime(), r1 = __builtin_amdgcn_s_memrealtime();
        if (blockIdx.x == 0) { const unsigned long long mhz = (t1 - t0) * 100ull / (r1 - r0 + 1ull); const unsigned long long until = r1 + mhz * 100ull;
            while (__builtin_amdgcn_s_memrealtime() < until) __builtin_amdgcn_s_sleep(8); } }
    SEAM(2);
#else
#if MK_SPLIT23
    RUN(2, ph_gemm1(C, A, bx, 3));
#else
    RUN(2, ph_gemm1(C, A, bx, 2)); SEAM(2);
#endif
#endif
#endif
    RUN(3, ph_upproj(C, A, bx, MK_SPLIT23 != 0)); SEAM(3);
#if !MK_NAIVE_ATTN
#if defined(DBG_CLOCK) && MK_ONE_LAUNCH
    if (IN(4)) {
        const unsigned long long t0 = __builtin_amdgcn_s_memtime(), r0 = __builtin_amdgcn_s_memrealtime();
        attn_phase<0>(C, ws, A->in[13]);
        const unsigned long long t1 = __builtin_amdgcn_s_memtime(), r1 = __builtin_amdgcn_s_memrealtime();
        if (blockIdx.x == 0) { const unsigned long long mhz = (t1 - t0) * 100ull / (r1 - r0 + 1ull); const unsigned long long until = r1 + mhz * 100ull;
            while (__builtin_amdgcn_s_memrealtime() < until) __builtin_amdgcn_s_sleep(8); }
    }
#elif defined(DBG_ABL) && MK_ONE_LAUNCH
    if (IN(4)) { attn_phase<DBG_ABL>(C, ws, A->in[13]); xcd_barrier(xbar); attn_phase<0>(C, ws, A->in[13]); }
#else
    RUN(4, attn_phase<0>(C, ws, A->in[13]));
#endif
#endif
    SEAM(4);
    RUN(5, ph_y(C, A, bx)); SEAM(5);
    RUN(6, ph_z(C, A, bx)); SEAM(6);
    RUN(7, p4_ln_router(C, A)); SEAM(7);
    RUN(8, p5_topk(C, A)); SEAM(8);
#if defined(DBG_M1ABL) && MK_ONE_LAUNCH
    if (IN(10)) { ph_moe1(C, A, DBG_M1ABL); xcd_barrier(xbar); ph_moe1(C, A, 0); } SEAM(10);
#else
    RUN(10, ph_moe1(C, A)); SEAM(10);
#endif
    RUN(11, ph_moe2(C, A)); SEAM(11);
    RUN(12, p8_final(C, A));
#undef RUN
#undef A
#undef ws
#undef IN
#undef SEAM
}

#ifdef DBG_COPY_OFF
__global__ void dbg_copy(u32x4* dst, const u32x4* src, size_t n16) { for (size_t i = blockIdx.x * 256ull + threadIdx.x; i < n16; i += gridDim.x * 256ull) dst[i] = src[i]; }
#endif
extern "C" void kernel_launch(void* const* d_in, const int* in_sizes, int n_in, void* d_out, int out_size, void* d_ws, size_t ws_size, hipStream_t stream) {
    static int ready = 0;
    if (ready == 0) {
        if (n_in != 25 || in_sizes[0] != NLAT * DM || out_size != NLAT * DM || ws_size < WS_NEED) {
            fprintf(stderr, "kernel_launch: unexpected shapes (n_in %d, x %d, out %d, ws %zu; need ws >= %zu)\n", n_in, n_in > 0 ? in_sizes[0] : -1, out_size, ws_size, (size_t)WS_NEED); ready = -1; return; }
        if (hipFuncSetAttribute((const void*)mk, hipFuncAttributeMaxDynamicSharedMemorySize, LDS_BYTES) != hipSuccess) { fprintf(stderr, "kernel_launch: hipFuncSetAttribute failed\n"); ready = -1; return; }
        int dev = 0, cus = 0, per_cu = 0;
        (void)hipGetDevice(&dev); (void)hipDeviceGetAttribute(&cus, hipDeviceAttributeMultiprocessorCount, dev);
        (void)hipOccupancyMaxActiveBlocksPerMultiprocessor(&per_cu, (const void*)mk, NTHR, LDS_BYTES);
        if (cus != 256 || per_cu < 1) { fprintf(stderr, "kernel_launch: needs 256 CUs with one resident workgroup each (cus %d, per_cu %d)\n", cus, per_cu); ready = -1; return; }
        ready = 1;
    }
    if (ready < 0) return;
    Args a{};
    for (int i = 0; i < 25; ++i) a.in[i] = (const float*)d_in[i];
    a.out = (float*)d_out; a.ws = (unsigned char*)d_ws;
#if MK_ONE_LAUNCH
    a.ph_lo = 0; a.ph_hi = NPHASE;
    if (hipMemsetAsync((char*)d_ws + WS_CTL, 0, XCD_BAR_WORDS * 4, stream) != hipSuccess) { fprintf(stderr, "kernel_launch: memset of the barrier words failed\n"); return; }
    void* kargs[] = {&a};
    hipError_t e = hipLaunchCooperativeKernel((const void*)mk, dim3(256), dim3(NTHR), kargs, LDS_BYTES, stream);
    if (e != hipSuccess) fprintf(stderr, "kernel_launch: cooperative launch failed: %s\n", hipGetErrorString(e));
#else
#ifndef DBG_LAST_PHASE
#define DBG_LAST_PHASE 99
#endif
    for (int ph = 0; ph < NPHASE && ph <= DBG_LAST_PHASE; ++ph) {
#if MK_NAIVE_ATTN
        if (ph == 4) {
            unsigned char* ws = (unsigned char*)d_ws;
            naive_attn<0><<<NB * 8 * SEQ / 4, 256, 0, stream>>>((const bf16_t*)(ws + WS_QM), (const bf16_t*)(ws + WS_KM), (const bf16_t*)(ws + WS_VM), (bf16_t*)(ws + WS_OA), (const float*)(ws + WS_LAM), (const float*)d_in[13]);
            naive_attn<1><<<NB * 4 * SEQ / 4, 256, 0, stream>>>((const bf16_t*)(ws + WS_QD), (const bf16_t*)(ws + WS_KD), (const bf16_t*)(ws + WS_VD), (bf16_t*)(ws + WS_OA), (const float*)(ws + WS_LAM), (const float*)d_in[13]);
            continue;
        }
#endif
        a.ph_lo = ph; a.ph_hi = ph + 1;
        hipLaunchKernelGGL(mk, dim3(256), dim3(NTHR), LDS_BYTES, stream, a);
    }
#ifdef DBG_COPY_OFF
    dbg_copy<<<2048, 256, 0, stream>>>((u32x4*)d_out, (const u32x4*)((unsigned char*)d_ws + (size_t)DBG_COPY_OFF), (size_t)DBG_COPY_BYTES / 16);
#endif
    hipError_t e = hipPeekAtLastError();
    if (e != hipSuccess) fprintf(stderr, "kernel_launch: launch failed: %s\n", hipGetErrorString(e));
#endif
}
```

```cpp
#include <hip/hip_runtime.h>
#include <hip/hip_cooperative_groups.h>
#include <cstdio>
#include <cstdint>
namespace cg = cooperative_groups;

#ifndef MK_ONE_LAUNCH
#define MK_ONE_LAUNCH 1
#endif
#ifndef MK_SLOWK
#define MK_SLOWK 0
#endif
#ifndef MK_NAIVE_ATTN
#define MK_NAIVE_ATTN 0
#endif

#define LAS __attribute__((address_space(3)))
#define GAS __attribute__((address_space(1)))
typedef unsigned short bf16_t;
typedef short bf16x8 __attribute__((ext_vector_type(8)));
typedef short s16x4 __attribute__((ext_vector_type(4)));
typedef float f32x2 __attribute__((ext_vector_type(2)));
typedef float f32x4 __attribute__((ext_vector_type(4)));
typedef float f32x16 __attribute__((ext_vector_type(16)));
typedef unsigned u32x2 __attribute__((ext_vector_type(2)));
typedef unsigned u32x4 __attribute__((ext_vector_type(4)));

constexpr int DM = 1024, NB = 4, SEQ = 8192, CTXL = 256, SK = SEQ + CTXL;
constexpr int NLAT = NB * SEQ, NCTX = NB * CTXL, MTOT = NCTX + NLAT;
constexpr int NE = 16, CAP = 1024, FFD = 1024, NIN = 4000;
constexpr float EPS = 1e-6f, LOG2E = 1.4426950408889634f;
constexpr float MLA_QS = 0.10206207261596577f * LOG2E;
constexpr float DIFF_QS = 0.125f * LOG2E;
constexpr float ALPHA = 1.189207115002721f;
constexpr float LAMBDA_INIT = 0.2f;
constexpr int NWAVES = 8, NTHR = 512;

constexpr size_t MiB = 1u << 20;
constexpr size_t WS_CTL = 0;
constexpr size_t WS_MOD = 1 * MiB;
constexpr size_t WS_ROPE = 1 * MiB + 256 * 1024;
constexpr size_t WS_LAM = 1 * MiB + 512 * 1024;
constexpr size_t WS_KMAX = 1 * MiB + 640 * 1024;
template <int K> __device__ __forceinline__ float swz_xor(float v) { return __int_as_float(__builtin_amdgcn_ds_swizzle(__float_as_int(v), 0x1f | (K << 10))); }
__device__ __forceinline__ float half_sum(float v) { auto rr = __builtin_amdgcn_permlane32_swap(__float_as_uint(v), __float_as_uint(v), false, false); return __uint_as_float(rr[0]) + __uint_as_float(rr[1]); }
__device__ __forceinline__ float sum_fq(float v) { v += swz_xor<16>(v); return half_sum(v); }
__device__ __forceinline__ float wmax16(float v) { v = fmaxf(v, swz_xor<1>(v)); v = fmaxf(v, swz_xor<2>(v)); v = fmaxf(v, swz_xor<4>(v)); v = fmaxf(v, swz_xor<8>(v)); return v; }
constexpr size_t WS_SSQ = 2 * MiB;
constexpr size_t WS_KR = 4 * MiB;
constexpr size_t WS_AFF = 7 * MiB;
constexpr size_t WS_IDX = 9 * MiB;
constexpr size_t WS_GSEL = 9 * MiB + 512 * 1024;
constexpr size_t WS_SLOT = 10 * MiB;
constexpr size_t WS_WIN = 16 * MiB;
constexpr size_t WS_WUQ = 24 * MiB;
constexpr size_t WS_WUKV = 25 * MiB;
constexpr size_t WS_WOC = 26 * MiB;
constexpr size_t WS_WOUT = 28 * MiB;
constexpr size_t WS_W13 = 32 * MiB;
constexpr size_t WS_W2T = 96 * MiB;
constexpr size_t WS_A1 = 128 * MiB;
constexpr size_t WS_P0B = 194 * MiB;
constexpr size_t WS_QD = 228 * MiB;
constexpr size_t WS_KD = 260 * MiB;
constexpr size_t WS_VD = 293 * MiB;
constexpr size_t WS_QM = 326 * MiB;
constexpr size_t WS_KM = 374 * MiB;
constexpr size_t WS_VM = 424 * MiB;
constexpr size_t WS_OA = 128 * MiB;
constexpr size_t WS_Y = 192 * MiB;
constexpr size_t WS_H2 = 128 * MiB;
constexpr size_t WS_X1B = 192 * MiB;
constexpr size_t WS_OL = 256 * MiB;
constexpr size_t WS_XE = 256 * MiB;
constexpr size_t WS_HID = 384 * MiB;
constexpr size_t WS_YE = 256 * MiB;
constexpr size_t WS_NEED = 512 * MiB;

constexpr int LDS_BYTES = 156672;

typedef __bf16 bf16x2_t __attribute__((ext_vector_type(2)));
__device__ __forceinline__ unsigned cvt_pk_bf16(float lo, float hi) { const f32x2 v = {lo, hi}; const bf16x2_t b = __builtin_convertvector(v, bf16x2_t); return __builtin_bit_cast(unsigned, b); }
__device__ __forceinline__ float bf_lo(unsigned w) { return __uint_as_float(w << 16); }
__device__ __forceinline__ float bf_hi(unsigned w) { return __uint_as_float(w & 0xffff0000u); }
__device__ __forceinline__ float bf2f(bf16_t h) { return __uint_as_float(((unsigned)h) << 16); }
__device__ __forceinline__ float fast_exp2(float x) { return __builtin_amdgcn_exp2f(x); }
__device__ __forceinline__ float fast_rcp(float x) { return __builtin_amdgcn_rcpf(x); }
__device__ __forceinline__ float fast_rsq(float x) { return __builtin_amdgcn_rsqf(x); }
__device__ __forceinline__ float sigmoidf_(float x) { return fast_rcp(1.0f + fast_exp2(-x * LOG2E)); }
__device__ __forceinline__ float wave_sum(float v) {
#pragma unroll
    for (int o = 1; o < 64; o <<= 1) v += __shfl_xor(v, o);
    return v;
}
__device__ __forceinline__ float wave_max(float v) {
#pragma unroll
    for (int o = 1; o < 64; o <<= 1) v = fmaxf(v, __shfl_xor(v, o));
    return v;
}

__device__ __forceinline__ int lane_id() { return (int)__builtin_amdgcn_mbcnt_hi(~0u, __builtin_amdgcn_mbcnt_lo(~0u, 0u)); }
struct Args { const float* in[25]; float* out; unsigned char* ws; int ph_lo, ph_hi; };
typedef const __attribute__((address_space(4))) Args* KA;
__device__ __forceinline__ KA kargs() { KA p = (KA)__builtin_amdgcn_kernarg_segment_ptr(); asm volatile("" : "+s"(p)); return p; }

__device__ __forceinline__ void dep_arrive(unsigned* cnt) { __builtin_amdgcn_fence(__ATOMIC_RELEASE, "agent"); asm volatile("s_waitcnt vmcnt(0)" ::: "memory");
    (void)__hip_atomic_fetch_add(cnt, 1u, __ATOMIC_RELAXED, __HIP_MEMORY_SCOPE_AGENT); }
__device__ __forceinline__ void dep_wait(unsigned* cnt, unsigned target) {
    unsigned sp = 0u; while (__hip_atomic_load(cnt, __ATOMIC_RELAXED, __HIP_MEMORY_SCOPE_AGENT) < target) { __builtin_amdgcn_s_sleep(1); if (++sp > (1u << 22)) break; }
    __builtin_amdgcn_fence(__ATOMIC_ACQUIRE, "agent"); asm volatile("s_waitcnt vmcnt(0)" ::: "memory"); }
struct Ctx {
    LAS unsigned char* lds; unsigned char* lds_g;
    int tid, lane, wave, G, vcu, xcd, slot;
};

namespace pg8 {
constexpr int BM = 256, BK = 64, HALF = 128, HTB = HALF * BK * 2, STAGE_BYTES = 8 * HTB;
__host__ __device__ __forceinline__ int lds_byte(int r, int c) { const int st = (r >> 4) * 2 + (c >> 5), rr = r & 15, cc = c & 31, ob = rr * 64 + cc * 2; return st * 1024 + (ob ^ (((ob >> 9) & 1) << 5)); }
__host__ __device__ __forceinline__ void stage_rc(int b, int& R, int& C) { const int st = b / 1024, sb = b % 1024, swz = sb ^ (((sb >> 9) & 1) << 5); R = (st >> 1) * 16 + swz / 64; C = (st & 1) * 32 + (swz % 64) / 2; }
__host__ __device__ __forceinline__ int perm32(int rho) { const int n = rho >> 4, i = rho & 15; return 8 * (i >> 2) + 4 * n + (i & 3); }
struct Unit { int pm, pn, aux; };
struct Gemm { int K, lda, ldb; };

#define ACC_ZERO() do { _Pragma("unroll") for (int a_ = 0; a_ < 2; ++a_) _Pragma("unroll") for (int b_ = 0; b_ < 2; ++b_) _Pragma("unroll") for (int m_ = 0; m_ < 4; ++m_) _Pragma("unroll") for (int n_ = 0; n_ < 2; ++n_) acc[a_][b_][m_][n_] = (f32x4){0.f, 0.f, 0.f, 0.f}; } while (0)

#if MK_SLOWK
template <class Epi, class Sched, bool GATHER = false>
__device__ __forceinline__ void gemm_phase(int wave, LAS unsigned char* lds, const Gemm g, const Sched& S, const Epi& E, const LAS int* rowsL = nullptr) {
    const int tid = wave * 64 + lane_id(), wid = __builtin_amdgcn_readfirstlane(tid >> 6), lane = tid & 63, wr = wid >> 2, wc = wid & 3, fr = lane & 15, fq = lane >> 4;
    f32x4 acc[2][2][4][2];
    ACC_ZERO();
    Unit cur;
    for (int ui = 0; S.next(ui, cur); ++ui) {
        const char* cA = S.a_ptr(cur); const char* cB = S.b_ptr(cur);
        for (int k0 = 0; k0 < g.K; k0 += 32) {
            bf16x8 At[2][4], Bt[2][2];
#pragma unroll
            for (int ai = 0; ai < 2; ++ai)
#pragma unroll
                for (int m = 0; m < 4; ++m) At[ai][m] = *(const bf16x8*)(cA + ((size_t)(128 * ai + 64 * wr + 16 * m + fr) * g.lda + k0 + 8 * fq) * 2);
#pragma unroll
            for (int bj = 0; bj < 2; ++bj)
#pragma unroll
                for (int n = 0; n < 2; ++n) { const int sl = 16 * n + fr; const int row = 128 * bj + 32 * wc + (Epi::PERM ? perm32(sl) : sl);
                    Bt[bj][n] = *(const bf16x8*)(cB + ((size_t)row * g.ldb + k0 + 8 * fq) * 2); }
#pragma unroll
            for (int ai = 0; ai < 2; ++ai)
#pragma unroll
                for (int bj = 0; bj < 2; ++bj)
#pragma unroll
                    for (int m = 0; m < 4; ++m)
#pragma unroll
                        for (int n = 0; n < 2; ++n) acc[ai][bj][m][n] = __builtin_amdgcn_mfma_f32_16x16x32_bf16(Bt[bj][n], At[ai][m], acc[ai][bj][m][n], 0, 0, 0);
        }
        E(acc, cur, wr, wc, fr, fq);
        if (!E.keep(cur)) ACC_ZERO();
    }
}
#else
template <class Epi, class Sched, bool GATHER = false>
__device__ __forceinline__ void gemm_phase(int wave, LAS unsigned char* lds, const Gemm g, const Sched& S, const Epi& E, const LAS int* rowsL = nullptr) {
#ifndef PG8_ALIGN_EPI
#define PG8_ALIGN_EPI true
#endif
    constexpr bool ALIGN_EPI = PG8_ALIGN_EPI;
    int tid_ = wave * 64 + lane_id(); asm volatile("" : "+v"(tid_));
    const int tid = tid_, wid = __builtin_amdgcn_readfirstlane(tid >> 6), lane = tid & 63, wr = wid >> 2, wc = wid & 3, fr = lane & 15, fq = lane >> 4;
    const int K = g.K, nt = K / BK;
    unsigned voffA[2], voffB[2];
#pragma unroll
    for (int i = 0; i < 2; ++i) { int R, C; stage_rc(tid * 16 + i * 8192, R, C); const int Rb = Epi::PERM ? ((R & ~31) + perm32(R & 31)) : R;
        voffA[i] = (unsigned)(R * g.lda + C) * 2u; voffB[i] = (unsigned)(Rb * g.ldb + C) * 2u; }
    unsigned vc[2][2] = {{0u, 0u}, {0u, 0u}}, vn[2][2] = {{0u, 0u}, {0u, 0u}}; int gR[2] = {0, 0}, gC[2] = {0, 0};
    if constexpr (GATHER) {
#pragma unroll
        for (int i = 0; i < 2; ++i) stage_rc(tid * 16 + i * 8192, gR[i], gC[i]);
    }
#define PG8_GOFFS(dst, ord) do { _Pragma("unroll") for (int h_ = 0; h_ < 2; ++h_) _Pragma("unroll") for (int i_ = 0; i_ < 2; ++i_) \
        dst[h_][i_] = (unsigned)(rowsL[(ord) * 256 + h_ * 128 + gR[i_]] * g.lda + gC[i_]) * 2u; } while (0)
#define PG8_STAGE_A(bufoff, gbase0, h, nextflag) do { if constexpr (GATHER) { const unsigned vv_[2] = {(nextflag) ? vn[h][0] : vc[h][0], (nextflag) ? vn[h][1] : vc[h][1]}; PG8_STAGE(bufoff, gbase0, vv_); } \
        else { PG8_STAGE(bufoff, (gbase0) + (h) * hstepA, voffA); } } while (0)
    const size_t kstep = (size_t)(BK * 2);
    const size_t hstepA = (size_t)HALF * g.lda * 2, hstepB = (size_t)HALF * g.ldb * 2;
    const unsigned ldsw = (unsigned)wid * 1024u;
    const int aoff = lds_byte(wr * 64 + fr, fq * 8), boff = lds_byte(wc * 32 + fr, fq * 8);
#define PG8_SA(b, h) (((b) * 2 + (h)) * HTB)
#define PG8_SB(b, h) ((4 + (b) * 2 + (h)) * HTB)
#define PG8_STAGE(bufoff, gbase, voff) do { _Pragma("unroll") for (int _i = 0; _i < 2; ++_i) \
        __builtin_amdgcn_global_load_lds((const unsigned*)((const char*)(gbase) + (voff)[_i]), (LAS unsigned*)(lds + (bufoff) + ldsw + _i * 8192), 16, 0, 0); } while (0)
#define PG8_LDA(dst, b, h) do { _Pragma("unroll") for (int m = 0; m < 4; ++m) _Pragma("unroll") for (int k = 0; k < 2; ++k) dst[m][k] = *(const LAS bf16x8*)(lds + PG8_SA(b, h) + aoff + m * 2048 + k * 1024); } while (0)
#define PG8_LDB(dst, b, h) do { _Pragma("unroll") for (int n = 0; n < 2; ++n) _Pragma("unroll") for (int k = 0; k < 2; ++k) dst[n][k] = *(const LAS bf16x8*)(lds + PG8_SB(b, h) + boff + n * 2048 + k * 1024); } while (0)
#define PG8_MMA(ai, bj, At, Bt) do { __builtin_amdgcn_s_setprio(1); _Pragma("unroll") for (int m = 0; m < 4; ++m) _Pragma("unroll") for (int n = 0; n < 2; ++n) _Pragma("unroll") for (int k = 0; k < 2; ++k) \
        acc[ai][bj][m][n] = __builtin_amdgcn_mfma_f32_16x16x32_bf16(Bt[n][k], At[m][k], acc[ai][bj][m][n], 0, 0, 0); __builtin_amdgcn_s_setprio(0); } while (0)
#define PG8_WAIT_V(n) asm volatile("s_waitcnt vmcnt(" #n ")" ::: "memory")
#define PG8_WAIT_L(n) asm volatile("s_waitcnt lgkmcnt(" #n ")" ::: "memory")
#define PG8_BAR __builtin_amdgcn_s_barrier()
#define PG8_SCHED __builtin_amdgcn_sched_barrier(0)
    Unit cur, nxt; int ui = 0;
    if (!S.next(0, cur)) return;
#ifdef PG8_STAGGER_US
#ifndef PG8_STAGGER_GROUPS
#define PG8_STAGGER_GROUPS 8
#endif
    if (Epi::STAGGER) {
      const unsigned long long until = __builtin_amdgcn_s_memrealtime() + (unsigned long long)((blockIdx.x >> 3) & (PG8_STAGGER_GROUPS - 1)) * (PG8_STAGGER_US * 10ull);
      while (__builtin_amdgcn_s_memrealtime() < until) __builtin_amdgcn_s_sleep(4); }
#endif
    f32x4 acc[2][2][4][2];
    ACC_ZERO();
    bf16x8 At[4][2], B0[2][2], B1[2][2];
    const char* cA = S.a_ptr(cur); const char* cB = S.b_ptr(cur);
    if constexpr (GATHER) PG8_GOFFS(vc, 0);
    PG8_STAGE(PG8_SB(0, 0), cB, voffB); PG8_STAGE(PG8_SB(0, 1), cB + hstepB, voffB); PG8_STAGE_A(PG8_SA(0, 0), cA, 0, false); PG8_STAGE_A(PG8_SA(0, 1), cA, 1, false);
    if (wr == 1) PG8_BAR;
    PG8_WAIT_V(2); PG8_BAR;
    PG8_STAGE(PG8_SB(1, 0), cB + kstep, voffB); PG8_STAGE_A(PG8_SA(1, 0), cA + kstep, 0, false); PG8_STAGE(PG8_SB(1, 1), cB + hstepB + kstep, voffB);
    PG8_WAIT_V(6); PG8_BAR;
    for (;;) {
        const bool has_next = S.next(ui + 1, nxt);
        const char* nA = has_next ? S.a_ptr(nxt) : cA; const char* nB = has_next ? S.b_ptr(nxt) : cB;
        if constexpr (GATHER) { if (has_next) PG8_GOFFS(vn, ui + 1); else { vn[0][0] = vc[0][0]; vn[0][1] = vc[0][1]; vn[1][0] = vc[1][0]; vn[1][1] = vc[1][1]; } }
        for (int t = 0; t < nt; t += 2) {
            const bool last = (t == nt - 2);
            const char* a1 = cA + (size_t)(t + 1) * kstep;
            const char* a2 = last ? nA : cA + (size_t)(t + 2) * kstep; const char* b2 = last ? nB : cB + (size_t)(t + 2) * kstep;
            const char* a3 = a2 + kstep; const char* b3 = b2 + kstep;
            PG8_LDB(B0, 0, 0); PG8_LDB(B1, 0, 1); PG8_SCHED; PG8_LDA(At, 0, 0); PG8_STAGE_A(PG8_SA(1, 1), a1, 1, false);
            PG8_WAIT_V(8); PG8_WAIT_L(0); PG8_BAR; PG8_MMA(0, 0, At, B0); PG8_MMA(0, 1, At, B1); PG8_BAR; PG8_SCHED;
            PG8_LDA(At, 0, 1); PG8_STAGE(PG8_SB(0, 0), b2, voffB); PG8_STAGE(PG8_SB(0, 1), b2 + hstepB, voffB); PG8_STAGE_A(PG8_SA(0, 0), a2, 0, last);
            PG8_WAIT_V(8); PG8_WAIT_L(0); PG8_BAR; PG8_MMA(1, 0, At, B0); PG8_MMA(1, 1, At, B1); PG8_BAR; PG8_SCHED;
            PG8_LDB(B0, 1, 0); PG8_LDB(B1, 1, 1); PG8_SCHED; PG8_LDA(At, 1, 0); PG8_STAGE_A(PG8_SA(0, 1), a2, 1, last);
            PG8_WAIT_V(8); PG8_WAIT_L(0); PG8_BAR; PG8_MMA(0, 0, At, B0); PG8_MMA(0, 1, At, B1); PG8_BAR; PG8_SCHED;
            PG8_LDA(At, 1, 1); PG8_STAGE(PG8_SB(1, 0), b3, voffB); PG8_STAGE(PG8_SB(1, 1), b3 + hstepB, voffB); PG8_STAGE_A(PG8_SA(1, 0), a3, 0, last);
            PG8_WAIT_V(8); PG8_WAIT_L(0); PG8_BAR; PG8_MMA(1, 0, At, B0); PG8_MMA(1, 1, At, B1); PG8_BAR; PG8_SCHED;
        }
        if constexpr (ALIGN_EPI) { if (wr == 0) PG8_BAR; }
        E(acc, cur, wr, wc, fr, fq);
#ifdef MK_EPI_DRAIN
        PG8_WAIT_V(0);
#endif
        if (!has_next) break;
        if (!E.keep(cur)) ACC_ZERO();
        cur = nxt; cA = nA; cB = nB; ++ui;
        if constexpr (GATHER) { vc[0][0] = vn[0][0]; vc[0][1] = vn[0][1]; vc[1][0] = vn[1][0]; vc[1][1] = vn[1][1]; }
        if constexpr (ALIGN_EPI) { if (wr == 1) PG8_BAR; }
    }
    PG8_WAIT_V(0);
    if constexpr (!ALIGN_EPI) { if (wr == 0) PG8_BAR; }
    PG8_BAR;
#undef PG8_GOFFS
#undef PG8_STAGE_A
#undef PG8_SA
#undef PG8_SB
#undef PG8_STAGE
#undef PG8_LDA
#undef PG8_LDB
#undef PG8_MMA
#undef PG8_WAIT_V
#undef PG8_WAIT_L
#undef PG8_BAR
#undef PG8_SCHED
}
#endif
}
using pg8::Unit;

__device__ __forceinline__ void static_order(int L, int nM, int nN, int& pm, int& pn) {
    const int nwg = nM * nN; int wgid = L;
    { const int q = nwg / 8, r = nwg % 8, xcd = wgid % 8, off = wgid / 8; wgid = (xcd < r ? xcd * (q + 1) : r * (q + 1) + (xcd - r) * q) + off; }
    const int nig = 8 * nN, gid = wgid / nig, fm = gid * 8, gsz = (nM - fm) < 8 ? (nM - fm) : 8;
    pm = fm + ((wgid % nig) % gsz); pn = (wgid % nig) / gsz;
}
#ifndef PG8_STAGGER_MASK
#define PG8_STAGGER_MASK 7
#endif
#ifndef EPI_NT
#define EPI_NT 0
#endif
__device__ __forceinline__ void st16(void* p, u32x4 v) { if (EPI_NT) __builtin_nontemporal_store(v, (u32x4*)p); else *(u32x4*)p = v; }
__device__ __forceinline__ u32x4 pack8(f32x4 a, f32x4 b) { u32x4 w; w.x = cvt_pk_bf16(a[0], a[1]); w.y = cvt_pk_bf16(a[2], a[3]); w.z = cvt_pk_bf16(b[0], b[1]); w.w = cvt_pk_bf16(b[2], b[3]); return w; }
__device__ __forceinline__ void rope4(f32x4& x1, f32x4& x2, f32x4 c, f32x4 s) { const f32x4 o1 = x1 * c - x2 * s, o2 = x2 * c + x1 * s; x1 = o1; x2 = o2; }
__device__ __forceinline__ float sq4(f32x4 v) { return (v[0] * v[0] + v[1] * v[1]) + (v[2] * v[2] + v[3] * v[3]); }

struct Sched1 {
    int G, c; const char* A1; const char* WIN; int ctxmode;
    __device__ __forceinline__ bool next(int i, Unit& u) const {
        u.aux = 0;
        if (ctxmode == 1) { if (i > 0 || c >= 20) return false; u.pm = c / 5; const int j = c % 5; u.pn = (j == 0) ? 1 : (3 + j); return true; }
        if (ctxmode == 3) {
            if (c < 20) { if (i == 0) { u.pm = c / 5; const int j = c % 5; u.pn = (j == 0) ? 1 : (3 + j); return true; } --i; }
            const int L3 = i * G + c; if (L3 >= 2048) return false;
            int pm, pn; static_order(L3, 128, 16, pm, pn); u.pm = pm + 4; u.pn = pn;
            if (pn < 2 && i == 4) u.aux = 2 + ((c < 20 && c % 5 == 0) ? 1 : 0);
            return true; }
        int L = i * G + c;
        if (L < 2048) { int pm, pn; static_order(L, 128, 16, pm, pn); u.pm = pm + 4; u.pn = pn; return true; }
        if (ctxmode == 0) return false;
        L -= 2048; if (L >= 20) return false;
        u.pm = L / 5; const int j = L % 5; u.pn = (j == 0) ? 1 : (3 + j); return true;
    }
    __device__ __forceinline__ const char* a_ptr(const Unit& u) const { return A1 + (size_t)u.pm * 256 * 1024 * 2; }
    __device__ __forceinline__ const char* b_ptr(const Unit& u) const { return WIN + (size_t)u.pn * 256 * 1024 * 2; }
};
#ifndef E1_ROPE_LDS
#define E1_ROPE_LDS 1
#endif
struct Epi1 {
    static constexpr bool PERM = true, STAGGER = (PG8_STAGGER_MASK & 1) != 0;
    bf16_t* P0B; float* SSQ; bf16_t* KR; bf16_t* QD; bf16_t* KD; bf16_t* VD; bf16_t* GT; const float* rope; unsigned* KMAX; const LAS float* ropeL;
    unsigned* ready;
    __device__ __forceinline__ bool keep(const Unit&) const { return false; }
    __device__ __forceinline__ void operator()(f32x4 (&acc)[2][2][4][2], const Unit& u, int wr, int wc, int fr, int fq) const {
        asm volatile("" : "+v"(fr), "+v"(fq));
        const bool isctx = u.pm < 4; int b, tbase;
        if (isctx) { b = u.pm; tbase = 0; } else { const int lt = u.pm - 4; b = lt >> 5; tbase = (lt & 31) * 256; }
        const int pn = u.pn;
        const int lr0 = 64 * wr + fr, cw = 32 * wc + 8 * fq;
#define E1_ROWS(...) _Pragma("unroll") for (int ai = 0; ai < 2; ++ai) _Pragma("unroll") for (int m = 0; m < 4; ++m) { const int lr = 128 * ai + 16 * m + lr0; const int t = tbase + lr; __VA_ARGS__ asm volatile("" ::: "memory"); }
        if (pn == 0) {
            bf16_t* P = P0B + (size_t)u.pm * 256 * 512 + cw; float* SQ = SSQ + (size_t)u.pm * 256 * 8 + wc;
            E1_ROWS({ (void)t; float ss = 0.f;
                _Pragma("unroll") for (int bj = 0; bj < 2; ++bj) { const f32x4 v0 = acc[ai][bj][m][0], v1 = acc[ai][bj][m][1]; ss += sq4(v0) + sq4(v1); *(u32x4*)(P + lr * 512 + 128 * bj) = pack8(v0, v1); }
                ss = sum_fq(ss); if (fq == 0) SQ[lr * 8] = ss; })
        } else if (pn == 1) {
            bf16_t* P = P0B + (size_t)u.pm * 256 * 512 + 256 + cw; float* SQ = SSQ + (size_t)u.pm * 256 * 8 + 4 + wc; bf16_t* KRb = KR + (size_t)b * SK * 32 + 8 * fq;
            const int axis = fq >> 1, sub = fq & 1; float kmx = 0.f;
            E1_ROWS({ const f32x4 v0 = acc[ai][0][m][0], v1 = acc[ai][0][m][1]; float ss = sq4(v0) + sq4(v1);
                *(u32x4*)(P + lr * 512) = pack8(v0, v1);
                ss = sum_fq(ss); if (fq == 0) SQ[lr * 8] = ss;
                f32x4 w0 = acc[ai][1][m][0], w1 = acc[ai][1][m][1];
                *(u32x4*)(P + lr * 512 + 128) = pack8(w0, w1);
                if (wc == 0) { const int kidx = isctx ? lr : 256 + t;
                    if (!isctx) { const int pos = axis ? (t & 63) : (t >> 6); const f32x4 c = *(const LAS f32x4*)(ropeL + 4096 + pos * 8 + 4 * sub), s = *(const LAS f32x4*)(ropeL + 5120 + pos * 8 + 4 * sub); rope4(w0, w1, c, s); }
                    float s2 = sq4(w0) + sq4(w1); s2 = sum_fq(s2); kmx = fmaxf(kmx, s2);
                    *(u32x4*)(KRb + kidx * 32) = pack8(w0, w1); } })
            if (wc == 0) { const float mx = wmax16(kmx); if ((fr | fq) == 0) atomicMax(KMAX + 64 + b, __float_as_uint(mx)); }
        }
        if (pn < 2 && ready && u.aux) {
            asm volatile("s_waitcnt vmcnt(0)" ::: "memory"); __syncthreads();
            if ((wr | wc) == 0 && (fr | fq) == 0) { __builtin_amdgcn_fence(__ATOMIC_RELEASE, "agent"); asm volatile("s_waitcnt vmcnt(0)" ::: "memory");
                (void)__hip_atomic_fetch_add(ready, (unsigned)u.aux, __ATOMIC_RELAXED, __HIP_MEMORY_SCOPE_AGENT); }
        }
        if (pn < 2) {
        } else if (pn < 6) {
            const bool isq = pn < 4; const int h0 = 2 * (isq ? pn - 2 : pn - 4); const int axis = wc & 1;
            bf16_t* Qb = QD + (size_t)(b * 4 + h0) * SEQ * 128 + cw; bf16_t* Kb = KD + (size_t)(b * 4 + h0) * SK * 128 + cw; float kmx[2] = {0.f, 0.f};
            E1_ROWS({ const int kidx = isctx ? lr : 256 + t; const int pos = axis ? (t & 63) : (t >> 6);
                f32x4 c = {1.f, 1.f, 1.f, 1.f}, s = {0.f, 0.f, 0.f, 0.f};
#if E1_ROPE_LDS
                if (!isctx) { c = *(const LAS f32x4*)(ropeL + pos * 16 + 4 * fq); s = *(const LAS f32x4*)(ropeL + 2048 + pos * 16 + 4 * fq); }
#else
                if (!isctx) { c = *(const f32x4*)(rope + pos * 16 + 4 * fq); s = *(const f32x4*)(rope + 2048 + pos * 16 + 4 * fq); }
#endif
                _Pragma("unroll") for (int bj = 0; bj < 2; ++bj) { f32x4 v0 = acc[ai][bj][m][0], v1 = acc[ai][bj][m][1]; rope4(v0, v1, c, s);
                    if (isq) { v0 = v0 * DIFF_QS; v1 = v1 * DIFF_QS; float s2 = sq4(v0) + sq4(v1); s2 = sum_fq(s2); kmx[bj] = fmaxf(kmx[bj], s2);
                        *(u32x4*)(Qb + (bj * SEQ + t) * 128) = pack8(v0, v1); }
                    else { float s2 = sq4(v0) + sq4(v1); s2 = sum_fq(s2); kmx[bj] = fmaxf(kmx[bj], s2);
                        *(u32x4*)(Kb + (bj * SK + kidx) * 128) = pack8(v0, v1); } } })
            {
                _Pragma("unroll") for (int bj = 0; bj < 2; ++bj) { const float mx = wmax16(kmx[bj]); if ((fr | fq) == 0) atomicMax(KMAX + (isq ? 132 : 68) + (b * 4 + h0 + bj) * 4 + wc, __float_as_uint(mx)); } }
        } else if (pn < 8) {
            bf16_t* Vb = VD + (size_t)(b * 4 + 2 * (pn - 6)) * SK * 128 + cw;
            E1_ROWS({ const int kidx = isctx ? lr : 256 + t;
                _Pragma("unroll") for (int bj = 0; bj < 2; ++bj) *(u32x4*)(Vb + (bj * SK + kidx) * 128) = pack8(acc[ai][bj][m][0], acc[ai][bj][m][1]); })
        } else {
            bf16_t* Gb = GT + (size_t)(u.pm - 4) * 256 * 2048 + (pn - 8) * 128 + cw;
            E1_ROWS({ (void)t; f32x4 r0, r1, s0, s1;
                _Pragma("unroll") for (int j = 0; j < 4; ++j) { const float a0 = sigmoidf_(acc[ai][0][m][0][j]), a1 = sigmoidf_(acc[ai][0][m][1][j]); s0[j] = sigmoidf_(acc[ai][1][m][0][j]); s1[j] = sigmoidf_(acc[ai][1][m][1][j]);
                    r0[j] = s0[j] > 0.f ? a0 * fast_rcp(s0[j]) : 0.f; r1[j] = s1[j] > 0.f ? a1 * fast_rcp(s1[j]) : 0.f; }
                st16(Gb + lr * 2048, pack8(r0, r1)); st16(Gb + lr * 2048 + 1024, pack8(s0, s1)); })
        }
#undef E1_ROWS
    }
};

struct SchedUQ {
    int G, c; const char* P0B; const char* WUQ;
    __device__ __forceinline__ bool next(int i, Unit& u) const { const int L = i * G + c; if (L >= 384) return false; u.pn = L % 3; u.pm = L / 3; u.aux = 0; return true; }
    __device__ __forceinline__ const char* a_ptr(const Unit& u) const { return P0B + ((size_t)(NCTX + 256 * u.pm) * 512) * 2; }
    __device__ __forceinline__ const char* b_ptr(const Unit& u) const { return WUQ + (size_t)u.pn * 256 * 256 * 2; }
};
struct EpiUQ {
    static constexpr bool PERM = true, STAGGER = false;
    const float* SSQ; bf16_t* QM; const LAS float* ropeL;
    __device__ __forceinline__ bool keep(const Unit&) const { return false; }
    __device__ __forceinline__ void operator()(f32x4 (&acc)[2][2][4][2], const Unit& u, int wr, int wc, int fr, int fq) const {
        asm volatile("" : "+v"(fr), "+v"(fq));
        const int b = u.pm >> 5, tbase = (u.pm & 31) * 256;
        const float* SQ = SSQ + (size_t)(NCTX + u.pm * 256) * 8; bf16_t* Qb = QM + (size_t)b * 8 * SEQ * 96;
        int hh[2], dd[2];
#pragma unroll
        for (int bj = 0; bj < 2; ++bj) { const int c = 256 * u.pn + 128 * bj + 32 * wc + 8 * fq; hh[bj] = c / 96; dd[bj] = c - 96 * hh[bj]; }
        float rsv[8];
#pragma unroll
        for (int i = 0; i < 8; ++i) { const int lr = 128 * (i >> 2) + 64 * wr + 16 * (i & 3) + fr; const f32x4 sq = *(const f32x4*)(SQ + lr * 8);
            rsv[i] = fast_rsq(((sq[0] + sq[1]) + (sq[2] + sq[3])) * (1.0f / 256.0f) + EPS); }
#pragma unroll
        for (int ai = 0; ai < 2; ++ai)
#pragma unroll
            for (int m = 0; m < 4; ++m) {
                const int lr = 128 * ai + 64 * wr + 16 * m + fr; const int t = tbase + lr;
                const float rs = rsv[ai * 4 + m];
#pragma unroll
                for (int bj = 0; bj < 2; ++bj) { const int h = hh[bj], d = dd[bj];
                    f32x4 v0 = acc[ai][bj][m][0] * rs, v1 = acc[ai][bj][m][1] * rs;
                    if (d >= 64) { const int g = (d - 64) >> 3, axis = g >> 1, sub = g & 1; const int pos = axis ? (t & 63) : (t >> 6);
                        const f32x4 cc = *(const LAS f32x4*)(ropeL + pos * 8 + 4 * sub), ss = *(const LAS f32x4*)(ropeL + 1024 + pos * 8 + 4 * sub); rope4(v0, v1, cc, ss); }
                    v0 = v0 * MLA_QS; v1 = v1 * MLA_QS;
                    *(u32x4*)(Qb + (h * SEQ + t) * 96 + d) = pack8(v0, v1); }
                asm volatile("" ::: "memory");
            }
    }
};
struct SchedUKV {
    int G, c; const char* P0B; const char* WUKV;
    __device__ __forceinline__ bool next(int i, Unit& u) const { const int L = i * G + c; if (L >= 528) return false; u.pn = L & 3; u.pm = L >> 2; u.aux = 0; return true; }
    __device__ __forceinline__ const char* a_ptr(const Unit& u) const { return P0B + ((size_t)(256 * u.pm) * 512 + 256) * 2; }
    __device__ __forceinline__ const char* b_ptr(const Unit& u) const { return WUKV + (size_t)u.pn * 256 * 256 * 2; }
};
struct EpiUKV {
    static constexpr bool PERM = true, STAGGER = false;
    const float* SSQ; const bf16_t* KR; bf16_t* KM; bf16_t* VM; unsigned* KMAX;
    __device__ __forceinline__ bool keep(const Unit&) const { return false; }
    __device__ __forceinline__ void operator()(f32x4 (&acc)[2][2][4][2], const Unit& u, int wr, int wc, int fr, int fq) const {
        asm volatile("" : "+v"(fr), "+v"(fq));
        const bool isctx = u.pm < 4; int b, tbase;
        if (isctx) { b = u.pm; tbase = 0; } else { const int lt = u.pm - 4; b = lt >> 5; tbase = 256 + (lt & 31) * 256; }
        const float* SQ = SSQ + (size_t)(u.pm * 256) * 8 + 4; const bf16_t* KRb = KR + (size_t)b * SK * 32 + 8 * fq;
        bf16_t* Kb = KM + (size_t)(b * 8 + 2 * u.pn) * SK * 96; bf16_t* Vb = VM + (size_t)(b * 8 + 2 * u.pn) * SK * 64;
        float kmx[2] = {0.f, 0.f};
        float rsv[8];
#pragma unroll
        for (int i = 0; i < 8; ++i) { const int lr = 128 * (i >> 2) + 64 * wr + 16 * (i & 3) + fr; const f32x4 sq = *(const f32x4*)(SQ + lr * 8);
            rsv[i] = fast_rsq(((sq[0] + sq[1]) + (sq[2] + sq[3])) * (1.0f / 128.0f) + EPS); }
#pragma unroll
        for (int ai = 0; ai < 2; ++ai)
#pragma unroll
            for (int m = 0; m < 4; ++m) {
                const int lr = 128 * ai + 64 * wr + 16 * m + fr; const int kidx = tbase + lr;
                const float rs = rsv[ai * 4 + m];
#pragma unroll
                for (int bj = 0; bj < 2; ++bj) { const int row = bj * SK + kidx;
                    const f32x4 k0 = acc[ai][bj][m][0] * rs, k1 = acc[ai][bj][m][1] * rs;
                    if (wc < 2) { float s2 = sq4(k0) + sq4(k1); s2 = sum_fq(s2); kmx[bj] = fmaxf(kmx[bj], s2); }
                    const u32x4 w = pack8(k0, k1);
                    if (wc < 2) *(u32x4*)(Kb + row * 96 + 32 * wc + 8 * fq) = w; else *(u32x4*)(Vb + row * 64 + 32 * (wc - 2) + 8 * fq) = w; }
                asm volatile("" ::: "memory");
            }
        if (wc == 0) {
            u32x4 kr[8];
#pragma unroll
            for (int i = 0; i < 8; ++i) { const int lr = 128 * (i >> 2) + 64 * wr + 16 * (i & 3) + fr; kr[i] = *(const u32x4*)(KRb + (tbase + lr) * 32); }
#pragma unroll
            for (int i = 0; i < 8; ++i) { const int lr = 128 * (i >> 2) + 64 * wr + 16 * (i & 3) + fr; const int kidx = tbase + lr;
#pragma unroll
                for (int bj = 0; bj < 2; ++bj) *(u32x4*)(Kb + (bj * SK + kidx) * 96 + 64 + 8 * fq) = kr[i]; }
        }
        if (wc < 2) {
#pragma unroll
            for (int bj = 0; bj < 2; ++bj) { const float mx = wmax16(kmx[bj]); if ((fr | fq) == 0) atomicMax(KMAX + (b * 8 + 2 * u.pn + bj) * 2 + wc, __float_as_uint(mx)); }
        }
    }
};

struct SchedY {
    int G, c; const char* OA; const char* WOC;
    __device__ __forceinline__ bool next(int i, Unit& u) const { if (i >= 4) return false; const int T = (i >> 1) * G + c; if (T >= 512) return false;
        int pm, pn; static_order(T, 128, 4, pm, pn); u.pm = pm; u.pn = pn; u.aux = i & 1; return true; }
    __device__ __forceinline__ const char* a_ptr(const Unit& u) const { return OA + ((size_t)u.pm * 256 * 1024 + u.aux * 512) * 2; }
    __device__ __forceinline__ const char* b_ptr(const Unit& u) const { return WOC + ((size_t)u.pn * 256 * 1024 + u.aux * 512) * 2; }
};
struct EpiY {
    static constexpr bool PERM = true, STAGGER = false;
    const bf16_t* GT; bf16_t* Y;
    __device__ __forceinline__ bool keep(const Unit& u) const { return u.aux == 0; }
    __device__ __forceinline__ void operator()(f32x4 (&acc)[2][2][4][2], const Unit& u, int wr, int wc, int fr, int fq) const {
        asm volatile("" : "+v"(fr), "+v"(fq));
        const bf16_t* Gp = GT + ((size_t)u.pm * 256 + 64 * wr + fr) * 2048 + 256 * u.pn + 32 * wc + 8 * fq;
        if (u.aux == 0) {
#pragma unroll
            for (int ai = 0; ai < 2; ++ai)
#pragma unroll
                for (int m = 0; m < 4; ++m)
#pragma unroll
                    for (int bj = 0; bj < 2; ++bj) { const bf16_t* g = Gp + (128 * ai + 16 * m) * 2048 + 128 * bj;
                        const u32x4 ga = *(const u32x4*)g;
                        const f32x4 a0 = {bf_lo(ga.x), bf_hi(ga.x), bf_lo(ga.y), bf_hi(ga.y)}, a1 = {bf_lo(ga.z), bf_hi(ga.z), bf_lo(ga.w), bf_hi(ga.w)};
                        acc[ai][bj][m][0] = acc[ai][bj][m][0] * a0; acc[ai][bj][m][1] = acc[ai][bj][m][1] * a1; }
        } else {
            bf16_t* Yp = Y + ((size_t)u.pm * 256 + 64 * wr + fr) * 1024 + 256 * u.pn + 32 * wc + 8 * fq;
#pragma unroll
            for (int ai = 0; ai < 2; ++ai) {
                u32x4 gbv[4][2];
#pragma unroll
                for (int m = 0; m < 4; ++m)
#pragma unroll
                    for (int bj = 0; bj < 2; ++bj) gbv[m][bj] = *(const u32x4*)(Gp + (128 * ai + 16 * m) * 2048 + 128 * bj + 1024);
#pragma unroll
                for (int m = 0; m < 4; ++m)
#pragma unroll
                    for (int bj = 0; bj < 2; ++bj) { const u32x4 gb = gbv[m][bj];
                        const f32x4 b0 = {bf_lo(gb.x), bf_hi(gb.x), bf_lo(gb.y), bf_hi(gb.y)}, b1 = {bf_lo(gb.z), bf_hi(gb.z), bf_lo(gb.w), bf_hi(gb.w)};
                        *(u32x4*)(Yp + (128 * ai + 16 * m) * 1024 + 128 * bj) = pack8(acc[ai][bj][m][0] * b0, acc[ai][bj][m][1] * b1); }
                asm volatile("" ::: "memory");
            }
        }
    }
};

struct SchedZ {
    int G, c; const char* Y; const char* WOUT;
    __device__ __forceinline__ bool next(int i, Unit& u) const { const int L = i * G + c; if (L >= 512) return false; int pm, pn; static_order(L, 128, 4, pm, pn); u.pm = pm; u.pn = pn; u.aux = 0; return true; }
    __device__ __forceinline__ const char* a_ptr(const Unit& u) const { return Y + (size_t)u.pm * 256 * 1024 * 2; }
    __device__ __forceinline__ const char* b_ptr(const Unit& u) const { return WOUT + (size_t)u.pn * 256 * 1024 * 2; }
};
struct EpiZ {
    static constexpr bool PERM = true, STAGGER = false;
    const float* mod; bf16_t* OL;
    __device__ __forceinline__ bool keep(const Unit&) const { return false; }
    __device__ __forceinline__ void operator()(f32x4 (&acc)[2][2][4][2], const Unit& u, int wr, int wc, int fr, int fq) const {
        asm volatile("" : "+v"(fr), "+v"(fq));
        const int b = u.pm >> 5; const float* g1 = mod + b * 6144 + 2048 + 256 * u.pn + 32 * wc + 8 * fq;
        bf16_t* O = OL + (size_t)u.pm * 256 * 1024 + 256 * u.pn + 32 * wc + 8 * fq;
        f32x4 gq[2][2];
#pragma unroll
        for (int bj = 0; bj < 2; ++bj) { gq[bj][0] = *(const f32x4*)(g1 + 128 * bj); gq[bj][1] = *(const f32x4*)(g1 + 128 * bj + 4); }
#pragma unroll
        for (int bj = 0; bj < 2; ++bj) { const f32x4 g0 = gq[bj][0], g4 = gq[bj][1];
#pragma unroll
            for (int ai = 0; ai < 2; ++ai)
#pragma unroll
                for (int m = 0; m < 4; ++m) { const int lr = 128 * ai + 64 * wr + 16 * m + fr;
                    *(u32x4*)(O + lr * 1024 + 128 * bj) = pack8(acc[ai][bj][m][0] * g0, acc[ai][bj][m][1] * g4); } }
    }
};

struct SchedM1 {
    int xcd, slot; const char* XE; const char* W13;
    __device__ __forceinline__ bool next(int i, Unit& u) const { if (i >= 8) return false; const int e = 2 * xcd + (i >> 2), ap = (i & 3) * 4 + (slot >> 3);
        u.pn = slot & 7; u.pm = ((ap >> 2) * 16 + e) * 4 + (ap & 3); u.aux = e; return true; }
    __device__ __forceinline__ const char* a_ptr(const Unit& u) const { return XE + (size_t)(u.pm >> 6) * SEQ * 1024 * 2; }
    __device__ __forceinline__ const char* b_ptr(const Unit& u) const { return W13 + ((size_t)u.aux * 2048 + u.pn * 256) * 1024 * 2; }
};
struct EpiM1 {
    static constexpr bool PERM = true, STAGGER = (PG8_STAGGER_MASK & 2) != 0;
    bf16_t* HID; int abl;
    __device__ __forceinline__ bool keep(const Unit&) const { return false; }
    __device__ __forceinline__ void operator()(f32x4 (&acc)[2][2][4][2], const Unit& u, int wr, int wc, int fr, int fq) const {
        asm volatile("" : "+v"(fr), "+v"(fq));
        if (abl == 2) return;
#pragma unroll
        for (int ai = 0; ai < 2; ++ai)
#pragma unroll
            for (int m = 0; m < 4; ++m) { const size_t row = (size_t)u.pm * 256 + 128 * ai + 64 * wr + 16 * m + fr;
                f32x4 h0, h1;
#pragma unroll
                for (int j = 0; j < 4; ++j) { const float a0 = acc[ai][0][m][0][j], a1 = acc[ai][0][m][1][j];
                    h0[j] = a0 * sigmoidf_(a0) * acc[ai][1][m][0][j]; h1[j] = a1 * sigmoidf_(a1) * acc[ai][1][m][1][j]; }
                const u32x4 pk = pack8(h0, h1);
                if (abl == 0) st16(HID + row * 1024 + 128 * u.pn + 32 * wc + 8 * fq, pk);
                else if (abl == 3) { u32x2 p2; p2[0] = pk[0] ^ pk[2]; p2[1] = pk[1] ^ pk[3]; *(u32x2*)(HID + row * 1024 + 128 * u.pn + 32 * wc + 8 * fq) = p2; }
                else if (abl == 4) st16(HID + ((size_t)(blockIdx.x * 16) + (row & 15)) * 1024 + 128 * u.pn + 32 * wc + 8 * fq, pk);
                else if (abl == 5) { if (ai == 0 && m == 0) st16(HID + row * 1024 + 128 * u.pn + 32 * wc + 8 * fq, pk); else asm volatile("" :: "v"(pk)); }
                else asm volatile("" :: "v"(pk)); }
    }
};
struct SchedM2 {
    int xcd, slot; const char* HID; const char* W2T;
    __device__ __forceinline__ bool next(int i, Unit& u) const { if (i >= 4) return false; const int e = 2 * xcd + (i >> 1), ap = (i & 1) * 8 + (slot >> 2);
        u.pn = slot & 3; u.pm = ((ap >> 2) * 16 + e) * 4 + (ap & 3); u.aux = e; return true; }
    __device__ __forceinline__ const char* a_ptr(const Unit& u) const { return HID + (size_t)u.pm * 256 * 1024 * 2; }
    __device__ __forceinline__ const char* b_ptr(const Unit& u) const { return W2T + ((size_t)u.aux * 1024 + u.pn * 256) * 1024 * 2; }
};
struct EpiM2 {
    static constexpr bool PERM = true, STAGGER = (PG8_STAGGER_MASK & 4) != 0;
    const float* GSEL; bf16_t* YE;
    __device__ __forceinline__ bool keep(const Unit&) const { return false; }
    __device__ __forceinline__ void operator()(f32x4 (&acc)[2][2][4][2], const Unit& u, int wr, int wc, int fr, int fq) const {
        asm volatile("" : "+v"(fr), "+v"(fq));
#ifndef EPIM2_OLD
        float gv[8];
#pragma unroll
        for (int i = 0; i < 8; ++i) gv[i] = GSEL[(size_t)u.pm * 256 + 128 * (i >> 2) + 64 * wr + 16 * (i & 3) + fr];
#endif
#ifdef DBG_M2_FENCE
        asm volatile("s_waitcnt vmcnt(0)" ::: "memory");
#endif
#pragma unroll
        for (int ai = 0; ai < 2; ++ai)
#pragma unroll
            for (int m = 0; m < 4; ++m) { const size_t row = (size_t)u.pm * 256 + 128 * ai + 64 * wr + 16 * m + fr;
#ifdef EPIM2_OLD
                const float g = GSEL[row];
#else
                const float g = gv[ai * 4 + m];
#endif
#pragma unroll
                for (int bj = 0; bj < 2; ++bj)
                    st16(YE + row * 1024 + 256 * u.pn + 128 * bj + 32 * wc + 8 * fq, pack8(acc[ai][bj][m][0] * g, acc[ai][bj][m][1] * g)); }
    }
};

struct SchedU {
    SchedUQ q; SchedUKV kv; int G, c;
    __device__ __forceinline__ bool next(int i, Unit& u) const {
#ifdef DBG_UREP
        if (i >= 4 * (DBG_UREP + 1)) return false; int L = (i & 3) * G + c; if (L >= 912) L -= 512;
#else
        if (c < 0) return false;
        const int L = i * G + c; if (L >= 912) return false;
#endif
        if (L < 384) { u.pn = L % 3; u.pm = L / 3; u.aux = 0; } else { const int L2 = L - 384; u.pn = L2 & 3; u.pm = L2 >> 2; u.aux = 1; } return true; }
    __device__ __forceinline__ const char* a_ptr(const Unit& u) const { return u.aux == 0 ? q.a_ptr(u) : kv.a_ptr(u); }
    __device__ __forceinline__ const char* b_ptr(const Unit& u) const { return u.aux == 0 ? q.b_ptr(u) : kv.b_ptr(u); }
};
struct EpiU {
    static constexpr bool PERM = true, STAGGER = false;
    EpiUQ q; EpiUKV kv;
    __device__ __forceinline__ bool keep(const Unit&) const { return false; }
    __device__ __forceinline__ void operator()(f32x4 (&acc)[2][2][4][2], const Unit& u, int wr, int wc, int fr, int fq) const {
        if (u.aux == 0) q(acc, u, wr, wc, fr, fq); else kv(acc, u, wr, wc, fr, fq);
    }
};
namespace fa {
#define KSWZ(row, colB) ((row) * 256 + ((colB) ^ (((row) & 15) << 4)))
#define SBAR() __builtin_amdgcn_sched_barrier(0)
__device__ __forceinline__ int crow(int r, int hi) { return (r & 3) + 8 * (r >> 2) + 4 * hi; }
constexpr float THRL = 11.0f;
constexpr int VOFF = 0, KOFF = 32768, BUFB = 16384, OTOFF = 65536, WSOFF = 135168;

__device__ __forceinline__ void partialSM(f32x16& p0, f32x16& p1, float& m_reg, float& alpha) {
    float pmax = p0[0];
#pragma unroll
    for (int r = 1; r < 16; ++r) pmax = fmaxf(pmax, p0[r]);
#pragma unroll
    for (int r = 0; r < 16; ++r) pmax = fmaxf(pmax, p1[r]);
    { auto rr = __builtin_amdgcn_permlane32_swap(__float_as_uint(pmax), __float_as_uint(pmax), false, false);
      pmax = fmaxf(__uint_as_float(rr[0]), __uint_as_float(rr[1])); }
    float mn;
    if (__builtin_expect(__all(pmax - m_reg <= THRL), 1)) { mn = m_reg; alpha = 1.f; }
    else { mn = fmaxf(m_reg, pmax); alpha = fast_exp2(m_reg - mn); m_reg = mn; }
#pragma unroll
    for (int r = 0; r < 16; ++r) { p0[r] -= mn; p1[r] -= mn; }
#pragma unroll
    for (int r = 0; r < 16; ++r) p0[r] = fast_exp2(p0[r]);
}
__device__ __forceinline__ void finishSM(f32x16& p0, f32x16& p1, float alpha, float& l_reg, bf16x8& pa0, bf16x8& pa1, bf16x8& pa2, bf16x8& pa3) {
#pragma unroll
    for (int r = 0; r < 16; ++r) p1[r] = fast_exp2(p1[r]);
    float ps = 0.f;
#pragma unroll
    for (int r = 0; r < 16; ++r) ps += p0[r];
#pragma unroll
    for (int r = 0; r < 16; ++r) ps += p1[r];
    { auto rr = __builtin_amdgcn_permlane32_swap(__float_as_uint(ps), __float_as_uint(ps), false, false);
      ps = __uint_as_float(rr[0]) + __uint_as_float(rr[1]); }
    l_reg = l_reg * alpha + ps;
#define PK4(P, BASE, OUT) do { unsigned a0 = cvt_pk_bf16(P[BASE + 0], P[BASE + 1]), a1 = cvt_pk_bf16(P[BASE + 2], P[BASE + 3]);   \
    unsigned b0 = cvt_pk_bf16(P[BASE + 4], P[BASE + 5]), b1 = cvt_pk_bf16(P[BASE + 6], P[BASE + 7]);                              \
    auto r0 = __builtin_amdgcn_permlane32_swap(a0, b0, false, false); auto r1 = __builtin_amdgcn_permlane32_swap(a1, b1, false, false); \
    u32x4 w = {r0[0], r1[0], r0[1], r1[1]}; OUT = __builtin_bit_cast(bf16x8, w); } while (0)
    PK4(p0, 0, pa0); PK4(p0, 8, pa1); PK4(p1, 0, pa2); PK4(p1, 8, pa3);
#undef PK4
}
template <int NQ>
__device__ __forceinline__ void qkt(f32x16& p0, f32x16& p1, const LAS unsigned char* Ks, const bf16x8* qr, int r32, int hi, int kcolB) {
    p0 = f32x16{}; p1 = f32x16{};
#pragma unroll
    for (int d0 = 0; d0 < NQ; ++d0) { const int cb = kcolB + (d0 * 16 + hi * 8) * 2;
        const bf16x8 b0 = *(const LAS bf16x8*)(Ks + KSWZ(r32, cb));
        const bf16x8 b1 = *(const LAS bf16x8*)(Ks + KSWZ(32 + r32, cb));
        p0 = __builtin_amdgcn_mfma_f32_32x32x16_bf16(b0, qr[d0], p0, 0, 0, 0);
        p1 = __builtin_amdgcn_mfma_f32_32x32x16_bf16(b1, qr[d0], p1, 0, 0, 0); }
}
template <int NCB> __device__ __forceinline__ int v_st(int k, int c) { const int kk = k; return ((kk >> 3) * NCB + (c >> 5)) * 512 + ((kk & 7) * 32 + (c & 31)) * 2; }
__device__ __forceinline__ int v_rd_base(int lane) { return ((lane & 3) << 3) | (((lane >> 2) & 3) << 6) | (((lane >> 4) & 1) << 5) | (((lane >> 5) & 1) << 8); }
template <int OFF> __device__ __forceinline__ s16x4 tr_read(int vb) {
    s16x4 r; asm volatile("ds_read_b64_tr_b16 %0, %1 offset:%2" : "=&v"(r) : "v"(vb), "i"(OFF) : "memory"); return r;
}
template <int NCB, int D0> __device__ __forceinline__ void pv_one(f32x16& od, int vb, bf16x8 pa0, bf16x8 pa1, bf16x8 pa2, bf16x8 pa3) {
#define VO(ks, half) (D0 * 512 + (ks) * (1024 * NCB) + (half) * (512 * NCB))
    const s16x4 l0 = tr_read<VO(0, 0)>(vb), h0 = tr_read<VO(0, 1)>(vb), l1 = tr_read<VO(1, 0)>(vb), h1 = tr_read<VO(1, 1)>(vb);
    const s16x4 l2 = tr_read<VO(2, 0)>(vb), h2 = tr_read<VO(2, 1)>(vb), l3 = tr_read<VO(3, 0)>(vb), h3 = tr_read<VO(3, 1)>(vb);
#undef VO
    asm volatile("s_waitcnt lgkmcnt(0)" ::: "memory"); SBAR();
#define PK(L, H) (bf16x8){L[0], L[1], L[2], L[3], H[0], H[1], H[2], H[3]}
    od = __builtin_amdgcn_mfma_f32_32x32x16_bf16(pa0, PK(l0, h0), od, 0, 0, 0);
    od = __builtin_amdgcn_mfma_f32_32x32x16_bf16(pa1, PK(l1, h1), od, 0, 0, 0);
    od = __builtin_amdgcn_mfma_f32_32x32x16_bf16(pa2, PK(l2, h2), od, 0, 0, 0);
    od = __builtin_amdgcn_mfma_f32_32x32x16_bf16(pa3, PK(l3, h3), od, 0, 0, 0);
#undef PK
}
template <int NCB> __device__ __forceinline__ void pv_all(f32x16* o, int vb, bf16x8 pa0, bf16x8 pa1, bf16x8 pa2, bf16x8 pa3) {
    pv_one<NCB, 0>(o[0], vb, pa0, pa1, pa2, pa3); pv_one<NCB, 1>(o[1], vb, pa0, pa1, pa2, pa3);
    if constexpr (NCB == 4) { pv_one<NCB, 2>(o[2], vb, pa0, pa1, pa2, pa3); pv_one<NCB, 3>(o[3], vb, pa0, pa1, pa2, pa3); }
}

#ifndef ATT_PKSUM
#define ATT_PKSUM 0
#endif
typedef short v4i16_t __attribute__((ext_vector_type(4)));
__device__ __forceinline__ s16x4 vtr(const LAS unsigned char* p) { return __builtin_bit_cast(s16x4, __builtin_amdgcn_ds_read_tr16_b64_v4i16((LAS v4i16_t*)p)); }
template <int LO, int N, int ABL = 0, bool SUM = true> __device__ __forceinline__ void expsum(f32x16& p0, f32x16& p1, float (&ls)[4], int lo_rt, float msub) {
#if ATT_PKSUM
    f32x2 l2 = {ls[0], ls[1]};
#pragma unroll
    for (int q = 0; q < N; q += 2) { const int r = lo_rt + q;
        if (r < 16) { const float e0 = (ABL & 1) ? (p0[r] - msub) : fast_exp2(p0[r] - msub), e1 = (ABL & 1) ? (p0[r + 1] - msub) : fast_exp2(p0[r + 1] - msub); p0[r] = e0; p0[r + 1] = e1; if (SUM) l2 += (f32x2){e0, e1}; }
        else if (r < 32) { const float e0 = (ABL & 1) ? (p1[r - 16] - msub) : fast_exp2(p1[r - 16] - msub), e1 = (ABL & 1) ? (p1[r - 15] - msub) : fast_exp2(p1[r - 15] - msub); p1[r - 16] = e0; p1[r - 15] = e1; if (SUM) l2 += (f32x2){e0, e1}; } }
    ls[0] = l2[0]; ls[1] = l2[1];
#else
#pragma unroll
    for (int q = 0; q < N; ++q) { const int r = lo_rt + q;
        if (r < 16) { const float e = (ABL & 1) ? (p0[r] - msub) : fast_exp2(p0[r] - msub); p0[r] = e; if (SUM) ls[0] += e; } else if (r < 32) { const float e = (ABL & 1) ? (p1[r - 16] - msub) : fast_exp2(p1[r - 16] - msub); p1[r - 16] = e; if (SUM) ls[0] += e; } }
#endif
}
#define PK4(P, BASE, OUT) do { const u32x4 w_ = {cvt_pk_bf16(P[BASE + 0], P[BASE + 1]), cvt_pk_bf16(P[BASE + 2], P[BASE + 3]), cvt_pk_bf16(P[BASE + 4], P[BASE + 5]), cvt_pk_bf16(P[BASE + 6], P[BASE + 7])}; \
    OUT = __builtin_bit_cast(bf16x8, w_); } while (0)

#ifndef ROWSUM_MFMA
#define ROWSUM_MFMA 0
#endif
#ifdef ATT_NOSGB
#define SGB(mask, n) do { } while (0)
#else
#define SGB(mask, n) __builtin_amdgcn_sched_group_barrier(mask, n, 0)
#endif
template <int ABL> __device__ __forceinline__ f32x16 mfma_a(bf16x8 a, bf16x8 b, f32x16 c) { if constexpr (ABL & 2) { asm volatile("" :: "v"(a), "v"(b)); return c; } else return __builtin_amdgcn_mfma_f32_32x32x16_bf16(a, b, c, 0, 0, 0); }
template <int ABL> __device__ __forceinline__ bf16x8 ldsrd_a(const LAS unsigned char* p, bf16x8 alt) { if constexpr (ABL & 16) { asm volatile("" : "+v"(alt)); return alt; } else return *(const LAS bf16x8*)p; }
template <int NQ, int NCB, bool DOQK, bool DOPV, int SHIFT, int ABL, int NEXB>
__device__ __forceinline__ void tile_step(f32x16& c0, f32x16& c1, f32x16& p0, f32x16& p1, f32x16 (&o)[NCB], f32x16& lacc, const LAS unsigned char* Kb, const int (&ka)[NQ],
                                          const bf16x8 (&qr)[NQ], const f32x16& negm, float msub, const LAS unsigned char* Vb) {
    const f32x16 zero16 = {};
    constexpr int NG = 2 * NQ, NM = 4 * NCB;
    SBAR();
    if constexpr (DOQK) {
#pragma unroll
        for (int d0 = 0; d0 < NQ; ++d0) {
            const bf16x8 kf0 = ldsrd_a<ABL>(Kb + ka[d0], qr[d0]), kf1 = ldsrd_a<ABL>(Kb + ka[d0] + 8192, qr[d0]);
            if (d0 == 0) { c0 = mfma_a<ABL>(kf0, qr[d0], (SHIFT == 1) ? negm : zero16); c1 = mfma_a<ABL>(kf1, qr[d0], (SHIFT == 1) ? negm : zero16); }
            else { c0 = mfma_a<ABL>(kf0, qr[d0], c0); c1 = mfma_a<ABL>(kf1, qr[d0], c1); }
        }
    }
    if constexpr (DOPV) {
#define VO(d0, ks, half) ((d0) * 512 + (ks) * (1024 * NCB) + (half) * (512 * NCB))
        bf16x8 pa[4];
        { float ls_[4] = {0.f, 0.f, 0.f, 0.f}; ls_[0] = lacc[0]; ls_[1] = lacc[1]; expsum<0, 32 - NEXB, ABL, !ROWSUM_MFMA>(p0, p1, ls_, 0, msub);
          PK4(p0, 0, pa[0]); PK4(p0, 8, pa[1]);
          if constexpr (NEXB > 0) expsum<0, NEXB, ABL, !ROWSUM_MFMA>(p0, p1, ls_, 32 - NEXB, msub);
          PK4(p1, 0, pa[2]); PK4(p1, 8, pa[3]);
          if (!ROWSUM_MFMA) { lacc[0] = ls_[0]; lacc[1] = ls_[1]; } }
        const u32x4 one4 = {0x3f803f80u, 0x3f803f80u, 0x3f803f80u, 0x3f803f80u}; const bf16x8 ones = __builtin_bit_cast(bf16x8, one4);
#pragma unroll
        for (int idx = 0; idx < NM; ++idx) { const int ks = idx / NCB, d0 = idx % NCB;
#if ROWSUM_MFMA
            if (d0 == 0) lacc = mfma_a<ABL>(pa[ks], ones, lacc);
#endif
            bf16x8 vf;
            if constexpr (ABL & 16) { vf = pa[ks]; asm volatile("" : "+v"(vf)); } else { const s16x4 vl = vtr(Vb + VO(d0, ks, 0)), vh = vtr(Vb + VO(d0, ks, 1)); vf = (bf16x8){vl[0], vl[1], vl[2], vl[3], vh[0], vh[1], vh[2], vh[3]}; }
            o[d0] = mfma_a<ABL>(pa[ks], vf, o[d0]);
        }
#undef VO
    }
#ifndef ATT_PACKFRONT
#define ATT_PACKFRONT 0
#endif
#ifndef ATT_MFMA2
#define ATT_MFMA2 0
#endif
#ifndef ATT_VAH_MLA
#define ATT_VAH_MLA 8
#endif
#ifndef ATT_VAH_DIFF
#define ATT_VAH_DIFF 6
#endif
#ifndef ATT_FRONT
#define ATT_FRONT 8
#endif
#ifndef ATT_KAHEAD
#define ATT_KAHEAD 2
#endif
#ifndef ATT_VSTART
#define ATT_VSTART 4
#endif
#ifndef ATT_VSTART_MLA
#define ATT_VSTART_MLA 8
#endif
#ifndef ATT_VSTART_DIFF
#define ATT_VSTART_DIFF ATT_VSTART
#endif
#ifndef ATT_FRONT_MLA
#define ATT_FRONT_MLA 4
#endif
#ifndef ATT_FRONT_DIFF
#define ATT_FRONT_DIFF ATT_FRONT
#endif
    constexpr int VAH = (NCB == 4) ? ATT_VAH_DIFF : ATT_VAH_MLA;
    constexpr int VPER = (SHIFT == 2) ? 1 : 0;
    constexpr int FRONT_ = (NCB == 4) ? ATT_FRONT_DIFF : ATT_FRONT_MLA, VST = (NCB == 4) ? ATT_VSTART_DIFF : ATT_VSTART_MLA;
    constexpr int NEXA = 32 - NEXB, FRONT = DOQK ? FRONT_ : NEXA, HALFM = NM / 2;
#ifndef ATT_KAHEAD_DIFF
#define ATT_KAHEAD_DIFF ATT_KAHEAD
#endif
    constexpr int KAH_ = (NCB == 4) ? ATT_KAHEAD_DIFF : ATT_KAHEAD;
    constexpr int KFIRST = (KAH_ >= NG) ? NG : KAH_;
    if constexpr (DOQK) SGB(0x100, KFIRST);
    if constexpr (DOPV && FRONT > 0) { SGB(0x400, FRONT); if constexpr (VPER > 0) SGB(0x002, FRONT * VPER); }
    if constexpr (DOQK) {
        constexpr int PER = (NEXA - FRONT + NG - 1) / NG;
#pragma unroll
        for (int g = 0; g < NG; ++g) {
            if (ATT_MFMA2) { if (g & 1) continue;
                if (KFIRST + g < NG) SGB(0x100, 2);
                SGB(0x008, 2);
                if constexpr (DOPV) { if constexpr (PER > 0) { SGB(0x400, 2 * PER); if constexpr (VPER > 0) SGB(0x002, 2 * PER * VPER); } if (g >= NG - VST) SGB(0x100, (4 * VAH) / VST); }
                continue; }
            if (KFIRST + g < NG) SGB(0x100, 1);
            SGB(0x008, 1);
            if constexpr (DOPV) { if constexpr (PER > 0) { SGB(0x400, PER); if constexpr (VPER > 0) SGB(0x002, PER * VPER); } if (g >= NG - VST) SGB(0x100, (2 * VAH) / VST); }
        }
    }
    if constexpr (DOPV) {
        if constexpr (!DOQK) SGB(0x100, 2 * VAH);
        SGB(0x002, ATT_PACKFRONT ? 16 : 8);
        constexpr int PERB = NEXB > 0 ? (NEXB + HALFM - 1) / HALFM : 0;
#pragma unroll
        for (int idx = 0; idx < NM + (ROWSUM_MFMA ? 4 : 0); ++idx) {
            if (idx + VAH < NM) SGB(0x100, 2);
            if constexpr (NEXB > 0) { if (idx == HALFM) SGB(0x002, 8); }
            SGB(0x008, 1);
            if constexpr (NEXB > 0) { if (idx < HALFM) { SGB(0x400, PERB); if constexpr (VPER > 0) SGB(0x002, PERB * VPER); } }
            else { if (!ATT_PACKFRONT && idx < 4) SGB(0x002, 2); }
        }
    }
    if constexpr (DOQK) asm volatile("" : "+v"(c0), "+v"(c1));
    if constexpr (DOPV) {
#pragma unroll
        for (int d = 0; d < NCB; ++d) asm volatile("" : "+v"(o[d]));
        asm volatile("" : "+v"(lacc));
    }
    SBAR();
}

#ifndef ATT_WIDE_O
#define ATT_WIDE_O 0
#endif
#ifndef ATT_NEXB_DIFF
#define ATT_NEXB_DIFF 0
#endif
#ifndef ATT_OLD_SLEEP
#define ATT_OLD_SLEEP 0
#endif
#ifndef ATT_STAGE_FIRST
#define ATT_STAGE_FIRST 1
#endif
#ifndef ATT_OLDSTAGE
#define ATT_OLDSTAGE 0
#endif
template <int MODE> struct AU { static constexpr int DQK = MODE ? 64 : 96, DV = MODE ? 128 : 64, LDK = MODE ? 128 : 96, NQ = DQK / 16, NST = (MODE == 0 && ATT_OLDSTAGE) ? 256 : 512,
                                                     NLD = (64 * (LDK / 8) + 64 * (DV / 8) + NST - 1) / NST; };
template <int MODE, int ABL, int SHIFT>
__device__ __forceinline__ void attn_unit(LAS unsigned char* lds, const bf16_t* __restrict__ Qu, const bf16_t* __restrict__ Kh, const bf16_t* __restrict__ Vh, bf16_t* Ou,
                                          float kmax0, float kmax1, float lam, const float* __restrict__ gsub, int wave,
                                          const bf16_t* __restrict__ Qn, const bf16_t* __restrict__ Kn, const bf16_t* __restrict__ Vn, bf16x8 (&qr)[AU<MODE>::NQ], bf16x8 (&sr_)[AU<MODE>::NLD]) {
    constexpr int DQK = MODE ? 64 : 96, DV = MODE ? 128 : 64, LDQ = MODE ? 128 : 96, LDK = MODE ? 128 : 96, LDV = DV;
    constexpr int KCPR = LDK / 8, VCPR = LDV / 8, NKCH = 64 * KCPR, NCH = NKCH + 64 * VCPR, NST = AU<MODE>::NST, NLD = (NCH + NST - 1) / NST, NCB = DV / 32, NQ = DQK / 16, NT = SK / 64;
    static_assert(NQ == AU<MODE>::NQ && NLD == AU<MODE>::NLD, "AU mismatch");
    static_assert(NST == 512 || (NKCH % NST == 0 && NCH % NST == 0), "half-workgroup staging needs whole K and V slots");
    constexpr int NEXB = MODE ? ATT_NEXB_DIFF : 0;
    int tid_ = wave * 64 + lane_id(); asm volatile("" : "+v"(tid_));
    const int tid = tid_, wid = wave, lane = tid & 63, r32 = lane & 31, hi = lane >> 5;
    const int mp = MODE ? (wid >> 2) : 0, qw = MODE ? (wid & 3) : wid;
    f32x16 o[NCB];
#pragma unroll
    for (int d = 0; d < NCB; ++d) o[d] = f32x16{};
    float qss = 0.f;
    const int qoff = (qw * 32 + r32) * LDQ + mp * 64 + hi * 8;
#pragma unroll
    for (int d0 = 0; d0 < NQ; ++d0) {
#pragma unroll
        for (int j = 0; j < 8; ++j) { const float v = bf2f((bf16_t)qr[d0][j]); qss += v * v; } }
    { auto rr = __builtin_amdgcn_permlane32_swap(__float_as_uint(qss), __float_as_uint(qss), false, false); qss = __uint_as_float(rr[0]) + __uint_as_float(rr[1]); }
    const float Mrow = 1.02f * sqrtf(qss) * (mp ? kmax1 : kmax0) + 0.5f;
    f32x16 negm = {}; const float msub = (SHIFT == 2) ? Mrow : 0.f;
    if constexpr (SHIFT == 1) {
#pragma unroll
        for (int r = 0; r < 16; ++r) negm[r] = -Mrow;
        asm volatile("" : "+v"(negm)); }
    unsigned voff[NLD]; int dst[NLD]; bool isk[NLD];
    const bool stg = (NST == 512) || wid < 4;
#pragma unroll
    for (int i = 0; i < NLD; ++i) { int c = (tid & (NST - 1)) + NST * i; if (c >= NCH) c -= NCH;
        if (MODE) isk[i] = (i < 2); else if (NST == 256) isk[i] = (i < NKCH / NST); else isk[i] = (i == 0) || ((i == 1) == (wid < 4));
        if (c < NKCH) { const int row = c / KCPR, ch = c % KCPR; voff[i] = (row * LDK + ch * 8) * 2; dst[i] = KOFF + BUFB + KSWZ(row, ch * 16); }
        else { const int c2 = c - NKCH; const int row = c2 / VCPR, ch = c2 % VCPR; voff[i] = (row * LDV + ch * 8) * 2; dst[i] = VOFF + v_st<NCB>(row, ch * 8); } }
    int ka[NQ];
#pragma unroll
    for (int d0 = 0; d0 < NQ; ++d0) ka[d0] = KSWZ(r32, mp * 128 + (d0 * 16 + hi * 8) * 2);
    const LAS unsigned char* Kb0 = lds + KOFF; const LAS unsigned char* Vb0 = lds + VOFF + v_rd_base(lane);
#define STAGE_LOAD_AT(KB, VB, j) do { if (stg) { const char* kb_ = (const char*)((KB) + (long)((j) + 1) * (64 * LDK)); const char* vb_ = (const char*)((VB) + (long)(j) * (64 * LDV)); \
        _Pragma("unroll") for (int i_ = 0; i_ < NLD; ++i_) sr_[i_] = *(const bf16x8*)((isk[i_] ? kb_ : vb_) + voff[i_]); } } while (0)
#define STAGE_LOAD(j) STAGE_LOAD_AT(Kh, Vh, j)
#define STAGE_WRITE(jodd) do { if (stg) { _Pragma("unroll") for (int i_ = 0; i_ < NLD; ++i_) *(LAS bf16x8*)(lds + (dst[i_] ^ ((jodd) ? BUFB : 0))) = sr_[i_]; } } while (0)
    f32x16 sA0, sA1, sB0, sB1, lacc = {};
    __syncthreads();
    STAGE_WRITE(1); STAGE_LOAD(0);
    __syncthreads();
    if (ATT_STAGE_FIRST) { STAGE_WRITE(0); STAGE_LOAD(1); }
    tile_step<NQ, NCB, true, false, SHIFT, ABL, NEXB>(sA0, sA1, sA0, sA1, o, lacc, Kb0, ka, qr, negm, msub, Vb0);
    if (!ATT_STAGE_FIRST) { STAGE_WRITE(0); STAGE_LOAD(1); }
    __syncthreads();
#ifdef DBG_STAMP
#define ITER(C0, C1, P0, P1, todd, t) do { \
        const unsigned long long ts0_ = __builtin_amdgcn_s_memtime(); \
        if (ATT_STAGE_FIRST) { STAGE_WRITE(todd); if (!(ABL & 4)) STAGE_LOAD((t) + 1); } \
        const unsigned long long ts1_ = __builtin_amdgcn_s_memtime(); \
        tile_step<NQ, NCB, true, true, SHIFT, ABL, NEXB>(C0, C1, P0, P1, o, lacc, Kb0 + ((todd) ? BUFB : 0), ka, qr, negm, msub, Vb0 + ((todd) ? 0 : BUFB)); \
        if (!ATT_STAGE_FIRST) { STAGE_WRITE(todd); if (!(ABL & 4)) STAGE_LOAD((t) + 1); } \
        const unsigned long long ts2_ = __builtin_amdgcn_s_memtime(); \
        if (!(ABL & 8)) __syncthreads(); \
        const unsigned long long ts3_ = __builtin_amdgcn_s_memtime(); \
        stamp_acc += (DBG_STAMP == 1) ? ts3_ - ts2_ : (DBG_STAMP == 2) ? ts2_ - ts1_ : ts1_ - ts0_; } while (0)
    unsigned long long stamp_acc = 0ull;
#else
#define ITER(C0, C1, P0, P1, todd, t) do { \
        if (ATT_STAGE_FIRST) { STAGE_WRITE(todd); if (!(ABL & 4)) STAGE_LOAD((t) + 1); } \
        if (ATT_OLD_SLEEP > 0) { if (wid < 4) __builtin_amdgcn_s_sleep(ATT_OLD_SLEEP); } \
        tile_step<NQ, NCB, true, true, SHIFT, ABL, NEXB>(C0, C1, P0, P1, o, lacc, Kb0 + ((todd) ? BUFB : 0), ka, qr, negm, msub, Vb0 + ((todd) ? 0 : BUFB)); \
        if (!ATT_STAGE_FIRST) { STAGE_WRITE(todd); if (!(ABL & 4)) STAGE_LOAD((t) + 1); } \
        if (!(ABL & 8)) __syncthreads(); } while (0)
#endif
    if (!(ABL & 32))
    for (int t = 1; t + 1 < NT; t += 2) {
        ITER(sB0, sB1, sA0, sA1, 1, t);
        ITER(sA0, sA1, sB0, sB1, 0, t + 1);
    }
    {
        if (ATT_STAGE_FIRST) { STAGE_WRITE(1);
            if constexpr (MODE == 0) { long dk = Kn - Kh, dv = Vn - Vh; asm volatile("" : "+s"(dk), "+s"(dv)); STAGE_LOAD_AT(Kh + dk, Vh + dv, -1); } }
        tile_step<NQ, NCB, true, true, SHIFT, ABL, NEXB>(sB0, sB1, sA0, sA1, o, lacc, Kb0 + BUFB, ka, qr, negm, msub, Vb0);
        if (!ATT_STAGE_FIRST) STAGE_WRITE(1);
        { long dq = Qn - Qu; asm volatile("" : "+s"(dq));
            if constexpr (MODE == 0 && !ATT_STAGE_FIRST) { long dk = Kn - Kh, dv = Vn - Vh; asm volatile("" : "+s"(dk), "+s"(dv)); STAGE_LOAD_AT(Kh + dk, Vh + dv, -1); }
#pragma unroll
            for (int d0 = 0; d0 < NQ; ++d0) qr[d0] = *(const bf16x8*)(Qu + dq + qoff + d0 * 16); }
        if (!(ABL & 8)) __syncthreads(); }
    tile_step<NQ, NCB, false, true, SHIFT, ABL, NEXB>(sB0, sB1, sB0, sB1, o, lacc, Kb0, ka, qr, negm, msub, Vb0 + BUFB);
#ifdef DBG_STAMP
    if (lane == 0) { LAS unsigned long long* sp_ = (LAS unsigned long long*)(lds + 139264) + wid; *sp_ = *sp_ + stamp_acc; }
#endif
#undef ITER
    float rli[16];
#if ROWSUM_MFMA
#pragma unroll
    for (int r = 0; r < 16; ++r) rli[r] = fast_rcp(lacc[r]);
#else
    { float l_reg = lacc[0] + lacc[1]; LAS float* li_l = (LAS float*)(lds + WSOFF) + wid * 64;
      auto rr = __builtin_amdgcn_permlane32_swap(__float_as_uint(l_reg), __float_as_uint(l_reg), false, false); l_reg = __uint_as_float(rr[0]) + __uint_as_float(rr[1]);
      if (hi == 0) li_l[r32] = l_reg; asm volatile("s_waitcnt lgkmcnt(0)" ::: "memory");
#pragma unroll
      for (int r = 0; r < 16; ++r) rli[r] = fast_rcp(li_l[crow(r, hi)]); }
#endif
    if constexpr (MODE == 0) {
        bf16_t* Ow = Ou + (size_t)(wid * 32) * 1024;
#if ATT_WIDE_O
        LAS float* T = (LAS float*)(lds + OTOFF) + wid * (32 * 68);
#pragma unroll
        for (int r = 0; r < 16; ++r) { const int orow = crow(r, hi);
#pragma unroll
            for (int d0 = 0; d0 < NCB; ++d0) T[orow * 68 + d0 * 32 + r32] = o[d0][r] * rli[r]; }
#pragma unroll
        for (int k = 0; k < 4; ++k) { const int row = 8 * k + (lane >> 3), ch = lane & 7;
            const f32x4 a = *(const LAS f32x4*)(T + row * 68 + ch * 8), b = *(const LAS f32x4*)(T + row * 68 + ch * 8 + 4);
            u32x4 w; w.x = cvt_pk_bf16(a[0], a[1]); w.y = cvt_pk_bf16(a[2], a[3]); w.z = cvt_pk_bf16(b[0], b[1]); w.w = cvt_pk_bf16(b[2], b[3]);
            *(u32x4*)(Ow + (size_t)row * 1024 + ch * 8) = w; }
#else
#pragma unroll
        for (int r = 0; r < 16; ++r) { const int orow = crow(r, hi);
#pragma unroll
            for (int d0 = 0; d0 < NCB; ++d0) Ow[(size_t)orow * 1024 + d0 * 32 + r32] = (bf16_t)(cvt_pk_bf16(o[d0][r] * rli[r], 0.f) & 0xffffu); }
#endif
    } else {
        __syncthreads();
        LAS float* Ost = (LAS float*)lds;
#pragma unroll
        for (int r = 0; r < 16; ++r) { const int row = mp * 128 + qw * 32 + crow(r, hi);
#pragma unroll
            for (int d0 = 0; d0 < NCB; ++d0) Ost[row * 128 + d0 * 32 + r32] = o[d0][r] * rli[r]; }
        __syncthreads();
        const float g0 = gsub[2 * lane], g1 = gsub[2 * lane + 1];
        { long dk = Kn - Kh, dv = Vn - Vh; asm volatile("" : "+s"(dk), "+s"(dv)); STAGE_LOAD_AT(Kh + dk, Vh + dv, -1); }
#pragma unroll 4
        for (int k = 0; k < 16; ++k) { const int row = wid * 16 + k;
            const f32x2 a = *(const LAS f32x2*)(Ost + row * 128 + 2 * lane), b2 = *(const LAS f32x2*)(Ost + (128 + row) * 128 + 2 * lane);
            const float d0 = a.x - lam * b2.x, d1 = a.y - lam * b2.y;
            const float ss = wave_sum(d0 * d0 + d1 * d1);
            const float rs = (fast_rsq(ss * (1.0f / 128.0f) + EPS)) * (1.0f - LAMBDA_INIT);
            *(unsigned*)(Ou + (size_t)row * 1024 + 2 * lane) = cvt_pk_bf16(d0 * rs * g0, d1 * rs * g1); }
    }
#undef STAGE_LOAD
#undef STAGE_LOAD_AT
#undef STAGE_WRITE
}
template <int MODE>
__device__ __forceinline__ void attn_prefetch(const bf16_t* __restrict__ Qu, const bf16_t* __restrict__ Kh, const bf16_t* __restrict__ Vh, int wave, bf16x8 (&qr)[AU<MODE>::NQ], bf16x8 (&sr_)[AU<MODE>::NLD]) {
    constexpr int DV = MODE ? 128 : 64, LDQ = MODE ? 128 : 96, LDK = MODE ? 128 : 96, LDV = DV;
    constexpr int KCPR = LDK / 8, VCPR = LDV / 8, NKCH = 64 * KCPR, NCH = NKCH + 64 * VCPR, NLD = AU<MODE>::NLD, NQ = AU<MODE>::NQ, NST = AU<MODE>::NST;
    int tid_ = wave * 64 + lane_id(); asm volatile("" : "+v"(tid_));
    const int tid = tid_, wid = wave, lane = tid & 63, r32 = lane & 31, hi = lane >> 5;
    const int mp = MODE ? (wid >> 2) : 0, qw = MODE ? (wid & 3) : wid;
    const int qoff = (qw * 32 + r32) * LDQ + mp * 64 + hi * 8;
#pragma unroll
    for (int d0 = 0; d0 < NQ; ++d0) qr[d0] = *(const bf16x8*)(Qu + qoff + d0 * 16);
    if ((NST == 512) || wid < 4)
#pragma unroll
    for (int i = 0; i < NLD; ++i) { int c = (tid & (NST - 1)) + NST * i; if (c >= NCH) c -= NCH;
        const bool isk = MODE ? (i < 2) : (NST == 256 ? (i < NKCH / NST) : ((i == 0) || ((i == 1) == (wid < 4))));
        unsigned vo; if (c < NKCH) { const int row = c / KCPR, ch = c % KCPR; vo = (row * LDK + ch * 8) * 2; } else { const int c2 = c - NKCH; const int row = c2 / VCPR, ch = c2 % VCPR; vo = (row * LDV + ch * 8) * 2; }
        sr_[i] = *(const bf16x8*)((isk ? (const char*)Kh : (const char*)(Vh - 64 * LDV)) + vo); }
}
#undef PK4
#undef KSWZ
#undef SBAR
}

#ifndef DBG_STAMP_WAVE
#define DBG_STAMP_WAVE 0
#endif
#ifndef ATT_YOUNG_PRIO
#define ATT_YOUNG_PRIO 0
#endif
template <int ABL>
__device__ __forceinline__ void attn_phase(const Ctx& C, unsigned char* ws, const float* gsub) {
    const bf16_t* QM = (const bf16_t*)(ws + WS_QM); const bf16_t* KM = (const bf16_t*)(ws + WS_KM); const bf16_t* VM = (const bf16_t*)(ws + WS_VM);
    const bf16_t* QD = (const bf16_t*)(ws + WS_QD); const bf16_t* KD = (const bf16_t*)(ws + WS_KD); const bf16_t* VD = (const bf16_t*)(ws + WS_VD);
    bf16_t* OA = (bf16_t*)(ws + WS_OA); const float* KMX = (const float*)(ws + WS_KMAX);
    const float lam = *(const float*)(ws + WS_LAM);
#ifdef DBG_STAMP
    if (lane_id() == 0) ((LAS unsigned long long*)(C.lds + 139264))[C.wave] = 0ull;
#endif
#if ATT_YOUNG_PRIO
    if (C.wave >= 4) __builtin_amdgcn_s_setprio(1);
#endif
    if (!(ABL & 64)) {
        bf16x8 qrM[fa::AU<0>::NQ], srM[fa::AU<0>::NLD];
        { const int bh = C.xcd * 4; fa::attn_prefetch<0>(QM + ((size_t)bh * SEQ + C.slot * 256) * 96, KM + (size_t)bh * SK * 96, VM + (size_t)bh * SK * 64, C.wave, qrM, srM); }
#pragma unroll 1
        for (int r = 0; r < 4; ++r) {
            const int bh = C.xcd * 4 + r, b = bh >> 3, h = bh & 7, qb = C.slot;
            const float kmax = sqrtf(KMX[bh * 2] + KMX[bh * 2 + 1] + KMX[64 + b]);
            const int bn = r < 3 ? bh + 1 : bh;
            fa::attn_unit<0, ABL, 1>(C.lds, QM + ((size_t)bh * SEQ + qb * 256) * 96, KM + (size_t)bh * SK * 96, VM + (size_t)bh * SK * 64,
                             OA + ((size_t)b * SEQ + qb * 256) * 1024 + h * 64, kmax, kmax, lam, gsub, C.wave,
                             QM + ((size_t)bn * SEQ + qb * 256) * 96, KM + (size_t)bn * SK * 96, VM + (size_t)bn * SK * 64, qrM, srM);
        }
    }
    if (!(ABL & 128)) {
        bf16x8 qrD[fa::AU<1>::NQ], srD[fa::AU<1>::NLD];
        { const int bh = C.xcd * 2; fa::attn_prefetch<1>(QD + ((size_t)bh * SEQ + C.slot * 128) * 128, KD + (size_t)bh * SK * 128, VD + (size_t)bh * SK * 128, C.wave, qrD, srD); }
#pragma unroll 1
        for (int r = 0; r < 4; ++r) {
            const int bh = C.xcd * 2 + (r >> 1), b = bh >> 2, h = bh & 3, qb = (r & 1) * 32 + C.slot;
            const float km0 = sqrtf(KMX[68 + bh * 4] + KMX[68 + bh * 4 + 1]), km1 = sqrtf(KMX[68 + bh * 4 + 2] + KMX[68 + bh * 4 + 3]);
            const float qm0 = sqrtf(KMX[132 + bh * 4] + KMX[132 + bh * 4 + 1]), qm1 = sqrtf(KMX[132 + bh * 4 + 2] + KMX[132 + bh * 4 + 3]);
            const bf16_t* Qp = QD + ((size_t)bh * SEQ + qb * 128) * 128; bf16_t* Op = OA + ((size_t)b * SEQ + qb * 128) * 1024 + 512 + h * 128;
            const int rn = r < 3 ? r + 1 : r, bhn = C.xcd * 2 + (rn >> 1), qbn = (rn & 1) * 32 + C.slot;
            const bf16_t* Qn = QD + ((size_t)bhn * SEQ + qbn * 128) * 128; const bf16_t* Kn = KD + (size_t)bhn * SK * 128; const bf16_t* Vn = VD + (size_t)bhn * SK * 128;
            if (fmaxf(qm0 * km0, qm1 * km1) * 1.02f < 100.0f) fa::attn_unit<1, ABL, 0>(C.lds, Qp, KD + (size_t)bh * SK * 128, VD + (size_t)bh * SK * 128, Op, km0, km1, lam, gsub, C.wave, Qn, Kn, Vn, qrD, srD);
            else fa::attn_unit<1, ABL, 2>(C.lds, Qp, KD + (size_t)bh * SK * 128, VD + (size_t)bh * SK * 128, Op, km0, km1, lam, gsub, C.wave, Qn, Kn, Vn, qrD, srD);
        }
    }
#if ATT_YOUNG_PRIO
    __builtin_amdgcn_s_setprio(0);
#endif
    __syncthreads();
#ifdef DBG_STAMP
#ifndef DBG_STAMP_MULT
#define DBG_STAMP_MULT 2
#endif
    if (blockIdx.x == 0 && C.wave == DBG_STAMP_WAVE) { const unsigned long long a_ = ((LAS unsigned long long*)(C.lds + 139264))[C.wave]; const unsigned long long t0_ = __builtin_amdgcn_s_memtime();
        while (__builtin_amdgcn_s_memtime() - t0_ < a_ * (unsigned long long)DBG_STAMP_MULT) __builtin_amdgcn_s_sleep(8); }
    __syncthreads();
#endif
}

#if MK_NAIVE_ATTN
template <int MODE>
__global__ __launch_bounds__(256) void naive_attn(const bf16_t* __restrict__ Q, const bf16_t* __restrict__ K, const bf16_t* __restrict__ V, bf16_t* __restrict__ OA,
                                                  const float* __restrict__ lamp, const float* __restrict__ gsub) {
    constexpr int NH = MODE ? 4 : 8, DQK = MODE ? 64 : 96, LDQ = MODE ? 128 : 96, LDK = LDQ, DV = MODE ? 128 : 64, NMAP = MODE ? 2 : 1;
    const int lane = threadIdx.x & 63; const long gw = (long)blockIdx.x * 4 + (threadIdx.x >> 6);
    const int q = (int)(gw % SEQ); const int bh = (int)(gw / SEQ); const int b = bh / NH, h = bh % NH;
    const bf16_t* Qrow = Q + ((size_t)bh * SEQ + q) * LDQ; const bf16_t* Kh = K + (size_t)bh * SK * LDK; const bf16_t* Vh = V + (size_t)bh * SK * DV;
    float res0 = 0.f, res1 = 0.f; const float lam = *lamp;
    for (int mp = 0; mp < NMAP; ++mp) {
        u32x4 qp[DQK / 8];
#pragma unroll
        for (int i = 0; i < DQK / 8; ++i) qp[i] = *(const u32x4*)(Qrow + mp * 64 + 8 * i);
        float m = -1e30f, l = 0.f, acc0 = 0.f, acc1 = 0.f;
        for (int t = 0; t < SK / 64; ++t) {
            const bf16_t* kr = Kh + (size_t)(t * 64 + lane) * LDK + mp * 64; float s = 0.f;
#pragma unroll
            for (int i = 0; i < DQK / 8; ++i) { const u32x4 kv = *(const u32x4*)(kr + 8 * i);
                s += bf_lo(qp[i].x) * bf_lo(kv.x) + bf_hi(qp[i].x) * bf_hi(kv.x) + bf_lo(qp[i].y) * bf_lo(kv.y) + bf_hi(qp[i].y) * bf_hi(kv.y)
                   + bf_lo(qp[i].z) * bf_lo(kv.z) + bf_hi(qp[i].z) * bf_hi(kv.z) + bf_lo(qp[i].w) * bf_lo(kv.w) + bf_hi(qp[i].w) * bf_hi(kv.w); }
            const float mn = fmaxf(m, wave_max(s)); const float alpha = exp2f(m - mn); const float p = exp2f(s - mn);
            l = l * alpha + wave_sum(p); acc0 *= alpha; acc1 *= alpha; m = mn;
            for (int kk = 0; kk < 64; ++kk) { const float pk = __shfl(p, kk); const bf16_t* vr = Vh + (size_t)(t * 64 + kk) * DV;
                acc0 += pk * bf2f(vr[lane]); if (DV == 128) acc1 += pk * bf2f(vr[64 + lane]); }
        }
        const float il = 1.0f / l;
        if (mp == 0) { res0 = acc0 * il; res1 = acc1 * il; } else { res0 -= lam * acc0 * il; res1 -= lam * acc1 * il; }
    }
    if (MODE == 0) { OA[((size_t)b * SEQ + q) * 1024 + h * 64 + lane] = (bf16_t)(cvt_pk_bf16(res0, 0.f) & 0xffffu); }
    else { const float ss = wave_sum(res0 * res0 + res1 * res1); const float rs = (fast_rsq(ss * (1.0f / 128.0f) + EPS)) * (1.0f - LAMBDA_INIT);
        bf16_t* o = OA + ((size_t)b * SEQ + q) * 1024 + 512 + h * 128;
        o[lane] = (bf16_t)(cvt_pk_bf16(res0 * rs * gsub[lane], 0.f) & 0xffffu); o[64 + lane] = (bf16_t)(cvt_pk_bf16(res1 * rs * gsub[64 + lane], 0.f) & 0xffffu); }
}
#endif
namespace fa16 {
using fa::VOFF; using fa::KOFF; using fa::BUFB; using fa::WSOFF; using fa::vtr; using fa::v_st; using fa::AU;
#define KSWZ(row, colB) ((row) * 256 + ((colB) ^ (((row) & 15) << 4)))
#define SBAR() __builtin_amdgcn_sched_barrier(0)
#ifdef ATT_NOSGB
#define SGB(mask, n) do { } while (0)
#else
#define SGB(mask, n) __builtin_amdgcn_sched_group_barrier(mask, n, 0)
#endif
#ifndef ATT16_KAH
#define ATT16_KAH 3
#endif
#ifndef ATT16_VAH
#define ATT16_VAH 4
#endif
#ifndef ATT16_FRONT
#define ATT16_FRONT 8
#endif
__device__ __forceinline__ f32x4 mfma16(bf16x8 a, bf16x8 b, f32x4 c) { return __builtin_amdgcn_mfma_f32_16x16x32_bf16(a, b, c, 0, 0, 0); }
__device__ __forceinline__ bf16x8 pack8f(const f32x4& a, const f32x4& b) { const u32x4 w = {cvt_pk_bf16(a[0], a[1]), cvt_pk_bf16(a[2], a[3]), cvt_pk_bf16(b[0], b[1]), cvt_pk_bf16(b[2], b[3])}; return __builtin_bit_cast(bf16x8, w); }

template <int NQK, int NDT, bool DOQK, bool DOPV, int SHIFT>
__device__ __forceinline__ void tile_step16(f32x4 (&c)[4][2], f32x4 (&p)[4][2], f32x4 (&o)[2][NDT], float (&ls)[2], const LAS unsigned char* Kb, const int (&ka)[NQK],
                                            const bf16x8 (&qr)[NQK][2], const float (&negm)[2], const float (&msub)[2], const LAS unsigned char* Vb) {
    constexpr int NCB = NDT / 2, NG = 8 * NQK, NM = 4 * NDT;
    SBAR();
    if constexpr (DOQK) {
#pragma unroll
        for (int ks = 0; ks < NQK; ++ks)
#pragma unroll
            for (int kt = 0; kt < 4; ++kt) { const bf16x8 kf = *(const LAS bf16x8*)(Kb + ka[ks] + kt * 4096);
#pragma unroll
                for (int qt = 0; qt < 2; ++qt) {
                    if (ks == 0) { const float ini = (SHIFT == 1) ? negm[qt] : 0.f; const f32x4 c0 = {ini, ini, ini, ini}; c[kt][qt] = mfma16(kf, qr[ks][qt], c0); }
                    else c[kt][qt] = mfma16(kf, qr[ks][qt], c[kt][qt]); } }
    }
    if constexpr (DOPV) {
#pragma unroll
        for (int kt = 0; kt < 4; ++kt)
#pragma unroll
            for (int qt = 0; qt < 2; ++qt)
#pragma unroll
                for (int j = 0; j < 4; ++j) { const float e = fast_exp2(p[kt][qt][j] - msub[qt]); p[kt][qt][j] = e; ls[qt] += e; }
        bf16x8 pa[2][2];
#pragma unroll
        for (int pb = 0; pb < 2; ++pb)
#pragma unroll
            for (int qt = 0; qt < 2; ++qt) pa[qt][pb] = pack8f(p[2 * pb][qt], p[2 * pb + 1][qt]);
#define VO16(pb, dvt, half) ((4 * (pb) + 2 * (half)) * NCB * 512 + ((dvt) >> 1) * 512 + ((dvt) & 1) * 32)
#pragma unroll
        for (int pb = 0; pb < 2; ++pb)
#pragma unroll
            for (int dvt = 0; dvt < NDT; ++dvt) { const s16x4 vl = vtr(Vb + VO16(pb, dvt, 0)), vh = vtr(Vb + VO16(pb, dvt, 1));
                const bf16x8 vf = (bf16x8){vl[0], vl[1], vl[2], vl[3], vh[0], vh[1], vh[2], vh[3]};
#pragma unroll
                for (int qt = 0; qt < 2; ++qt) o[qt][dvt] = mfma16(vf, pa[qt][pb], o[qt][dvt]); }
#undef VO16
    }
    constexpr int VPER = (SHIFT == 2) ? 1 : 0;
    constexpr int FRONT = DOQK ? ATT16_FRONT : 32;
    constexpr int NKF = 4 * NQK, KFIRST = (ATT16_KAH >= NKF) ? NKF : ATT16_KAH, VAH = ATT16_VAH;
    if constexpr (DOQK) SGB(0x100, KFIRST);
    if constexpr (DOPV && FRONT > 0) { SGB(0x400, FRONT); if constexpr (VPER > 0) SGB(0x002, FRONT * VPER); }
    if constexpr (DOQK) {
        constexpr int PER = (32 - FRONT + NG - 1) / NG;
#pragma unroll
        for (int g = 0; g < NG; ++g) {
            if ((g & 1) == 0 && KFIRST + (g >> 1) < NKF) SGB(0x100, 1);
            SGB(0x008, 1);
            if constexpr (DOPV) { if constexpr (PER > 0) { SGB(0x400, PER); if constexpr (VPER > 0) SGB(0x002, PER * VPER); } if (g >= NG - 4) SGB(0x100, (2 * VAH) / 4); }
        }
    }
    if constexpr (DOPV) {
        if constexpr (!DOQK) SGB(0x100, 2 * VAH);
        SGB(0x002, 8);
#pragma unroll
        for (int idx = 0; idx < NM; ++idx) {
            if ((idx & 1) == 0 && (idx >> 1) + VAH < 2 * NDT) SGB(0x100, 2);
            SGB(0x008, 1);
            if (idx < 4) SGB(0x002, 2);
        }
    }
    if constexpr (DOQK) {
#pragma unroll
        for (int kt = 0; kt < 4; ++kt) asm volatile("" : "+v"(c[kt][0]), "+v"(c[kt][1]));
    }
    if constexpr (DOPV) {
#pragma unroll
        for (int d = 0; d < NDT; ++d) asm volatile("" : "+v"(o[0][d]), "+v"(o[1][d]));
        asm volatile("" : "+v"(ls[0]), "+v"(ls[1]));
    }
    SBAR();
}

template <int MODE> struct AU16 { static constexpr int NQK = (MODE ? 64 : 96) / 32; };

template <int MODE>
__device__ __forceinline__ void attn_prefetch16(const bf16_t* __restrict__ Qu, const bf16_t* __restrict__ Kh, const bf16_t* __restrict__ Vh, int wave, bf16x8 (&qr)[AU16<MODE>::NQK][2], bf16x8 (&sr_)[AU<MODE>::NLD]) {
    constexpr int DV = MODE ? 128 : 64, LDQ = MODE ? 128 : 96, LDK = MODE ? 128 : 96, LDV = DV;
    constexpr int KCPR = LDK / 8, VCPR = LDV / 8, NKCH = 64 * KCPR, NCH = NKCH + 64 * VCPR, NLD = AU<MODE>::NLD, NQK = AU16<MODE>::NQK, NST = AU<MODE>::NST;
    int tid_ = wave * 64 + lane_id(); asm volatile("" : "+v"(tid_));
    const int tid = tid_, wid = wave, lane = tid & 63, l16 = lane & 15, g = lane >> 4;
    const int mp = MODE ? (wid >> 2) : 0, qw = MODE ? (wid & 3) : wid;
    const int qoff = (qw * 32 + l16) * LDQ + mp * 64 + g * 8;
#pragma unroll
    for (int ks = 0; ks < NQK; ++ks)
#pragma unroll
        for (int qt = 0; qt < 2; ++qt) qr[ks][qt] = *(const bf16x8*)(Qu + qoff + qt * 16 * LDQ + ks * 32);
    if ((NST == 512) || wid < 4)
#pragma unroll
    for (int i = 0; i < NLD; ++i) { int cc = (tid & (NST - 1)) + NST * i; if (cc >= NCH) cc -= NCH;
        const bool isk = MODE ? (i < 2) : (NST == 256 ? (i < NKCH / NST) : ((i == 0) || ((i == 1) == (wid < 4))));
        unsigned vo; if (cc < NKCH) { const int row = cc / KCPR, ch = cc % KCPR; vo = (row * LDK + ch * 8) * 2; } else { const int c2 = cc - NKCH; const int row = c2 / VCPR, ch = c2 % VCPR; vo = (row * LDV + ch * 8) * 2; }
        sr_[i] = *(const bf16x8*)((isk ? (const char*)Kh : (const char*)(Vh - 64 * LDV)) + vo); }
}

template <int MODE, int SHIFT>
__device__ __forceinline__ void attn_unit16(LAS unsigned char* lds, const bf16_t* __restrict__ Qu, const bf16_t* __restrict__ Kh, const bf16_t* __restrict__ Vh, bf16_t* Ou,
                                            float kmax0, float kmax1, float lam, const float* __restrict__ gsub, int wave,
                                            const bf16_t* __restrict__ Qn, const bf16_t* __restrict__ Kn, const bf16_t* __restrict__ Vn, bf16x8 (&qr)[AU16<MODE>::NQK][2], bf16x8 (&sr_)[AU<MODE>::NLD]) {
    constexpr int DQK = MODE ? 64 : 96, DV = MODE ? 128 : 64, LDQ = MODE ? 128 : 96, LDK = MODE ? 128 : 96, LDV = DV;
    constexpr int KCPR = LDK / 8, VCPR = LDV / 8, NKCH = 64 * KCPR, NCH = NKCH + 64 * VCPR, NST = AU<MODE>::NST, NLD = AU<MODE>::NLD, NCB = DV / 32, NDT = DV / 16, NQK = DQK / 32, NT = SK / 64;
    int tid_ = wave * 64 + lane_id(); asm volatile("" : "+v"(tid_));
    const int tid = tid_, wid = wave, lane = tid & 63, l16 = lane & 15, g = lane >> 4;
    const int mp = MODE ? (wid >> 2) : 0, qw = MODE ? (wid & 3) : wid;
    f32x4 o[2][NDT];
#pragma unroll
    for (int qt = 0; qt < 2; ++qt)
#pragma unroll
        for (int d = 0; d < NDT; ++d) o[qt][d] = (f32x4){0.f, 0.f, 0.f, 0.f};
    const int qoff = (qw * 32 + l16) * LDQ + mp * 64 + g * 8;
    float negm[2], msub[2];
#pragma unroll
    for (int qt = 0; qt < 2; ++qt) { float qss = 0.f;
#pragma unroll
        for (int ks = 0; ks < NQK; ++ks)
#pragma unroll
            for (int j = 0; j < 8; ++j) { const float v = bf2f((bf16_t)qr[ks][qt][j]); qss += v * v; }
        qss = sum_fq(qss);
        const float Mrow = 1.02f * sqrtf(qss) * (mp ? kmax1 : kmax0) + 0.5f;
        negm[qt] = (SHIFT == 1) ? -Mrow : 0.f; msub[qt] = (SHIFT == 2) ? Mrow : 0.f; }
    unsigned voff[NLD]; int dst[NLD]; bool isk[NLD];
    const bool stg = (NST == 512) || wid < 4;
#pragma unroll
    for (int i = 0; i < NLD; ++i) { int cc = (tid & (NST - 1)) + NST * i; if (cc >= NCH) cc -= NCH;
        if (MODE) isk[i] = (i < 2); else if (NST == 256) isk[i] = (i < NKCH / NST); else isk[i] = (i == 0) || ((i == 1) == (wid < 4));
        if (cc < NKCH) { const int row = cc / KCPR, ch = cc % KCPR; voff[i] = (row * LDK + ch * 8) * 2; dst[i] = KOFF + BUFB + KSWZ(row, ch * 16); }
        else { const int c2 = cc - NKCH; const int row = c2 / VCPR, ch = c2 % VCPR; voff[i] = (row * LDV + ch * 8) * 2; dst[i] = VOFF + v_st<NCB>(row, ch * 8); } }
    int ka[NQK];
#pragma unroll
    for (int ks = 0; ks < NQK; ++ks) ka[ks] = KSWZ(l16, mp * 128 + ks * 64 + g * 16);
    const int vrd = ((g >> 1) * NCB) * 512 + ((4 * (g & 1) + (l16 >> 2)) * 32 + (l16 & 3) * 4) * 2;
    const LAS unsigned char* Kb0 = lds + KOFF; const LAS unsigned char* Vb0 = lds + VOFF + vrd;
#define STAGE_LOAD_AT(KB, VB, j) do { if (stg) { const char* kb_ = (const char*)((KB) + (long)((j) + 1) * (64 * LDK)); const char* vb_ = (const char*)((VB) + (long)(j) * (64 * LDV)); \
        _Pragma("unroll") for (int i_ = 0; i_ < NLD; ++i_) sr_[i_] = *(const bf16x8*)((isk[i_] ? kb_ : vb_) + voff[i_]); } } while (0)
#define STAGE_LOAD(j) STAGE_LOAD_AT(Kh, Vh, j)
#define STAGE_WRITE(jodd) do { if (stg) { _Pragma("unroll") for (int i_ = 0; i_ < NLD; ++i_) *(LAS bf16x8*)(lds + (dst[i_] ^ ((jodd) ? BUFB : 0))) = sr_[i_]; } } while (0)
    f32x4 sA[4][2], sB[4][2]; float ls[2] = {0.f, 0.f};
    __syncthreads();
    STAGE_WRITE(1); STAGE_LOAD(0);
    __syncthreads();
    STAGE_WRITE(0); STAGE_LOAD(1);
    tile_step16<NQK, NDT, true, false, SHIFT>(sA, sA, o, ls, Kb0, ka, qr, negm, msub, Vb0);
    __syncthreads();
#define ITER(C, P, todd, t) do { \
        STAGE_WRITE(todd); STAGE_LOAD((t) + 1); \
        tile_step16<NQK, NDT, true, true, SHIFT>(C, P, o, ls, Kb0 + ((todd) ? BUFB : 0), ka, qr, negm, msub, Vb0 + ((todd) ? 0 : BUFB)); \
        __syncthreads(); } while (0)
    for (int t = 1; t + 1 < NT; t += 2) {
        ITER(sB, sA, 1, t);
        ITER(sA, sB, 0, t + 1);
    }
    {
        STAGE_WRITE(1);
        if constexpr (MODE == 0) { long dk = Kn - Kh, dv = Vn - Vh; asm volatile("" : "+s"(dk), "+s"(dv)); STAGE_LOAD_AT(Kh + dk, Vh + dv, -1); }
        tile_step16<NQK, NDT, true, true, SHIFT>(sB, sA, o, ls, Kb0 + BUFB, ka, qr, negm, msub, Vb0);
        { long dq = Qn - Qu; asm volatile("" : "+s"(dq));
#pragma unroll
          for (int ks = 0; ks < NQK; ++ks)
#pragma unroll
              for (int qt = 0; qt < 2; ++qt) qr[ks][qt] = *(const bf16x8*)(Qu + dq + qoff + qt * 16 * LDQ + ks * 32); }
        __syncthreads(); }
    tile_step16<NQK, NDT, false, true, SHIFT>(sB, sB, o, ls, Kb0, ka, qr, negm, msub, Vb0 + BUFB);
#undef ITER
    float rl[2];
#pragma unroll
    for (int qt = 0; qt < 2; ++qt) rl[qt] = fast_rcp(sum_fq(ls[qt]));
    if constexpr (MODE == 0) {
        bf16_t* Ow = Ou + (size_t)(wid * 32) * 1024;
#pragma unroll
        for (int qt = 0; qt < 2; ++qt)
#pragma unroll
            for (int d = 0; d < NDT; ++d) { u32x2 w; w.x = cvt_pk_bf16(o[qt][d][0] * rl[qt], o[qt][d][1] * rl[qt]); w.y = cvt_pk_bf16(o[qt][d][2] * rl[qt], o[qt][d][3] * rl[qt]);
                *(u32x2*)(Ow + (size_t)(qt * 16 + l16) * 1024 + d * 16 + 4 * g) = w; }
    } else {
        __syncthreads();
        LAS float* Ost = (LAS float*)lds;
#pragma unroll
        for (int qt = 0; qt < 2; ++qt) { const int row = mp * 128 + qw * 32 + qt * 16 + l16;
#pragma unroll
            for (int d = 0; d < NDT; ++d) *(LAS f32x4*)(Ost + row * 128 + d * 16 + 4 * g) = o[qt][d] * rl[qt]; }
        __syncthreads();
        const float g0 = gsub[2 * lane], g1 = gsub[2 * lane + 1];
        { long dk = Kn - Kh, dv = Vn - Vh; asm volatile("" : "+s"(dk), "+s"(dv)); STAGE_LOAD_AT(Kh + dk, Vh + dv, -1); }
#pragma unroll 4
        for (int k = 0; k < 16; ++k) { const int row = wid * 16 + k;
            const f32x2 a = *(const LAS f32x2*)(Ost + row * 128 + 2 * lane), b2 = *(const LAS f32x2*)(Ost + (128 + row) * 128 + 2 * lane);
            const float d0 = a.x - lam * b2.x, d1 = a.y - lam * b2.y;
            const float ss = wave_sum(d0 * d0 + d1 * d1);
            const float rs = (fast_rsq(ss * (1.0f / 128.0f) + EPS)) * (1.0f - LAMBDA_INIT);
            *(unsigned*)(Ou + (size_t)row * 1024 + 2 * lane) = cvt_pk_bf16(d0 * rs * g0, d1 * rs * g1); }
    }
#undef STAGE_LOAD
#undef STAGE_LOAD_AT
#undef STAGE_WRITE
}
#undef KSWZ
#undef SBAR
#undef SGB
}

#ifndef ATT16
#define ATT16 0
#endif
__device__ __forceinline__ void attn_phase16(const Ctx& C, unsigned char* ws, const float* gsub) {
    const bf16_t* QM = (const bf16_t*)(ws + WS_QM); const bf16_t* KM = (const bf16_t*)(ws + WS_KM); const bf16_t* VM = (const bf16_t*)(ws + WS_VM);
    const bf16_t* QD = (const bf16_t*)(ws + WS_QD); const bf16_t* KD = (const bf16_t*)(ws + WS_KD); const bf16_t* VD = (const bf16_t*)(ws + WS_VD);
    bf16_t* OA = (bf16_t*)(ws + WS_OA); const float* KMX = (const float*)(ws + WS_KMAX);
    const float lam = *(const float*)(ws + WS_LAM);
    {
#if (ATT16 & 1)
        bf16x8 qrM[fa16::AU16<0>::NQK][2], srM[fa::AU<0>::NLD];
        { const int bh = C.xcd * 4; fa16::attn_prefetch16<0>(QM + ((size_t)bh * SEQ + C.slot * 256) * 96, KM + (size_t)bh * SK * 96, VM + (size_t)bh * SK * 64, C.wave, qrM, srM); }
#else
        bf16x8 qrM[fa::AU<0>::NQ], srM[fa::AU<0>::NLD];
        { const int bh = C.xcd * 4; fa::attn_prefetch<0>(QM + ((size_t)bh * SEQ + C.slot * 256) * 96, KM + (size_t)bh * SK * 96, VM + (size_t)bh * SK * 64, C.wave, qrM, srM); }
#endif
#pragma unroll 1
        for (int r = 0; r < 4; ++r) {
            const int bh = C.xcd * 4 + r, b = bh >> 3, h = bh & 7, qb = C.slot;
            const float kmax = sqrtf(KMX[bh * 2] + KMX[bh * 2 + 1] + KMX[64 + b]);
            const int bn = r < 3 ? bh + 1 : bh;
#if (ATT16 & 1)
            fa16::attn_unit16<0, 1>(
#else
            fa::attn_unit<0, 0, 1>(
#endif
                             C.lds, QM + ((size_t)bh * SEQ + qb * 256) * 96, KM + (size_t)bh * SK * 96, VM + (size_t)bh * SK * 64,
                             OA + ((size_t)b * SEQ + qb * 256) * 1024 + h * 64, kmax, kmax, lam, gsub, C.wave,
                             QM + ((size_t)bn * SEQ + qb * 256) * 96, KM + (size_t)bn * SK * 96, VM + (size_t)bn * SK * 64, qrM, srM);
        }
    }
    {
#if (ATT16 & 2)
        bf16x8 qrD[fa16::AU16<1>::NQK][2], srD[fa::AU<1>::NLD];
        { const int bh = C.xcd * 2; fa16::attn_prefetch16<1>(QD + ((size_t)bh * SEQ + C.slot * 128) * 128, KD + (size_t)bh * SK * 128, VD + (size_t)bh * SK * 128, C.wave, qrD, srD); }
#else
        bf16x8 qrD[fa::AU<1>::NQ], srD[fa::AU<1>::NLD];
        { const int bh = C.xcd * 2; fa::attn_prefetch<1>(QD + ((size_t)bh * SEQ + C.slot * 128) * 128, KD + (size_t)bh * SK * 128, VD + (size_t)bh * SK * 128, C.wave, qrD, srD); }
#endif
#pragma unroll 1
        for (int r = 0; r < 4; ++r) {
            const int bh = C.xcd * 2 + (r >> 1), b = bh >> 2, h = bh & 3, qb = (r & 1) * 32 + C.slot;
            const float km0 = sqrtf(KMX[68 + bh * 4] + KMX[68 + bh * 4 + 1]), km1 = sqrtf(KMX[68 + bh * 4 + 2] + KMX[68 + bh * 4 + 3]);
            const float qm0 = sqrtf(KMX[132 + bh * 4] + KMX[132 + bh * 4 + 1]), qm1 = sqrtf(KMX[132 + bh * 4 + 2] + KMX[132 + bh * 4 + 3]);
            const bf16_t* Qp = QD + ((size_t)bh * SEQ + qb * 128) * 128; bf16_t* Op = OA + ((size_t)b * SEQ + qb * 128) * 1024 + 512 + h * 128;
            const int rn = r < 3 ? r + 1 : r, bhn = C.xcd * 2 + (rn >> 1), qbn = (rn & 1) * 32 + C.slot;
            const bf16_t* Qn = QD + ((size_t)bhn * SEQ + qbn * 128) * 128; const bf16_t* Kn = KD + (size_t)bhn * SK * 128; const bf16_t* Vn = VD + (size_t)bhn * SK * 128;
            const bf16_t* Kp = KD + (size_t)bh * SK * 128; const bf16_t* Vp = VD + (size_t)bh * SK * 128;
#if (ATT16 & 2)
            if (fmaxf(qm0 * km0, qm1 * km1) * 1.02f < 100.0f) fa16::attn_unit16<1, 0>(C.lds, Qp, Kp, Vp, Op, km0, km1, lam, gsub, C.wave, Qn, Kn, Vn, qrD, srD);
            else fa16::attn_unit16<1, 2>(C.lds, Qp, Kp, Vp, Op, km0, km1, lam, gsub, C.wave, Qn, Kn, Vn, qrD, srD);
#else
            if (fmaxf(qm0 * km0, qm1 * km1) * 1.02f < 100.0f) fa::attn_unit<1, 0, 0>(C.lds, Qp, Kp, Vp, Op, km0, km1, lam, gsub, C.wave, Qn, Kn, Vn, qrD, srD);
            else fa::attn_unit<1, 0, 2>(C.lds, Qp, Kp, Vp, Op, km0, km1, lam, gsub, C.wave, Qn, Kn, Vn, qrD, srD);
#endif
        }
    }
    __syncthreads();
}
__device__ __forceinline__ int invperm64(int d) { const int a = d >> 5, half = (d >> 4) & 1, i = d & 15; return (a * 4 + (i >> 2)) * 8 + half * 4 + (i & 3); }
__device__ __forceinline__ int invperm32(int d) { const int a = d >> 4, half = (d >> 3) & 1, i = d & 7; return (a * 2 + (i >> 2)) * 8 + half * 4 + (i & 3); }
struct MapWin { __device__ __forceinline__ int operator()(int n) const {
    if (n < 384) return n;
    if (n < 416) return 384 + invperm32(n - 384);
    if (n < 1440) { const int isk = n >= 928; const int rel = n - (isk ? 928 : 416); return (isk ? 1024 : 512) + (rel & ~63) + invperm64(rel & 63); }
    if (n < 1952) return 1536 + (n - 1440);
    { const int g = n - 1952, isb = g >> 10, c = g & 1023; return 2048 + (c >> 7) * 256 + isb * 128 + (c & 127); } } };
struct MapUq { __device__ __forceinline__ int operator()(int n) const { const int h = n / 96, d = n - 96 * h; return d < 64 ? n : h * 96 + 64 + invperm32(d - 64); } };
struct MapId { int off; __device__ __forceinline__ int operator()(int n) const { return off + n; } };
struct MapW13 { int off; __device__ __forceinline__ int operator()(int f) const { return off + (f >> 7) * 256 + (f & 127); } };

struct TrSrc { const float* W; int ldw, k0, n0; };
__device__ __forceinline__ void tr_load(const TrSrc& t, f32x4 (&v)[8], int lane) {
#pragma unroll
    for (int i = 0; i < 8; ++i) v[i] = *(const f32x4*)(t.W + (size_t)(t.k0 + 8 * i + (lane >> 3)) * t.ldw + t.n0 + (lane & 7) * 4);
}
template <class RM>
__device__ __forceinline__ void tr_store(f32x4 (&v)[8], int k0, int n0, bf16_t* WT, int ldt, int kdst0, const float* kscale, RM rm, LAS float* scr, int lane) {
#pragma unroll
    for (int i = 0; i < 8; ++i) { const int kk = 8 * i + (lane >> 3); f32x4 w = v[i]; if (kscale) w = w * kscale[k0 + kk]; LAS float* d = scr + kk * 33 + (lane & 7) * 4;
        d[0] = w[0]; d[1] = w[1]; d[2] = w[2]; d[3] = w[3]; }
    asm volatile("s_waitcnt lgkmcnt(0)" ::: "memory");
    const int c = lane & 7;
#pragma unroll
    for (int j = 0; j < 4; ++j) { const int n = (lane >> 3) + 8 * j; const LAS float* s = scr + (8 * c) * 33 + n;
        u32x4 o; o.x = cvt_pk_bf16(s[0 * 33], s[1 * 33]); o.y = cvt_pk_bf16(s[2 * 33], s[3 * 33]); o.z = cvt_pk_bf16(s[4 * 33], s[5 * 33]); o.w = cvt_pk_bf16(s[6 * 33], s[7 * 33]);
        *(u32x4*)(WT + (size_t)rm(n0 + n) * ldt + kdst0 + k0 + 8 * c) = o; }
    asm volatile("s_waitcnt lgkmcnt(0)" ::: "memory");
}
template <class RM>
__device__ __forceinline__ void tr_item(const float* __restrict__ W, int ldw, int k0, int n0, bf16_t* WT, int ldt, int kdst0, const float* kscale, RM rm, LAS float* scr, int lane) {
    f32x4 v[8]; tr_load(TrSrc{W, ldw, k0, n0}, v, lane); tr_store(v, k0, n0, WT, ldt, kdst0, kscale, rm, scr, lane);
}
namespace p0i { constexpr int I_IN = 16 * 125, I_UQ = 4 * 24, I_UKV = 2 * 32, I_OM = 8 * 32, I_OD = 8 * 32, I_OUT = 16 * 32, I_E = 16 * 16 * 32;
    constexpr int NITEMS = I_IN + I_UQ + I_UKV + I_OM + I_OD + I_OUT + 2 * I_E; }
__device__ __forceinline__ TrSrc p0_item_src(KA A, int it) {
    using namespace p0i; int r = it;
    if (r < I_IN) return TrSrc{A->in[6], NIN, 64 * (r / 125), 32 * (r % 125)}; r -= I_IN;
    if (r < I_UQ) return TrSrc{A->in[8], 768, 64 * (r / 24), 32 * (r % 24)}; r -= I_UQ;
    if (r < I_UKV) return TrSrc{A->in[10], 1024, 64 * (r / 32), 32 * (r % 32)}; r -= I_UKV;
    if (r < I_OM) return TrSrc{A->in[11], 1024, 64 * (r / 32), 32 * (r % 32)}; r -= I_OM;
    if (r < I_OD) return TrSrc{A->in[14], 1024, 64 * (r / 32), 32 * (r % 32)}; r -= I_OD;
    if (r < I_OUT) return TrSrc{A->in[15], 1024, 64 * (r / 32), 32 * (r % 32)}; r -= I_OUT;
    const int which = r / I_E; r -= which * I_E; const int e = r / 512, q = r % 512;
    return TrSrc{(which == 0 ? A->in[20] : A->in[21]) + (size_t)e * 1024 * 1024, 1024, 64 * (q / 32), 32 * (q % 32)};
}
__device__ __forceinline__ void p0_item_store(KA A, unsigned char* ws, int it, f32x4 (&v)[8], LAS float* scr, int lane) {
    using namespace p0i; int r = it;
    if (r < I_IN) { tr_store(v, 64 * (r / 125), 32 * (r % 125), (bf16_t*)(ws + WS_WIN), 1024, 0, nullptr, MapWin{}, scr, lane); return; } r -= I_IN;
    if (r < I_UQ) { tr_store(v, 64 * (r / 24), 32 * (r % 24), (bf16_t*)(ws + WS_WUQ), 256, 0, A->in[7], MapUq{}, scr, lane); return; } r -= I_UQ;
    if (r < I_UKV) { tr_store(v, 64 * (r / 32), 32 * (r % 32), (bf16_t*)(ws + WS_WUKV), 256, 0, A->in[9], MapId{0}, scr, lane); return; } r -= I_UKV;
    if (r < I_OM) { tr_store(v, 64 * (r / 32), 32 * (r % 32), (bf16_t*)(ws + WS_WOC), 1024, 0, nullptr, MapId{0}, scr, lane); return; } r -= I_OM;
    if (r < I_OD) { tr_store(v, 64 * (r / 32), 32 * (r % 32), (bf16_t*)(ws + WS_WOC), 1024, 512, nullptr, MapId{0}, scr, lane); return; } r -= I_OD;
    if (r < I_OUT) { tr_store(v, 64 * (r / 32), 32 * (r % 32), (bf16_t*)(ws + WS_WOUT), 1024, 0, nullptr, MapId{0}, scr, lane); return; } r -= I_OUT;
    const int which = r / I_E; r -= which * I_E; const int e = r / 512, q = r % 512;
    tr_store(v, 64 * (q / 32), 32 * (q % 32), (bf16_t*)(ws + WS_W13), 1024, 0, nullptr, MapW13{e * 2048 + (which ? 128 : 0)}, scr, lane);
}

#ifndef P0_SHARE_BUSY
#define P0_SHARE_BUSY 5
#endif
__device__ __forceinline__ void p0_prologue(const Ctx& C0, KA A, unsigned* modcnt) {
    Ctx C = C0; C.tid = C.wave * 64 + lane_id(); asm volatile("" : "+v"(C.tid)); C.lane = C.tid & 63;
    unsigned char* ws = A->ws;
    const float* cvec = A->in[1]; const float* cctx = A->in[3]; const float* w_ada = A->in[4]; const float* b_ada = A->in[5];
#ifdef DBG_P0PART
    unsigned long long tp_[4]; tp_[0] = __builtin_amdgcn_s_memrealtime();
#endif
    if (C.vcu < 96) {
        LAS float* sl = (LAS float*)(C.lds + 86016);
        { float cvv[10];
#pragma unroll
          for (int k = 0; k < 10; ++k) { const int i = C.tid + NTHR * k; cvv[k] = (i < 4096) ? cvec[i] : cctx[i - 4096]; }
#pragma unroll
          for (int k = 0; k < 10; ++k) sl[C.tid + NTHR * k] = cvv[k] * sigmoidf_(cvv[k]); }
        __syncthreads();
        const int col = C.vcu * 64 + C.lane; float acc[5] = {0.f, 0.f, 0.f, 0.f, 0.f};
#pragma unroll 32
        for (int k = C.wave * 128; k < C.wave * 128 + 128; ++k) { const float wv = w_ada[(size_t)k * 6144 + col];
#pragma unroll
            for (int r = 0; r < 5; ++r) acc[r] += sl[r * 1024 + k] * wv; }
        LAS float* red = (LAS float*)(C.lds + 73728);
#pragma unroll
        for (int r = 0; r < 5; ++r) red[(C.wave * 5 + r) * 64 + C.lane] = acc[r];
        __syncthreads();
        if (C.tid < 320) { const int r = C.tid >> 6, l = C.tid & 63; float s = 0.f;
#pragma unroll
            for (int w = 0; w < 8; ++w) s += red[(w * 5 + r) * 64 + l];
            ((float*)(ws + WS_MOD))[r * 6144 + C.vcu * 64 + l] = s + b_ada[C.vcu * 64 + l]; }
        asm volatile("s_waitcnt vmcnt(0)" ::: "memory");
        __syncthreads();
        if (modcnt && C.tid == 0) dep_arrive(modcnt);
    }
#ifdef DBG_P0PART
    tp_[1] = __builtin_amdgcn_s_memrealtime();
#endif
    if (C.vcu == C.G - 1) {
        if (C.tid < 196) ((unsigned*)(ws + WS_KMAX))[C.tid] = 0u;
        float* rope = (float*)(ws + WS_ROPE);
        for (int i = C.tid; i < 2048; i += NTHR) { const int pos = i >> 4, f = i & 15; const float inv = exp2f(-(float)f * (13.287712379549449f / 16.0f)); const float ang = (float)pos * inv;
            rope[i] = cosf(ang); rope[2048 + i] = sinf(ang); }
        for (int i = C.tid; i < 1024; i += NTHR) { const int pos = i >> 3, f = i & 7; const float inv = exp2f(-(float)f * (13.287712379549449f / 8.0f)); const float ang = (float)pos * inv;
            rope[4096 + i] = cosf(ang); rope[5120 + i] = sinf(ang); }
        if (C.wave == 0) { const float* dl = A->in[12]; const float s1 = wave_sum(dl[C.lane] * dl[64 + C.lane]), s2 = wave_sum(dl[128 + C.lane] * dl[192 + C.lane]);
            if (C.lane == 0) *(float*)(ws + WS_LAM) = expf(s1) - expf(s2) + LAMBDA_INIT; }
    }
    LAS float* scr = (LAS float*)(C.lds + C.wave * 8448);
    {
        constexpr int NBUSY = 97, SHARE_BUSY = P0_SHARE_BUSY;
        constexpr int N_B = NBUSY * NWAVES * SHARE_BUSY;
        const bool busy = C.vcu < 96 || C.vcu == C.G - 1;
        const int widx = busy ? ((C.vcu < 96 ? C.vcu : 96) * NWAVES + C.wave) : ((C.vcu - 96) * NWAVES + C.wave);
        const int stride = busy ? NBUSY * NWAVES : (C.G - NBUSY) * NWAVES;
        const int first = busy ? widx : N_B + widx, end = busy ? N_B : p0i::NITEMS;
        f32x4 v[8];
        if (first < end) tr_load(p0_item_src(A, first), v, C.lane);
        for (int it = first; it < end; it += stride) {
            const int nx = (it + stride < end) ? it + stride : it;
            f32x4 vn[8]; tr_load(p0_item_src(A, nx), vn, C.lane);
            p0_item_store(A, ws, it, v, scr, C.lane);
#pragma unroll
            for (int i = 0; i < 8; ++i) v[i] = vn[i];
        }
    }
#ifdef DBG_P0PART
    tp_[2] = __builtin_amdgcn_s_memrealtime();
    if (blockIdx.x == 0) { const unsigned long long dt = (DBG_P0PART == 1) ? tp_[1] - tp_[0] : tp_[2] - tp_[1]; const unsigned long long until_ = tp_[2] + dt * 10ull;
        while (__builtin_amdgcn_s_memrealtime() < until_) __builtin_amdgcn_s_sleep(8); }
#endif
    const int gt = C.vcu * NTHR + C.tid, NGT = C.G * NTHR; const u32x4 z4 = {0u, 0u, 0u, 0u};
    for (int i = gt; i < 96 * 128; i += NGT) *(u32x4*)(ws + WS_WIN + (size_t)416 * 2048 + (size_t)i * 16) = z4;
    for (int i = gt; i < 1024 * 16; i += NGT) *(u32x4*)(ws + WS_WUKV + (size_t)(i >> 4) * 512 + 256 + (size_t)(i & 15) * 16) = z4;
}

__device__ __forceinline__ void mod_row(KA A, const float* mod, bf16_t* A1, int r, int lane) {
    const float* src = r < NCTX ? A->in[2] + (size_t)r * 1024 : A->in[0] + (size_t)(r - NCTX) * 1024;
    const float* sh = mod + (r < NCTX ? 4 : ((r - NCTX) >> 13)) * 6144; const float* sc = sh + 1024;
#pragma unroll
    for (int j = 0; j < 4; ++j) { const int d = 4 * lane + 256 * j; const f32x4 v = *(const f32x4*)(src + d), s = *(const f32x4*)(sc + d), h = *(const f32x4*)(sh + d);
        const f32x4 o = v * (s + 1.0f) + h; u32x2 w; w.x = cvt_pk_bf16(o[0], o[1]); w.y = cvt_pk_bf16(o[2], o[3]);
        *(u32x2*)(A1 + (size_t)r * 1024 + d) = w; }
}
__device__ __forceinline__ void p0b_modulate(const Ctx& C0, KA A, int bx, bool ctxsplit, unsigned* modcnt) {
    Ctx C = C0; C.tid = C.wave * 64 + lane_id(); asm volatile("" : "+v"(C.tid)); C.lane = C.tid & 63;
    if (modcnt) { if (C.wave == 0) dep_wait(modcnt, 96u); __syncthreads(); }
    const float* mod = (const float*)(A->ws + WS_MOD); bf16_t* A1 = (bf16_t*)(A->ws + WS_A1);
    if (!ctxsplit) {
        const int gw = C.vcu * NWAVES + C.wave, NGW = C.G * NWAVES;
        f32x4 xin[4];
        { const float* src = gw < NCTX ? A->in[2] + (size_t)gw * 1024 : A->in[0] + (size_t)(gw - NCTX) * 1024;
#pragma unroll
          for (int j = 0; j < 4; ++j) xin[j] = *(const f32x4*)(src + 4 * C.lane + 256 * j); }
        int cm = -1; f32x4 sv1[4], hv[4];
        for (int r = gw; r < MTOT; r += NGW) {
            const int mi = r < NCTX ? 4 : ((r - NCTX) >> 13);
            if (mi != cm) { cm = mi; const float* sh = mod + mi * 6144; const float* sc = sh + 1024;
#pragma unroll
                for (int j = 0; j < 4; ++j) { const int d = 4 * C.lane + 256 * j; sv1[j] = *(const f32x4*)(sc + d) + 1.0f; hv[j] = *(const f32x4*)(sh + d); } }
            f32x4 cur[4];
#pragma unroll
            for (int j = 0; j < 4; ++j) cur[j] = xin[j];
            { const int nr = (r + NGW < MTOT) ? r + NGW : r; const float* src = nr < NCTX ? A->in[2] + (size_t)nr * 1024 : A->in[0] + (size_t)(nr - NCTX) * 1024;
#pragma unroll
              for (int j = 0; j < 4; ++j) xin[j] = *(const f32x4*)(src + 4 * C.lane + 256 * j); }
#pragma unroll
            for (int j = 0; j < 4; ++j) { const int d = 4 * C.lane + 256 * j;
                const f32x4 o = cur[j] * sv1[j] + hv[j]; u32x2 w; w.x = cvt_pk_bf16(o[0], o[1]); w.y = cvt_pk_bf16(o[2], o[3]);
                *(u32x2*)(A1 + (size_t)r * 1024 + d) = w; }
        }
    } else if (bx < 20) {
        const int r0 = (bx / 5) * 256 + C.wave * 32;
        for (int r = r0; r < r0 + 32; ++r) mod_row(A, mod, A1, r, C.lane);
        __threadfence(); __syncthreads();
    } else {
        const int gw = (bx - 20) * NWAVES + C.wave, NGW = (C.G - 20) * NWAVES;
        for (int r = NCTX + gw; r < MTOT; r += NGW) mod_row(A, mod, A1, r, C.lane);
    }
}

#ifndef LN_FENCE
#define LN_FENCE 0
#endif
template <int ABL = 0>
__device__ __forceinline__ void p4_ln_router(const Ctx& C0, KA A) {
    Ctx C = C0; C.tid = C.wave * 64 + lane_id(); asm volatile("" : "+v"(C.tid)); C.lane = C.tid & 63;
    bf16_t* X1B = (bf16_t*)(A->ws + WS_X1B); const bf16_t* OL = (const bf16_t*)(A->ws + WS_OL); const float* X = A->in[0]; bf16_t* H2 = (bf16_t*)(A->ws + WS_H2); float* aff = (float*)(A->ws + WS_AFF); const float* mod = (const float*)(A->ws + WS_MOD);
    LAS float* wrt = (LAS float*)C.lds;
    LAS float* lgL = wrt + 16384; LAS float* lbL = lgL + 1024; LAS float* scL = lbL + 1024; LAS float* shL = scL + 4096;
    {
        f32x4 tw[8], tg, tb, ts[2], th[2]; const f32x4* wr4 = (const f32x4*)A->in[18];
#pragma unroll
        for (int k = 0; k < 8; ++k) tw[k] = wr4[C.tid + 512 * k];
        const int t4 = C.tid & 255; tg = ((const f32x4*)A->in[16])[t4]; tb = ((const f32x4*)A->in[17])[t4];
#pragma unroll
        for (int k = 0; k < 2; ++k) { const int i4 = C.tid + 512 * k, bb = i4 >> 8, dd = (i4 & 255) * 4; ts[k] = *(const f32x4*)(mod + bb * 6144 + 4 * 1024 + dd); th[k] = *(const f32x4*)(mod + bb * 6144 + 3 * 1024 + dd); }
#pragma unroll
        for (int k = 0; k < 8; ++k) { const int i4 = C.tid + 512 * k, dcol = i4 >> 2, e0 = (i4 & 3) * 4;
#pragma unroll
            for (int c = 0; c < 4; ++c) wrt[(e0 + c) * 1024 + dcol] = tw[k][c]; }
        if (C.tid < 256) { *(LAS f32x4*)(lgL + 4 * t4) = tg; *(LAS f32x4*)(lbL + 4 * t4) = tb; }
#pragma unroll
        for (int k = 0; k < 2; ++k) { const int i4 = C.tid + 512 * k; *(LAS f32x4*)(scL + 4 * i4) = ts[k] + 1.0f; *(LAS f32x4*)(shL + 4 * i4) = th[k]; }
    }
    __syncthreads();
    const int gw = C.vcu * NWAVES + C.wave, NGW = C.G * NWAVES;
    constexpr int NR = 2;
    f32x4 xin[NR][4]; u32x2 oin[NR][4];
#pragma unroll
    for (int r = 0; r < NR; ++r)
#pragma unroll
        for (int j = 0; j < 4; ++j) { const int d = 4 * C.lane + 256 * j; const size_t rw = (size_t)(gw + r * NGW) * 1024; xin[r][j] = *(const f32x4*)(X + rw + d); oin[r][j] = *(const u32x2*)(OL + rw + d); }
    const float rbias = A->in[19][(C.lane >> 2) & 15];
    for (int row = gw; row < NLAT; row += NR * NGW) {
        const int b = row >> 13;
        f32x4 v[NR][4]; float s[NR];
#pragma unroll
        for (int r = 0; r < NR; ++r) { s[r] = 0.f;
#pragma unroll
            for (int j = 0; j < 4; ++j) { v[r][j] = xin[r][j] * ALPHA + (f32x4){bf_lo(oin[r][j].x), bf_hi(oin[r][j].x), bf_lo(oin[r][j].y), bf_hi(oin[r][j].y)}; s[r] += (v[r][j][0] + v[r][j][1]) + (v[r][j][2] + v[r][j][3]); } }
        { const int nrow = (row + NR * NGW < NLAT) ? row + NR * NGW : row;
#pragma unroll
          for (int r = 0; r < NR; ++r)
#pragma unroll
              for (int j = 0; j < 4; ++j) { const int d = 4 * C.lane + 256 * j; const size_t rw = (size_t)(nrow + r * NGW) * 1024; xin[r][j] = *(const f32x4*)(X + rw + d); oin[r][j] = *(const u32x2*)(OL + rw + d); } }
        float rstd[NR];
#pragma unroll
        for (int r = 0; r < NR; ++r) { const float mean = wave_sum(s[r]) * (1.0f / 1024.0f); float s2 = 0.f;
#pragma unroll
            for (int j = 0; j < 4; ++j) { v[r][j] = v[r][j] - mean; s2 += sq4(v[r][j]); }
            rstd[r] = fast_rsq(wave_sum(s2) * (1.0f / 1024.0f) + EPS); }
#pragma unroll
        for (int j = 0; j < 4; ++j) { const int d = 4 * C.lane + 256 * j;
            const f32x4 lgj = *(const LAS f32x4*)(lgL + d), lbj = *(const LAS f32x4*)(lbL + d), scj = *(const LAS f32x4*)(scL + b * 1024 + d), shj = *(const LAS f32x4*)(shL + b * 1024 + d);
#pragma unroll
            for (int r = 0; r < NR; ++r) { const size_t rw = (size_t)(row + r * NGW) * 1024; const f32x4 x1 = v[r][j] * rstd[r] * lgj + lbj;
                { u32x2 w1; w1.x = cvt_pk_bf16(x1[0], x1[1]); w1.y = cvt_pk_bf16(x1[2], x1[3]); *(u32x2*)(X1B + rw + d) = w1; }
                const f32x4 h = x1 * scj + shj; v[r][j] = h;
                u32x2 w; w.x = cvt_pk_bf16(h[0], h[1]); w.y = cvt_pk_bf16(h[2], h[3]); *(u32x2*)(H2 + rw + d) = w; }
            asm volatile("" ::: "memory"); }
        const bool h5 = (C.lane & 32) != 0, h4 = (C.lane & 16) != 0, h3 = (C.lane & 8) != 0, h2b = (C.lane & 4) != 0;
        const int myexp = (C.lane >> 2) & 15;
        float q[NR][8];
#pragma unroll
        for (int half = 0; half < 2; ++half) {
            f32x2 a2[NR][8];
#pragma unroll
            for (int r = 0; r < NR; ++r)
#pragma unroll
                for (int e = 0; e < 8; ++e) a2[r][e] = (f32x2){0.f, 0.f};
            if (ABL == 0)
#pragma unroll
            for (int j = 0; j < 4; ++j) { const int d = 4 * C.lane + 256 * j;
#pragma unroll
                for (int e = 0; e < 8; ++e) { const f32x4 wv = *(const LAS f32x4*)(wrt + (half * 8 + e) * 1024 + d); const f32x2 w01 = {wv[0], wv[1]}, w23 = {wv[2], wv[3]};
#pragma unroll
                    for (int r = 0; r < NR; ++r) { const f32x2 h01 = {v[r][j][0], v[r][j][1]}, h23 = {v[r][j][2], v[r][j][3]}; a2[r][e] += h01 * w01; a2[r][e] += h23 * w23; }
                    if (LN_FENCE && (e & (LN_FENCE - 1)) == LN_FENCE - 1) asm volatile("" ::: "memory"); } }
            float p[NR][8];
#pragma unroll
            for (int r = 0; r < NR; ++r)
#pragma unroll
                for (int e = 0; e < 8; ++e) p[r][e] = a2[r][e][0] + a2[r][e][1];
#pragma unroll
            for (int r = 0; r < NR; ++r)
#pragma unroll
                for (int e = 0; e < 8; ++e) { const float val = p[r][e];
                    auto rr = __builtin_amdgcn_permlane32_swap(__float_as_uint(val), __float_as_uint(val), false, false);
                    const float sum = val + __uint_as_float(h5 ? rr[0] : rr[1]);
                    if (half == 0) q[r][e] = h5 ? 0.f : sum; else q[r][e] = h5 ? sum : q[r][e]; }
        }
#pragma unroll
        for (int r = 0; r < NR; ++r) { float (&t)[8] = q[r]; const int n = (row + r * NGW) & 8191;
#pragma unroll
            for (int e = 0; e < 4; ++e) { const float keep = h4 ? t[e + 4] : t[e], send = h4 ? t[e] : t[e + 4]; t[e] = keep + swz_xor<16>(send); }
#pragma unroll
            for (int e = 0; e < 2; ++e) { const float keep = h3 ? t[e + 2] : t[e], send = h3 ? t[e] : t[e + 2]; t[e] = keep + swz_xor<8>(send); }
            { const float keep = h2b ? t[1] : t[0], send = h2b ? t[0] : t[1]; t[0] = keep + swz_xor<4>(send); }
            t[0] += swz_xor<2>(t[0]); t[0] += swz_xor<1>(t[0]);
            const float logit = t[0] + rbias;
            float mx = logit; mx = fmaxf(mx, swz_xor<4>(mx)); mx = fmaxf(mx, swz_xor<8>(mx)); mx = fmaxf(mx, swz_xor<16>(mx));
            { auto rr = __builtin_amdgcn_permlane32_swap(__float_as_uint(mx), __float_as_uint(mx), false, false); mx = fmaxf(__uint_as_float(rr[0]), __uint_as_float(rr[1])); }
            const float ex = expf(logit - mx); float den = ex; den += swz_xor<4>(den); den += swz_xor<8>(den); den += swz_xor<16>(den); den = half_sum(den);
            if ((C.lane & 3) == 0) aff[((size_t)b * 16 + myexp) * SEQ + n] = ex / den; }
    }
    __syncthreads();
}

__device__ __forceinline__ unsigned block_incl_scan(unsigned v, LAS unsigned* wtot, int lane, int wave, unsigned& total) {
    unsigned x = v;
#pragma unroll
    for (int o = 1; o < 64; o <<= 1) { const unsigned y = __shfl_up(x, o); if (lane >= o) x += y; }
    if (lane == 63) wtot[wave] = x;
    __syncthreads();
    unsigned off = 0, tot = 0;
#pragma unroll
    for (int w = 0; w < 8; ++w) { const unsigned t = wtot[w]; off += (w < wave) ? t : 0u; tot += t; }
    __syncthreads();
    total = tot; return x + off;
}
__device__ __forceinline__ void p5_topk(const Ctx& C0, KA A) {
    Ctx C = C0; C.tid = C.wave * 64 + lane_id(); asm volatile("" : "+v"(C.tid)); C.lane = C.tid & 63;
    const float* aff = (const float*)(A->ws + WS_AFF); int* idx = (int*)(A->ws + WS_IDX); float* gsel = (float*)(A->ws + WS_GSEL); short* slotmap = (short*)(A->ws + WS_SLOT);
    LAS unsigned* hist = (LAS unsigned*)C.lds; LAS unsigned* wtot = hist + 4096; LAS unsigned* res = wtot + 16;
    if (C.vcu >= NB * NE) {
        LAS float* scr = (LAS float*)(C.lds + C.wave * 8448); unsigned char* ws = A->ws;
        const int gw2 = (C.vcu - NB * NE) * NWAVES + C.wave, NGW2 = (C.G - NB * NE) * NWAVES;
        f32x4 v[8]; const float* w2 = A->in[22];
        if (gw2 < 16 * 512) tr_load(TrSrc{w2 + (size_t)(gw2 / 512) * 1024 * 1024, 1024, 64 * ((gw2 % 512) / 32), 32 * (gw2 % 32)}, v, C.lane);
        for (int r = gw2; r < 16 * 512; r += NGW2) { const int e = r / 512, q = r % 512;
            const int rn = (r + NGW2 < 16 * 512) ? r + NGW2 : r; f32x4 vn[8];
            tr_load(TrSrc{w2 + (size_t)(rn / 512) * 1024 * 1024, 1024, 64 * ((rn % 512) / 32), 32 * (rn % 32)}, vn, C.lane);
            tr_store(v, 64 * (q / 32), 32 * (q % 32), (bf16_t*)(ws + WS_W2T), 1024, 0, nullptr, MapId{e * 1024}, scr, C.lane);
#pragma unroll
            for (int i = 0; i < 8; ++i) v[i] = vn[i]; }
    }
    for (int be = C.vcu; be < NB * NE; be += C.G) {
        const int b = be >> 4, e = be & 15; unsigned key[16];
#pragma unroll
        for (int j = 0; j < 4; ++j) { const u32x4 k4 = *(const u32x4*)(aff + (size_t)be * SEQ + C.tid * 16 + 4 * j); key[4 * j] = k4.x; key[4 * j + 1] = k4.y; key[4 * j + 2] = k4.z; key[4 * j + 3] = k4.w; }
        unsigned prefix = 0u, mask = 0u, need = CAP;
#pragma unroll
        for (int pass = 0; pass < 3; ++pass) {
            const int shift = pass == 0 ? 20 : (pass == 1 ? 8 : 0), nb = pass == 2 ? 256 : 4096;
            for (int i = C.tid; i < nb; i += NTHR) hist[i] = 0u;
            __syncthreads();
#pragma unroll
            for (int k = 0; k < 16; ++k) if ((key[k] & mask) == prefix) atomicAdd((unsigned*)(hist + ((key[k] >> shift) & (unsigned)(nb - 1))), 1u);
            __syncthreads();
            const int per = nb / NTHR > 0 ? nb / NTHR : 1; const int lo = C.tid * per; unsigned s = 0u;
            if (lo < nb) for (int d = 0; d < per; ++d) s += hist[lo + d];
            unsigned total; const unsigned incl = block_incl_scan(s, wtot, C.lane, C.wave, total);
            unsigned running = total - incl;
            if (lo < nb) for (int d = per - 1; d >= 0; --d) { const unsigned hv = hist[lo + d]; if (running < need && need <= running + hv) { res[0] = (unsigned)(lo + d); res[1] = running; } running += hv; }
            __syncthreads();
            prefix |= res[0] << shift; mask |= (unsigned)(nb - 1) << shift; need -= res[1];
            __syncthreads();
        }
        const unsigned T = prefix; unsigned cg = 0u, ce = 0u;
#pragma unroll
        for (int k = 0; k < 16; ++k) { cg += key[k] > T ? 1u : 0u; ce += key[k] == T ? 1u : 0u; }
        unsigned total; const unsigned packed = cg | (ce << 16); const unsigned excl = block_incl_scan(packed, wtot, C.lane, C.wave, total) - packed;
        unsigned eqr = excl >> 16; unsigned slot = (excl & 0xffffu) + (eqr < need ? eqr : need);
#pragma unroll
        for (int k = 0; k < 16; ++k) { const int n = C.tid * 16 + k; const bool iseq = key[k] == T; const bool sel = key[k] > T || (iseq && eqr < need); eqr += iseq ? 1u : 0u;
            slotmap[(size_t)be * SEQ + n] = sel ? (short)slot : (short)-1;
            if (sel) { idx[be * CAP + slot] = n; gsel[be * CAP + slot] = __uint_as_float(key[k]); ++slot; } }
        __syncthreads();
    }
}
__device__ __forceinline__ void p5b_gather(const Ctx& C0, KA A) {
    Ctx C = C0; C.tid = C.wave * 64 + lane_id(); asm volatile("" : "+v"(C.tid)); C.lane = C.tid & 63;
    const int* idx = (const int*)(A->ws + WS_IDX); const bf16_t* H2 = (const bf16_t*)(A->ws + WS_H2); bf16_t* XE = (bf16_t*)(A->ws + WS_XE);
    const int gw = C.vcu * NWAVES + C.wave, NGW = C.G * NWAVES;
    for (int r = gw; r < NB * NE * CAP; r += NGW) { const int b = r >> 14; const int n = idx[r];
        const bf16_t* s = H2 + ((size_t)b * SEQ + n) * 1024; bf16_t* d = XE + (size_t)r * 1024;
        const u32x4 v0 = *(const u32x4*)(s + 8 * C.lane), v1 = *(const u32x4*)(s + 512 + 8 * C.lane);
        *(u32x4*)(d + 8 * C.lane) = v0; *(u32x4*)(d + 512 + 8 * C.lane) = v1; }
}
__device__ __forceinline__ void p8_final(const Ctx& C0, KA A) {
    Ctx C = C0; C.tid = C.wave * 64 + lane_id(); asm volatile("" : "+v"(C.tid)); C.lane = C.tid & 63;
    float* OUT = A->out; const bf16_t* X1B = (const bf16_t*)(A->ws + WS_X1B); const bf16_t* YE = (const bf16_t*)(A->ws + WS_YE); const short* slotmap = (const short*)(A->ws + WS_SLOT); const float* mod = (const float*)(A->ws + WS_MOD);
    f32x4 lg[4], lb[4];
#pragma unroll
    for (int j = 0; j < 4; ++j) { lg[j] = *(const f32x4*)(A->in[23] + 4 * C.lane + 256 * j); lb[j] = *(const f32x4*)(A->in[24] + 4 * C.lane + 256 * j); }
    const int gw = C.vcu * NWAVES + C.wave, NGW = C.G * NWAVES;
    u32x2 xv[4]; int myslot;
    { const int row = gw; const int b = row >> 13;
#pragma unroll
      for (int j = 0; j < 4; ++j) xv[j] = *(const u32x2*)(X1B + (size_t)row * 1024 + 4 * C.lane + 256 * j);
      myslot = (int)slotmap[((size_t)b * 16 + (C.lane & 15)) * SEQ + (row & (SEQ - 1))]; }
    f32x4 ov[4]; float* op = nullptr; int cb = -1; f32x4 gg[4];
#define P8_FLUSH() do { if (op) { _Pragma("unroll") for (int j = 0; j < 4; ++j) *(f32x4*)(op + 4 * C.lane + 256 * j) = ov[j]; op = nullptr; } } while (0)
    for (int row = gw; row < NLAT; row += NGW) {
        const int b = row >> 13; float* xr = OUT + (size_t)row * 1024;
        const int nrow = (row + NGW < NLAT) ? row + NGW : row; const int nb = nrow >> 13;
        u32x2 nxv[4];
#pragma unroll
        for (int j = 0; j < 4; ++j) nxv[j] = *(const u32x2*)(X1B + (size_t)nrow * 1024 + 4 * C.lane + 256 * j);
        const int nslot = (int)slotmap[((size_t)nb * 16 + (C.lane & 15)) * SEQ + (nrow & (SEQ - 1))];
        if (b != cb) { cb = b; const float* g2 = mod + b * 6144 + 5 * 1024;
#pragma unroll
            for (int j = 0; j < 4; ++j) gg[j] = *(const f32x4*)(g2 + 4 * C.lane + 256 * j); }
        f32x4 mo[4];
#pragma unroll
        for (int j = 0; j < 4; ++j) mo[j] = (f32x4){0.f, 0.f, 0.f, 0.f};
        unsigned m = (unsigned)(__ballot(myslot >= 0) & 0xffffull);
        while (m) {
            const int e0 = __builtin_ctz(m); m &= m - 1u; const bool two = m != 0u; const int e1 = two ? __builtin_ctz(m) : e0; if (two) m &= m - 1u;
            const bf16_t* y0 = YE + ((size_t)(b * 16 + e0) * CAP + __shfl(myslot, e0)) * 1024; const bf16_t* y1 = YE + ((size_t)(b * 16 + e1) * CAP + __shfl(myslot, e1)) * 1024;
            u32x2 w0[4], w1[4];
#pragma unroll
            for (int j = 0; j < 4; ++j) { w0[j] = *(const u32x2*)(y0 + 4 * C.lane + 256 * j); w1[j] = *(const u32x2*)(y1 + 4 * C.lane + 256 * j); }
            P8_FLUSH();
            const float k1 = two ? 1.0f : 0.0f;
#pragma unroll
            for (int j = 0; j < 4; ++j) mo[j] += (f32x4){bf_lo(w0[j].x), bf_hi(w0[j].x), bf_lo(w0[j].y), bf_hi(w0[j].y)} + (f32x4){bf_lo(w1[j].x), bf_hi(w1[j].x), bf_lo(w1[j].y), bf_hi(w1[j].y)} * k1;
        }
        P8_FLUSH();
        f32x4 v[4]; float s = 0.f;
#pragma unroll
        for (int j = 0; j < 4; ++j) { v[j] = (f32x4){bf_lo(xv[j].x), bf_hi(xv[j].x), bf_lo(xv[j].y), bf_hi(xv[j].y)} * ALPHA + gg[j] * mo[j]; s += (v[j][0] + v[j][1]) + (v[j][2] + v[j][3]); }
        const float mean = wave_sum(s) * (1.0f / 1024.0f); float s2 = 0.f;
#pragma unroll
        for (int j = 0; j < 4; ++j) { v[j] = v[j] - mean; s2 += sq4(v[j]); }
        const float rstd = fast_rsq(wave_sum(s2) * (1.0f / 1024.0f) + EPS);
#pragma unroll
        for (int j = 0; j < 4; ++j) ov[j] = v[j] * rstd * lg[j] + lb[j];
        op = xr;
#pragma unroll
        for (int j = 0; j < 4; ++j) xv[j] = nxv[j];
        myslot = nslot;
    }
    P8_FLUSH();
#undef P8_FLUSH
}
#define XB_TMO      128
#define XB_XCNT(j)  (256  + 64 * (j))
#define XB_XSUB(j)  (1280 + 64 * (j))
#define XB_XGEN(j)  (2304 + 64 * (j))
#define XB_TOP      3328
#define XB_TOPGEN   3392
#define XB_P0B      3520
#define XB_MOD      3552
#define XCD_BAR_WORDS 3584
#define XB_SPIN_CAP (1u << 18)
#ifndef XB_EARLY_ACQ
#define XB_EARLY_ACQ 0
#endif
#ifndef MK_SPLIT01
#define MK_SPLIT01 MK_ONE_LAUNCH
#endif
#ifndef MK_SPLIT23
#define MK_SPLIT23 MK_ONE_LAUNCH
#endif
__device__ __forceinline__ unsigned xb_ld(unsigned* p)              { return __hip_atomic_load(p, __ATOMIC_RELAXED, __HIP_MEMORY_SCOPE_AGENT); }
__device__ __forceinline__ unsigned xb_add(unsigned* p, unsigned v) { return __hip_atomic_fetch_add(p, v, __ATOMIC_RELAXED, __HIP_MEMORY_SCOPE_AGENT); }
__device__ __forceinline__ unsigned xb_xcc_id() { return (unsigned)__builtin_amdgcn_s_getreg((3 << 11) | 20) & 0xFu; }
#define XB_SPIN(cond, bar) do { unsigned _sp = 0; while (cond) { __builtin_amdgcn_s_sleep(1); \
    if ((++_sp & 255u) == 0u) { if (xb_ld(&(bar)[XB_TMO])) break; if (_sp > XB_SPIN_CAP) { atomicAdd(&(bar)[XB_TMO], 1u); break; } } } } while (0)
struct XcdBarrier { unsigned* bar; unsigned x; volatile LAS unsigned* st; int wave; };
__device__ __forceinline__ XcdBarrier xcd_barrier_post(unsigned* bar, volatile LAS unsigned* st, int wave) {
    XcdBarrier b; b.bar = bar; b.x = xb_xcc_id(); b.st = st; b.wave = wave;
    if (wave == 0 && lane_id() == 0) (void)xb_add(&bar[XB_XCNT(b.x)], 1u);
    return b;
}
__device__ __forceinline__ void xcd_barrier_complete(unsigned* bar, unsigned x, unsigned& nloc, unsigned& nx) {
    const unsigned G = gridDim.x;
    unsigned sum, cnt, mine, sp = 0u;
    for (;;) {
        sum = 0u; cnt = 0u; mine = 0u;
#pragma unroll
        for (unsigned j = 0; j < 16; ++j) { const unsigned c = xb_ld(&bar[XB_XCNT(j)]); sum += c; cnt += (c > 0u) ? 1u : 0u; mine = (j == x) ? c : mine; }
        if (sum == G) break;
        __builtin_amdgcn_s_sleep(1);
        if ((++sp & 255u) == 0u) { if (xb_ld(&bar[XB_TMO])) break; if (sp > XB_SPIN_CAP) { atomicAdd(&bar[XB_TMO], 1u); break; } }
    }
    nloc = mine > 0u ? mine : 1u; nx = cnt > 0u ? cnt : 1u;
}
__device__ __forceinline__ void xcd_barrier(const XcdBarrier& b) {
    asm volatile("s_waitcnt vmcnt(0)" ::: "memory");
    __syncthreads();
    if (b.wave == 0 && lane_id() == 0) {
        unsigned* bar = b.bar;
        __builtin_amdgcn_s_waitcnt(0);
        unsigned nloc = b.st[0], nx = b.st[1];
        if (nloc == 0u) { xcd_barrier_complete(bar, b.x, nloc, nx); b.st[0] = nloc; b.st[1] = nx; }
        const unsigned old = xb_add(&bar[XB_XSUB(b.x)], 1u);
        const unsigned gen = old / nloc;
#if XB_EARLY_ACQ
        if (old + 1u == (gen + 1u) * nloc) {
            __builtin_amdgcn_fence(__ATOMIC_RELEASE, "agent");
            asm volatile("s_waitcnt vmcnt(0)" ::: "memory");
            asm volatile("buffer_inv sc1" ::: "memory");
            const unsigned og = xb_add(&bar[XB_TOP], 1u);
            const unsigned tg = og / nx;
            if (og + 1u == (tg + 1u) * nx) xb_add(&bar[XB_TOPGEN], 1u);
            else XB_SPIN(xb_ld(&bar[XB_TOPGEN]) == tg, bar);
            asm volatile("s_waitcnt vmcnt(0)" ::: "memory");
            xb_add(&bar[XB_XGEN(b.x)], 1u);
            asm volatile("s_waitcnt vmcnt(0)" ::: "memory");
        } else {
            asm volatile("buffer_inv sc1" ::: "memory");
            XB_SPIN(xb_ld(&bar[XB_XGEN(b.x)]) == gen, bar);
            asm volatile("s_waitcnt vmcnt(0)" ::: "memory");
        }
#else
        if (old + 1u == (gen + 1u) * nloc) {
            __builtin_amdgcn_fence(__ATOMIC_RELEASE, "agent");
            asm volatile("s_waitcnt vmcnt(0)" ::: "memory");
            const unsigned og = xb_add(&bar[XB_TOP], 1u);
            const unsigned tg = og / nx;
            if (og + 1u == (tg + 1u) * nx) xb_add(&bar[XB_TOPGEN], 1u);
            else XB_SPIN(xb_ld(&bar[XB_TOPGEN]) == tg, bar);
            __builtin_amdgcn_fence(__ATOMIC_ACQUIRE, "agent");
            xb_add(&bar[XB_XGEN(b.x)], 1u);
            asm volatile("s_waitcnt vmcnt(0)" ::: "memory");
        } else {
            XB_SPIN(xb_ld(&bar[XB_XGEN(b.x)]) == gen, bar);
            __builtin_amdgcn_fence(__ATOMIC_ACQUIRE, "agent");
            asm volatile("s_waitcnt vmcnt(0)" ::: "memory");
        }
#endif
    }
    __syncthreads();
}

#ifndef MK_CTX_IN_MOD
#define MK_CTX_IN_MOD 0
#endif
__device__ __forceinline__ void ph_gemm1(const Ctx& C, KA A, int bx, int ctxmode) {
    unsigned char* ws = A->ws; const float* rope = (const float*)(ws + WS_ROPE);
    Sched1 S{C.G, bx, (const char*)(ws + WS_A1), (const char*)(ws + WS_WIN), ctxmode};
    {
        const int tid = C.wave * 64 + lane_id();
        ((LAS u32x4*)(C.lds + 131072))[tid] = ((const u32x4*)rope)[tid]; ((LAS u32x4*)(C.lds + 131072))[tid + 512] = ((const u32x4*)rope)[tid + 512]; ((LAS u32x4*)(C.lds + 131072))[tid + 1024] = ((const u32x4*)rope)[tid + 1024];
        __syncthreads();
    }
    Epi1 E{(bf16_t*)(ws + WS_P0B), (float*)(ws + WS_SSQ), (bf16_t*)(ws + WS_KR), (bf16_t*)(ws + WS_QD), (bf16_t*)(ws + WS_KD), (bf16_t*)(ws + WS_VD), (bf16_t*)A->out, rope, (unsigned*)(ws + WS_KMAX), (const LAS float*)(C.lds + 131072),
           ctxmode == 3 ? (unsigned*)(ws + WS_CTL) + XB_P0B : nullptr};
    pg8::gemm_phase(C.wave, C.lds, pg8::Gemm{1024, 1024, 1024}, S, E);
}
__device__ __forceinline__ void ph_upproj(const Ctx& C, KA A, int bx, bool split) {
    unsigned char* ws = A->ws; const float* rope = (const float*)(ws + WS_ROPE);
    if (split) {
        if (C.wave == 0) { unsigned* bar = (unsigned*)(ws + WS_CTL);
            if (lane_id() == 0) XB_SPIN(xb_ld(&bar[XB_P0B]) < 260u, bar);
            __builtin_amdgcn_fence(__ATOMIC_ACQUIRE, "agent"); asm volatile("s_waitcnt vmcnt(0)" ::: "memory"); }
    }
    {
        const int tid = C.wave * 64 + lane_id();
        ((LAS u32x4*)(C.lds + 131072))[tid] = ((const u32x4*)(rope + 4096))[tid];
        __syncthreads();
    }
    SchedUQ Sq{C.G, bx, (const char*)(ws + WS_P0B), (const char*)(ws + WS_WUQ)}; SchedUKV Sk{C.G, bx, (const char*)(ws + WS_P0B), (const char*)(ws + WS_WUKV)};
    SchedU S{Sq, Sk, split ? C.G - 20 : C.G, split ? bx - 20 : bx};
    EpiU E{EpiUQ{(const float*)(ws + WS_SSQ), (bf16_t*)(ws + WS_QM), (const LAS float*)(C.lds + 131072)}, EpiUKV{(const float*)(ws + WS_SSQ), (const bf16_t*)(ws + WS_KR), (bf16_t*)(ws + WS_KM), (bf16_t*)(ws + WS_VM), (unsigned*)(ws + WS_KMAX)}};
    pg8::gemm_phase(C.wave, C.lds, pg8::Gemm{256, 512, 256}, S, E);
}
__device__ __forceinline__ void ph_y(const Ctx& C, KA A, int bx) {
    unsigned char* ws = A->ws;
    SchedY S{C.G, bx, (const char*)(ws + WS_OA), (const char*)(ws + WS_WOC)}; EpiY E{(const bf16_t*)A->out, (bf16_t*)(ws + WS_Y)};
    pg8::gemm_phase(C.wave, C.lds, pg8::Gemm{512, 1024, 1024}, S, E);
}
__device__ __forceinline__ void ph_z(const Ctx& C, KA A, int bx) {
    unsigned char* ws = A->ws;
    SchedZ S{C.G, bx, (const char*)(ws + WS_Y), (const char*)(ws + WS_WOUT)}; EpiZ E{(const float*)(ws + WS_MOD), (bf16_t*)(ws + WS_OL)};
    pg8::gemm_phase(C.wave, C.lds, pg8::Gemm{1024, 1024, 1024}, S, E);
}
__device__ __forceinline__ void ph_moe1(const Ctx& C, KA A, int abl = 0) {
    unsigned char* ws = A->ws;
    SchedM1 S{C.xcd, C.slot, (const char*)(ws + WS_H2), (const char*)(ws + WS_W13)}; EpiM1 E{(bf16_t*)(ws + WS_HID), abl};
    LAS int* rowsL = (LAS int*)(C.lds + 131072); const int* idx = (const int*)(ws + WS_IDX);
    { int t_ = C.wave * 64 + lane_id(); asm volatile("" : "+v"(t_));
#pragma unroll
      for (int i = 0; i < 4; ++i) { const int q = t_ + 512 * i; Unit u; S.next(q >> 8, u); rowsL[q] = idx[u.pm * 256 + (q & 255)]; } }
    __syncthreads();
    pg8::gemm_phase<EpiM1, SchedM1, true>(C.wave, C.lds, pg8::Gemm{1024, 1024, 1024}, S, E, rowsL);
}
__device__ __forceinline__ void ph_moe2(const Ctx& C, KA A) {
    unsigned char* ws = A->ws;
    SchedM2 S{C.xcd, C.slot, (const char*)(ws + WS_HID), (const char*)(ws + WS_W2T)}; EpiM2 E{(const float*)(ws + WS_GSEL), (bf16_t*)(ws + WS_YE)};
    pg8::gemm_phase(C.wave, C.lds, pg8::Gemm{1024, 1024, 1024}, S, E);
}

constexpr int NPHASE = 13;
#ifdef DBG_UBENCH
#ifndef DBG_UBN
#define DBG_UBN 4096
#endif
__device__ __forceinline__ void dbg_ubench(unsigned char* wsb) {
    float x[8]; const int l = lane_id();
#pragma unroll
    for (int i = 0; i < 8; ++i) x[i] = -1.0f - 0.001f * (float)(l + i);
    f32x16 acc = {}; bf16x8 a, b;
#pragma unroll
    for (int i = 0; i < 8; ++i) { a[i] = (short)(0x3c00 + l); b[i] = (short)(0x3c00 + i); }
#pragma unroll 1
    for (int it = 0; it < DBG_UBN; ++it) {
        if (DBG_UBENCH == 1) {
#pragma unroll
            for (int i = 0; i < 8; ++i) x[i] = __builtin_amdgcn_exp2f(x[i]) - 1.5f;
        } else if (DBG_UBENCH == 2) {
#pragma unroll
            for (int i = 0; i < 8; ++i) { x[i] = x[i] + 1.25f; x[i] = x[i] - 1.5f; }
        } else if (DBG_UBENCH == 6) {
#pragma unroll
            for (int i = 0; i < 8; ++i) { unsigned xi = __float_as_uint(x[i]); asm volatile("v_exp_f16_e32 %0, %0" : "+v"(xi)); x[i] = __uint_as_float(xi); }
#pragma unroll
            for (int i = 0; i < 8; ++i) x[i] = x[i] - 1.5f;
        } else if (DBG_UBENCH == 7) {
#pragma unroll
            for (int i = 0; i < 8; ++i) { asm volatile("v_dot2_f32_f16 %0, %1, %1, %0" : "+v"(x[i]) : "v"(__float_as_uint(x[(i + 1) & 7]))); }
        } else if (DBG_UBENCH == 3) {
            acc = __builtin_amdgcn_mfma_f32_32x32x16_bf16(a, b, acc, 0, 0, 0); acc = __builtin_amdgcn_mfma_f32_32x32x16_bf16(b, a, acc, 0, 0, 0);
        } else if (DBG_UBENCH == 4) {
            acc = __builtin_amdgcn_mfma_f32_32x32x16_bf16(a, b, acc, 0, 0, 0);
#pragma unroll
            for (int i = 0; i < 4; ++i) x[i] = __builtin_amdgcn_exp2f(x[i]) - 1.5f;
            acc = __builtin_amdgcn_mfma_f32_32x32x16_bf16(b, a, acc, 0, 0, 0);
#pragma unroll
            for (int i = 4; i < 8; ++i) x[i] = __builtin_amdgcn_exp2f(x[i]) - 1.5f;
        } else {
            acc = __builtin_amdgcn_mfma_f32_32x32x16_bf16(a, b, acc, 0, 0, 0);
#pragma unroll
            for (int i = 0; i < 4; ++i) { x[i] = x[i] + 1.25f; x[i] = x[i] - 1.5f; }
            acc = __builtin_amdgcn_mfma_f32_32x32x16_bf16(b, a, acc, 0, 0, 0);
#pragma unroll
            for (int i = 4; i < 8; ++i) { x[i] = x[i] + 1.25f; x[i] = x[i] - 1.5f; }
        }
    }
    float s = 0.f;
#pragma unroll
    for (int i = 0; i < 8; ++i) s += x[i];
#pragma unroll
    for (int i = 0; i < 16; ++i) s += acc[i];
    if (s == 123.456f) *(float*)(wsb + WS_CTL + 65536) = s;
}
#endif

__global__ void __launch_bounds__(NTHR, 2) mk(Args A_) {
    extern __shared__ __attribute__((aligned(16))) unsigned char lds_raw[];
    Ctx C; C.lds = (LAS unsigned char*)lds_raw; C.lds_g = lds_raw;
    C.tid = threadIdx.x; C.lane = 0; C.wave = __builtin_amdgcn_readfirstlane(C.tid >> 6);
    C.G = gridDim.x; { const int bx = blockIdx.x; C.xcd = bx & 7; C.slot = bx >> 3; C.vcu = (bx & 7) * (C.G >> 3) + (bx >> 3); }
    const int lo = A_.ph_lo, hi = A_.ph_hi;
#define A kargs()
#define ws (kargs()->ws)
#if MK_ONE_LAUNCH
    volatile LAS unsigned* bst = (volatile LAS unsigned*)(C.lds + LDS_BYTES - 64);
    if (threadIdx.x < 2) bst[threadIdx.x] = 0u;
    __syncthreads();
    const XcdBarrier xbar = xcd_barrier_post((unsigned*)(ws + WS_CTL), bst, C.wave);
#ifndef MK_CG_SEAM0
#define MK_CG_SEAM0 0
#endif

#define SEAM(k) do { if (lo <= (k) && (k) + 1 < hi) { if (MK_CG_SEAM0 && (k) == 0) cg::this_grid().sync(); else xcd_barrier(xbar); } } while (0)
#else
#define SEAM(k) do { } while (0)
#endif
#ifndef DBG_ONLY
#define DBG_ONLY -1
#endif
#ifndef DBG_SKIP_MASK
#define DBG_SKIP_MASK 0
#endif
#define IN(k) ((DBG_ONLY < 0 || DBG_ONLY == (k)) && !((DBG_SKIP_MASK >> (k)) & 1) && lo <= (k) && (k) < hi)
#ifndef DBG_REPEAT
#define DBG_REPEAT -1
#endif
#if MK_ONE_LAUNCH
#ifndef DBG_REPN
#define DBG_REPN 1
#endif
#define RUN(k, call) do { if (IN(k)) { if (DBG_REPEAT == (k)) { _Pragma("unroll 1") for (int r_ = 0; r_ <= DBG_REPN; ++r_) { if (r_) xcd_barrier(xbar); call; } } else { call; } } } while (0)
#else
#define RUN(k, call) do { if (IN(k)) { call; } } while (0)
#endif
    const int bx = blockIdx.x;
#ifdef DBG_TPHASE
#ifndef DBG_TMULT
#define DBG_TMULT 11
#endif
#define TBEG(k) unsigned long long tph0_##k = 0ull; if (DBG_TPHASE == (k)) tph0_##k = __builtin_amdgcn_s_memrealtime()
#define TEND(k) do { if (DBG_TPHASE == (k)) { const unsigned long long t1_ = __builtin_amdgcn_s_memrealtime(); if (blockIdx.x == 0) { const unsigned long long until_ = t1_ + (t1_ - tph0_##k) * (unsigned long long)(DBG_TMULT - 1); \
        while (__builtin_amdgcn_s_memrealtime() < until_) __builtin_amdgcn_s_sleep(8); } } } while (0)
#else
#define TBEG(k) do { } while (0)
#define TEND(k) do { } while (0)
#endif
#ifdef DBG_UBENCH
    if (IN(0)) dbg_ubench(ws);
#endif
#if MK_SPLIT01
    TBEG(200); TBEG(101); TBEG(0); RUN(0, p0_prologue(C, A, (unsigned*)(ws + WS_CTL) + XB_MOD)); TEND(0);
#define MODCNT ((unsigned*)(ws + WS_CTL) + XB_MOD)
#else
    RUN(0, p0_prologue(C, A, nullptr)); SEAM(0);
#define MODCNT ((unsigned*)nullptr)
#endif
#if MK_CTX_IN_MOD
    RUN(1, (p0b_modulate(C, A, bx, true, MODCNT), ph_gemm1(C, A, bx, 1))); SEAM(1);
    RUN(2, ph_gemm1(C, A, bx, 0)); SEAM(2);
#else
    TBEG(1); RUN(1, p0b_modulate(C, A, bx, false, MODCNT)); SEAM(1); TEND(1); TEND(101);
    TBEG(23);
#if defined(DBG_PHCLK) && MK_ONE_LAUNCH
    if (IN(2)) { const unsigned long long t0 = __builtin_amdgcn_s_memtime(), r0 = __builtin_amdgcn_s_memrealtime();
        ph_gemm1(C, A, bx, 2);
        const unsigned long long t1 = __builtin_amdgcn_s_memtime(), r1 = __builtin_amdgcn_s_memrealtime();
        if (blockIdx.x == 0) { const unsigned long long mhz = (t1 - t0) * 100ull / (r1 - r0 + 1ull); const unsigned long long until = r1 + mhz * 100ull;
            while (__builtin_amdgcn_s_memrealtime() < until) __builtin_amdgcn_s_sleep(8); } }
    SEAM(2);
#else
#if MK_SPLIT23
    RUN(2, ph_gemm1(C, A, bx, 3));
#else
    RUN(2, ph_gemm1(C, A, bx, 2)); SEAM(2);
#endif
#endif
#endif
    RUN(3, ph_upproj(C, A, bx, MK_SPLIT23 != 0)); SEAM(3); TEND(23);
    TBEG(4);
#if !MK_NAIVE_ATTN
#if defined(DBG_CLOCK) && MK_ONE_LAUNCH
    if (IN(4)) {
        const unsigned long long t0 = __builtin_amdgcn_s_memtime(), r0 = __builtin_amdgcn_s_memrealtime();
        attn_phase<0>(C, ws, A->in[13]);
        const unsigned long long t1 = __builtin_amdgcn_s_memtime(), r1 = __builtin_amdgcn_s_memrealtime();
        if (blockIdx.x == 0) { const unsigned long long mhz = (t1 - t0) * 100ull / (r1 - r0 + 1ull); const unsigned long long until = r1 + mhz * 100ull;
            while (__builtin_amdgcn_s_memrealtime() < until) __builtin_amdgcn_s_sleep(8); }
    }
#elif defined(DBG_ABL) && MK_ONE_LAUNCH
    if (IN(4)) { attn_phase<DBG_ABL>(C, ws, A->in[13]); xcd_barrier(xbar); attn_phase<0>(C, ws, A->in[13]); }
#else
#if ATT16
    RUN(4, attn_phase16(C, ws, A->in[13]));
#else
    RUN(4, attn_phase<0>(C, ws, A->in[13]));
#endif
#endif
#endif
    SEAM(4); TEND(4);
    TBEG(5); RUN(5, ph_y(C, A, bx)); SEAM(5); TEND(5);
    TBEG(6); RUN(6, ph_z(C, A, bx)); TBEG(106); SEAM(6); TEND(106); TEND(6);
    TBEG(7);
#ifdef DBG_LNABL
    if (IN(7)) { p4_ln_router<DBG_LNABL>(C, A); xcd_barrier(xbar); p4_ln_router<0>(C, A); } SEAM(7);
#else
    RUN(7, p4_ln_router<0>(C, A)); SEAM(7);
#endif
    TEND(7);
    TBEG(8); RUN(8, p5_topk(C, A)); SEAM(8); TEND(8);
    TBEG(10);
#if defined(DBG_M1ABL) && MK_ONE_LAUNCH
    if (IN(10)) { ph_moe1(C, A, DBG_M1ABL); xcd_barrier(xbar); ph_moe1(C, A, 0); } SEAM(10);
#else
    RUN(10, ph_moe1(C, A)); SEAM(10);
#endif
    TEND(10);
    TBEG(11); RUN(11, ph_moe2(C, A)); SEAM(11); TEND(11);
#ifdef DBG_TPHASE
    TBEG(12); TBEG(212); RUN(12, p8_final(C, A)); TEND(12);
    if (DBG_TPHASE == 200 || DBG_TPHASE == 212) { xcd_barrier(xbar); }
    TEND(212); TEND(200);
#else
    RUN(12, p8_final(C, A));
#endif
#undef RUN
#undef TBEG
#undef TEND
#undef A
#undef ws
#undef IN
#undef SEAM
}

#ifdef DBG_COPY_OFF
__global__ void dbg_copy(u32x4* dst, const u32x4* src, size_t n16) { for (size_t i = blockIdx.x * 256ull + threadIdx.x; i < n16; i += gridDim.x * 256ull) dst[i] = src[i]; }
#endif
extern "C" void kernel_launch(void* const* d_in, const int* in_sizes, int n_in, void* d_out, int out_size, void* d_ws, size_t ws_size, hipStream_t stream) {
    static int ready = 0;
    if (ready == 0) {
        if (n_in != 25 || in_sizes[0] != NLAT * DM || out_size != NLAT * DM || ws_size < WS_NEED) {
            fprintf(stderr, "kernel_launch: unexpected shapes (n_in %d, x %d, out %d, ws %zu; need ws >= %zu)\n", n_in, n_in > 0 ? in_sizes[0] : -1, out_size, ws_size, (size_t)WS_NEED); ready = -1; return; }
        if (hipFuncSetAttribute((const void*)mk, hipFuncAttributeMaxDynamicSharedMemorySize, LDS_BYTES) != hipSuccess) { fprintf(stderr, "kernel_launch: hipFuncSetAttribute failed\n"); ready = -1; return; }
        int dev = 0, cus = 0, per_cu = 0;
        (void)hipGetDevice(&dev); (void)hipDeviceGetAttribute(&cus, hipDeviceAttributeMultiprocessorCount, dev);
        (void)hipOccupancyMaxActiveBlocksPerMultiprocessor(&per_cu, (const void*)mk, NTHR, LDS_BYTES);
        if (cus != 256 || per_cu < 1) { fprintf(stderr, "kernel_launch: needs 256 CUs with one resident workgroup each (cus %d, per_cu %d)\n", cus, per_cu); ready = -1; return; }
        ready = 1;
    }
    if (ready < 0) return;
    Args a{};
    for (int i = 0; i < 25; ++i) a.in[i] = (const float*)d_in[i];
    a.out = (float*)d_out; a.ws = (unsigned char*)d_ws;
#if MK_ONE_LAUNCH
    a.ph_lo = 0; a.ph_hi = NPHASE;
#ifdef DBG_EXTRA_MEMSET
    for (int i_ = 0; i_ < DBG_EXTRA_MEMSET; ++i_) (void)hipMemsetAsync((char*)d_ws + WS_CTL + 65536, 0, XCD_BAR_WORDS * 4, stream);
#endif
    if (hipMemsetAsync((char*)d_ws + WS_CTL, 0, XCD_BAR_WORDS * 4, stream) != hipSuccess) { fprintf(stderr, "kernel_launch: memset of the barrier words failed\n"); return; }
    void* kargs[] = {&a};
#ifdef DBG_PLAIN_LAUNCH
    (void)kargs; hipLaunchKernelGGL(mk, dim3(256), dim3(NTHR), LDS_BYTES, stream, a);
#else
    hipError_t e = hipLaunchCooperativeKernel((const void*)mk, dim3(256), dim3(NTHR), kargs, LDS_BYTES, stream);
    if (e != hipSuccess) fprintf(stderr, "kernel_launch: cooperative launch failed: %s\n", hipGetErrorString(e));
#endif
#else
#ifndef DBG_LAST_PHASE
#define DBG_LAST_PHASE 99
#endif
    for (int ph = 0; ph < NPHASE && ph <= DBG_LAST_PHASE; ++ph) {
#if MK_NAIVE_ATTN
        if (ph == 4) {
            unsigned char* ws = (unsigned char*)d_ws;
            naive_attn<0><<<NB * 8 * SEQ / 4, 256, 0, stream>>>((const bf16_t*)(ws + WS_QM), (const bf16_t*)(ws + WS_KM), (const bf16_t*)(ws + WS_VM), (bf16_t*)(ws + WS_OA), (const float*)(ws + WS_LAM), (const float*)d_in[13]);
            naive_attn<1><<<NB * 4 * SEQ / 4, 256, 0, stream>>>((const bf16_t*)(ws + WS_QD), (const bf16_t*)(ws + WS_KD), (const bf16_t*)(ws + WS_VD), (bf16_t*)(ws + WS_OA), (const float*)(ws + WS_LAM), (const float*)d_in[13]);
            continue;
        }
#endif
        a.ph_lo = ph; a.ph_hi = ph + 1;
        hipLaunchKernelGGL(mk, dim3(256), dim3(NTHR), LDS_BYTES, stream, a);
    }
#ifdef DBG_COPY_OFF
    dbg_copy<<<2048, 256, 0, stream>>>((u32x4*)d_out, (const u32x4*)((unsigned char*)d_ws + (size_t)DBG_COPY_OFF), (size_t)DBG_COPY_BYTES / 16);
#endif
    hipError_t e = hipPeekAtLastError();
    if (e != hipSuccess) fprintf(stderr, "kernel_launch: launch failed: %s\n", hipGetErrorString(e));
#endif
}
```
